# Optimizing an MI355X kernel written in HIP

```python
import math
import jax, jax.numpy as jnp
from jax import lax
import numpy as np

D_MODEL = 1024
BATCH = 8
SEQ = 4096
DEPTH = 2
DEC_BATCH = 16
DEC_SEQ = 64
PAST_LEN = 1024

CHUNK = 64
Q_BLOCK = 128
N_MEM = 256
MEM_HEADS = 4
MEM_HD = 64
MEM_W = MEM_HEADS * MEM_HD
MIX_W = D_MODEL - MEM_W
RET_HEADS = 6
RET_HD = MIX_W // RET_HEADS
RET_THETA = 10000.0
DIFF_HEADS = 6
DIFF_HD = MIX_W // (2 * DIFF_HEADS)
ROPE_THETA = 500000.0
ROT_DIM = DIFF_HD // 4
D_FF = -(-8 * D_MODEL // (3 * 256)) * 256
ALPHA = (2 * DEPTH) ** 0.25
BETA = (8 * DEPTH) ** -0.25
N_RET = (DEPTH + 1) // 2
N_DIFF = DEPTH // 2
LN_EPS = 1e-5
NEG_INF = -1e30

kernel_name = "chunk_causal_retention_diffattn_memory_encoder_step"


def _lambda_init(layer_idx):
    return 0.8 - 0.6 * math.exp(-0.3 * layer_idx)


def _layer_norm(x, g, b):
    xf = x.astype(jnp.float32)
    mu = jnp.mean(xf, axis=-1, keepdims=True)
    var = jnp.mean(jnp.square(xf - mu), axis=-1, keepdims=True)
    return ((xf - mu) * lax.rsqrt(var + LN_EPS) * g.astype(jnp.float32) + b.astype(jnp.float32)).astype(x.dtype)


def _post_norm(x, y, g, b):
    return _layer_norm(ALPHA * x + y, g, b)


def _rope(x, pos, rot_dim, theta):
    half = rot_dim // 2
    inv_freq = jnp.exp(-math.log(theta) * jnp.arange(half, dtype=jnp.float32) * 2.0 / rot_dim)
    ang = pos.astype(jnp.float32)[:, None] * inv_freq[None, :]
    bshape = (pos.shape[0],) + (1,) * (x.ndim - 3) + (half,)
    cos = jnp.cos(ang).reshape(bshape)
    sin = jnp.sin(ang).reshape(bshape)
    xf = x.astype(jnp.float32)
    x1 = xf[..., :half]
    x2 = xf[..., half:rot_dim]
    out = jnp.concatenate([x1 * cos - x2 * sin, x1 * sin + x2 * cos, xf[..., rot_dim:]], axis=-1)
    return out.astype(x.dtype)


def _memory_attention(mq, mem_k, mem_v):
    B, S = mq.shape[:2]
    s = jnp.einsum('bshd,bmhd->bhsm', mq, mem_k).astype(jnp.float32) * MEM_HD ** -0.5
    p = jax.nn.softmax(s, axis=-1)
    o = jnp.einsum('bhsm,bmhd->bshd', p, mem_v.astype(jnp.float32))
    return o.reshape(B, S, MEM_W)


def _retention_scan(q, k, v, r0):
    B, S, H, DK = q.shape
    DV = v.shape[-1]
    cl = min(S, CHUNK)
    nc = S // cl
    log_g = jnp.log(1.0 - jnp.exp2(-5.0 - jnp.arange(H, dtype=jnp.float32)))
    idx = jnp.arange(cl, dtype=jnp.float32)
    decay_in = jnp.exp(jnp.abs(idx[:, None] - idx[None, :])[None] * log_g[:, None, None])
    xi = jnp.exp((idx + 1.0)[:, None] * log_g[None, :])
    zeta = jnp.exp((cl - 1.0 - idx)[:, None] * log_g[None, :])
    g_chunk = jnp.exp(cl * log_g)

    def to_chunks(t):
        return t.reshape(B, nc, cl, H, t.shape[-1]).transpose(1, 0, 2, 3, 4)

    def step(r, qkv):
        qc, kc, vc = qkv
        inner = jnp.einsum('bihd,bjhd->bhij', qc, kc) * decay_in
        o = (jnp.einsum('bhij,bjhe->bihe', inner, vc)
             + jnp.einsum('bihd,bhde->bihe', qc, r) * xi[None, :, :, None])
        r = g_chunk[None, :, None, None] * r + jnp.einsum('bjhd,bjhe,jh->bhde', kc, vc, zeta)
        return r, o

    r, o = lax.scan(step, r0, (to_chunks(q), to_chunks(k), to_chunks(v)))
    return o.transpose(1, 0, 2, 3, 4).reshape(B, S, H, DV), r


def _retention_mixer(x, pos, r0, mem_k, mem_v, w_in, gn_g):
    B, S, _ = x.shape
    proj = x @ w_in
    q, k, v, g, mq = jnp.split(proj, [MIX_W, 2 * MIX_W, 3 * MIX_W, 4 * MIX_W], axis=-1)
    q = _rope(q.reshape(B, S, RET_HEADS, RET_HD), pos, RET_HD, RET_THETA).astype(jnp.float32)
    k = _rope(k.reshape(B, S, RET_HEADS, RET_HD), pos, RET_HD, RET_THETA).astype(jnp.float32) * RET_HD ** -0.5
    v = v.reshape(B, S, RET_HEADS, RET_HD).astype(jnp.float32)
    o, r_new = _retention_scan(q, k, v, r0.astype(jnp.float32))
    mu = jnp.mean(o, axis=-1, keepdims=True)
    var = jnp.mean(jnp.square(o - mu), axis=-1, keepdims=True)
    o = ((o - mu) * lax.rsqrt(var + LN_EPS)).reshape(B, S, MIX_W) * gn_g.astype(jnp.float32)
    o = o * jax.nn.silu(g.astype(jnp.float32))
    m = _memory_attention(mq.reshape(B, S, MEM_HEADS, MEM_HD), mem_k, mem_v)
    return jnp.concatenate([o, m], axis=-1).astype(x.dtype), r_new


def _diff_project(x, pos, w_in):
    B, S, _ = x.shape
    proj = x @ w_in
    q, k, v, mq = jnp.split(proj, [MIX_W, 2 * MIX_W, 3 * MIX_W], axis=-1)
    q = _rope(q.reshape(B, S, DIFF_HEADS, 2, DIFF_HD), pos, ROT_DIM, ROPE_THETA)
    k = _rope(k.reshape(B, S, DIFF_HEADS, 2, DIFF_HD), pos, ROT_DIM, ROPE_THETA)
    v = v.reshape(B, S, DIFF_HEADS, 2 * DIFF_HD)
    mq = mq.reshape(B, S, MEM_HEADS, MEM_HD)
    return q, k, v, mq


def _diff_lambda(lq1, lk1, lq2, lk2, lam_init):
    f = jnp.float32
    return (jnp.exp(jnp.sum(lq1.astype(f) * lk1.astype(f)))
            - jnp.exp(jnp.sum(lq2.astype(f) * lk2.astype(f))) + lam_init)


def _diff_weighted_values(s, lam, vf):
    p = jax.nn.softmax(s, axis=-1)
    a = p[:, :, 0] - lam * p[:, :, 1]
    return jnp.einsum('bhqk,bkhe->bqhe', a, vf)


def _diff_attention_prompt(q, k, v, lam):
    B, S = q.shape[:2]
    nb = S // Q_BLOCK
    qb = q.reshape(B, nb, Q_BLOCK, DIFF_HEADS, 2, DIFF_HD).transpose(1, 0, 2, 3, 4, 5)
    key_chunk = jnp.arange(S) // CHUNK
    vf = v.astype(jnp.float32)

    def block(args):
        q_blk, b_idx = args
        s = jnp.einsum('bqhcd,bkhcd->bhcqk', q_blk, k).astype(jnp.float32) * DIFF_HD ** -0.5
        q_chunk = (b_idx * Q_BLOCK + jnp.arange(Q_BLOCK)) // CHUNK
        mask = key_chunk[None, :] <= q_chunk[:, None]
        s = jnp.where(mask, s, NEG_INF)
        return _diff_weighted_values(s, lam, vf)

    o = lax.map(block, (qb, jnp.arange(nb)))
    return o.transpose(1, 0, 2, 3, 4).reshape(B, S, DIFF_HEADS, 2 * DIFF_HD)


def _diff_attention_sample(q, k_all, v_all, lam):
    s = jnp.einsum('bqhcd,bkhcd->bhcqk', q, k_all).astype(jnp.float32) * DIFF_HD ** -0.5
    return _diff_weighted_values(s, lam, v_all.astype(jnp.float32))


def _diff_head_norm(o, subln_g, lam_init):
    B, S = o.shape[:2]
    ms = jnp.mean(jnp.square(o), axis=-1, keepdims=True)
    o = o * lax.rsqrt(ms + LN_EPS) * subln_g.astype(jnp.float32) * (1.0 - lam_init)
    return o.reshape(B, S, MIX_W)


def _swiglu(x, w_gate, w_up, w_down):
    return (jax.nn.silu(x @ w_gate) * (x @ w_up)) @ w_down


def setup_inputs(seed: int = 0) -> dict:
    key = jax.random.key(seed)
    ks = jax.random.split(key, 32)
    f = jnp.float32

    def nrm(k, shape, scale):
        return jax.random.normal(k, shape, f) * scale

    d_is = D_MODEL ** -0.5
    ret_cols = 4 * MIX_W + MEM_W
    ret_col_scale = jnp.ones((ret_cols,), f).at[2 * MIX_W:3 * MIX_W].set(BETA)
    diff_cols = 3 * MIX_W + MEM_W
    diff_col_scale = jnp.ones((diff_cols,), f).at[2 * MIX_W:3 * MIX_W].set(BETA)
    mem_col_scale = jnp.ones((2 * MEM_W,), f).at[MEM_W:].set(BETA)
    return {
        "x_prompt": nrm(ks[0], (BATCH, SEQ, D_MODEL), 1.0),
        "x_sample": nrm(ks[1], (DEC_BATCH, DEC_SEQ, D_MODEL), 1.0),
        "mem_prompt": nrm(ks[2], (BATCH, N_MEM, D_MODEL), 1.0),
        "cache_ret_state": nrm(ks[3], (N_RET, DEC_BATCH, RET_HEADS, RET_HD, RET_HD), 0.5),
        "cache_diff_k": nrm(ks[4], (N_DIFF, DEC_BATCH, PAST_LEN, DIFF_HEADS, 2 * DIFF_HD), 1.0),
        "cache_diff_v": nrm(ks[5], (N_DIFF, DEC_BATCH, PAST_LEN, DIFF_HEADS, 2 * DIFF_HD), BETA),
        "cache_mem_k": nrm(ks[6], (DEPTH, DEC_BATCH, N_MEM, MEM_HEADS, MEM_HD), 1.0),
        "cache_mem_v": nrm(ks[7], (DEPTH, DEC_BATCH, N_MEM, MEM_HEADS, MEM_HD), BETA),
        "ret_w_in": nrm(ks[8], (N_RET, D_MODEL, ret_cols), d_is) * ret_col_scale,
        "ret_gn_g": 1.0 + nrm(ks[9], (N_RET, MIX_W), 0.02),
        "diff_w_in": nrm(ks[10], (N_DIFF, D_MODEL, diff_cols), d_is) * diff_col_scale,
        "diff_lambda_q1": nrm(ks[11], (N_DIFF, DIFF_HD), 0.1),
        "diff_lambda_k1": nrm(ks[12], (N_DIFF, DIFF_HD), 0.1),
        "diff_lambda_q2": nrm(ks[13], (N_DIFF, DIFF_HD), 0.1),
        "diff_lambda_k2": nrm(ks[14], (N_DIFF, DIFF_HD), 0.1),
        "diff_subln_g": 1.0 + nrm(ks[15], (N_DIFF, 2 * DIFF_HD), 0.02),
        "w_mem_kv": nrm(ks[16], (DEPTH, D_MODEL, 2 * MEM_W), d_is) * mem_col_scale,
        "w_o": nrm(ks[17], (DEPTH, D_MODEL, D_MODEL), d_is * BETA),
        "ln1_g": 1.0 + nrm(ks[18], (DEPTH, D_MODEL), 0.02),
        "ln1_b": nrm(ks[19], (DEPTH, D_MODEL), 0.02),
        "w_gate": nrm(ks[20], (DEPTH, D_MODEL, D_FF), d_is),
        "w_up": nrm(ks[21], (DEPTH, D_MODEL, D_FF), d_is),
        "w_down": nrm(ks[22], (DEPTH, D_FF, D_MODEL), D_FF ** -0.5 * BETA),
        "ln2_g": 1.0 + nrm(ks[23], (DEPTH, D_MODEL), 0.02),
        "ln2_b": nrm(ks[24], (DEPTH, D_MODEL), 0.02),
    }


def reference(x_prompt, x_sample, mem_prompt, cache_ret_state, cache_diff_k, cache_diff_v,
              cache_mem_k, cache_mem_v, ret_w_in, ret_gn_g, diff_w_in, diff_lambda_q1,
              diff_lambda_k1, diff_lambda_q2, diff_lambda_k2, diff_subln_g, w_mem_kv, w_o,
              ln1_g, ln1_b, w_gate, w_up, w_down, ln2_g, ln2_b):
    Bp, Sp, _ = x_prompt.shape
    Bs, Ss, _ = x_sample.shape
    pos_p = jnp.arange(Sp)
    pos_s = PAST_LEN + jnp.arange(Ss)
    xp, xs = x_prompt, x_sample
    ret_p, ret_s, dkp, dvp, dks, dvs, mkp, mvp = [], [], [], [], [], [], [], []
    for i in range(DEPTH):
        j = i // 2
        mk_p, mv_p = jnp.split(mem_prompt @ w_mem_kv[i], 2, axis=-1)
        mk_p = mk_p.reshape(Bp, N_MEM, MEM_HEADS, MEM_HD)
        mv_p = mv_p.reshape(Bp, N_MEM, MEM_HEADS, MEM_HD)
        mkp.append(mk_p)
        mvp.append(mv_p)
        mk_s, mv_s = cache_mem_k[i], cache_mem_v[i]
        if i % 2 == 0:
            r0 = jnp.zeros((Bp, RET_HEADS, RET_HD, RET_HD), jnp.float32)
            hp, rp = _retention_mixer(xp, pos_p, r0, mk_p, mv_p, ret_w_in[j], ret_gn_g[j])
            hs, rs = _retention_mixer(xs, pos_s, cache_ret_state[j], mk_s, mv_s, ret_w_in[j], ret_gn_g[j])
            ret_p.append(rp.astype(xp.dtype))
            ret_s.append(rs.astype(xs.dtype))
        else:
            lam_init = _lambda_init(i)
            lam = _diff_lambda(diff_lambda_q1[j], diff_lambda_k1[j], diff_lambda_q2[j], diff_lambda_k2[j], lam_init)
            q, k, v, mq = _diff_project(xp, pos_p, diff_w_in[j])
            o = _diff_attention_prompt(q, k, v, lam)
            hp = jnp.concatenate([_diff_head_norm(o, diff_subln_g[j], lam_init),
                                  _memory_attention(mq, mk_p, mv_p)], axis=-1).astype(xp.dtype)
            dkp.append(k.reshape(Bp, Sp, DIFF_HEADS, 2 * DIFF_HD))
            dvp.append(v)
            q, k, v, mq = _diff_project(xs, pos_s, diff_w_in[j])
            k_all = jnp.concatenate(
                [cache_diff_k[j].reshape(Bs, PAST_LEN, DIFF_HEADS, 2, DIFF_HD).astype(k.dtype), k], axis=1)
            v_all = jnp.concatenate([cache_diff_v[j].astype(v.dtype), v], axis=1)
            o = _diff_attention_sample(q, k_all, v_all, lam)
            hs = jnp.concatenate([_diff_head_norm(o, diff_subln_g[j], lam_init),
                                  _memory_attention(mq, mk_s, mv_s)], axis=-1).astype(xs.dtype)
            dks.append(k.reshape(Bs, Ss, DIFF_HEADS, 2 * DIFF_HD))
            dvs.append(v)
        xp = _post_norm(xp, hp @ w_o[i], ln1_g[i], ln1_b[i])
        xp = _post_norm(xp, _swiglu(xp, w_gate[i], w_up[i], w_down[i]), ln2_g[i], ln2_b[i])
        xs = _post_norm(xs, hs @ w_o[i], ln1_g[i], ln1_b[i])
        xs = _post_norm(xs, _swiglu(xs, w_gate[i], w_up[i], w_down[i]), ln2_g[i], ln2_b[i])
    return (xp, xs, jnp.stack(ret_p), jnp.stack(ret_s), jnp.stack(dkp), jnp.stack(dvp),
            jnp.stack(dks), jnp.stack(dvs), jnp.stack(mkp), jnp.stack(mvp))
```

```cpp
#include <hip/hip_runtime.h>
#include <hip/hip_cooperative_groups.h>
#include <stdint.h>
#include <stdio.h>
namespace cg = cooperative_groups;

typedef unsigned short bf16_t;
typedef short bf16x8 __attribute__((ext_vector_type(8)));
typedef float f32x4 __attribute__((ext_vector_type(4)));
typedef float f32x16 __attribute__((ext_vector_type(16)));
#define LAS __attribute__((address_space(3)))

#define MFMA32(a, b, c) __builtin_amdgcn_mfma_f32_32x32x16_bf16(a, b, c, 0, 0, 0)
#define MFMA16(a, b, c) __builtin_amdgcn_mfma_f32_16x16x32_bf16(a, b, c, 0, 0, 0)

constexpr int TP = 32768, TS = 1024, TT = TP + TS;
constexpr int NRET = 3328, NDIFF = 2560, DFF = 2816;
constexpr float ALPHA = 1.41421356237f;
constexpr float LAM_INIT = 0.35550907f;
constexpr int NTHR = 512;
constexpr int LDS_MAIN = 131072, LDS_BYTES = LDS_MAIN + 256;

constexpr size_t O_YP = 0, O_RSP = 34603008, O_RSS = 35389440, O_DKP = 36962304, O_DVP = 62128128,
                 O_DKS = 87293952, O_DVS = 88080384, O_MKP = 88866816, O_MVP = 89915392;
constexpr size_t W_CTRL = 0;
constexpr size_t W_ROPER = 16384;
constexpr size_t W_ROPED = W_ROPER + 4096ull * 64 * 8;
constexpr size_t W_WRET = W_ROPED + 4096ull * 8 * 8;
constexpr size_t W_WDIFF = W_WRET + (size_t)NRET * 1024 * 2;
constexpr size_t W_WMKV = W_WDIFF + (size_t)NDIFF * 1024 * 2;
constexpr size_t W_WO = W_WMKV + 2ull * 512 * 1024 * 2;
constexpr size_t W_WGU = W_WO + 2ull * 1024 * 1024 * 2;
constexpr size_t W_WD = W_WGU + 2ull * 5632 * 1024 * 2;
constexpr size_t W_MB = W_WD + 2ull * 1024 * 2816 * 2;
constexpr size_t W_MK = W_MB + 2048ull * 1024 * 2;
constexpr size_t W_MVT = W_MK + 2ull * 24 * 65536 * 2;
constexpr size_t W_XB = W_MVT + 2ull * 24 * 65536 * 2;
constexpr size_t W_H = W_XB + (size_t)TT * 1024 * 2;
constexpr size_t W_RA = W_H + (size_t)TT * 1024 * 2;
constexpr size_t W_END = W_RA + (size_t)TT * NRET * 2;
constexpr size_t W_QM = W_RA;
constexpr size_t W_KBP = W_QM + (size_t)TT * 1024 * 2;
constexpr size_t W_KBS = W_KBP + 8ull * 4096 * 768 * 2;
constexpr size_t W_VTP = W_KBS + 16ull * 1088 * 768 * 2;
constexpr size_t W_VTS = W_VTP + 8ull * 6 * 128 * 4096 * 2;
static_assert(W_VTS + 16ull * 6 * 128 * 1088 * 2 <= W_END, "layer-1 overlay too big");

struct Params {
    const float* in[25];
    float* out;
    char* ws;
    int ph_lo, ph_hi;
};

__device__ __forceinline__ int TIDX() { int t = threadIdx.x; asm volatile("" : "+v"(t)); return t; }
__device__ __forceinline__ int BIDX() { int t = blockIdx.x; asm volatile("" : "+s"(t)); return t; }
typedef __bf16 bf2_t __attribute__((ext_vector_type(2)));
typedef float f2_t __attribute__((ext_vector_type(2)));
__device__ __forceinline__ uint32_t pk2(float lo, float hi) { f2_t f = {lo, hi}; bf2_t b = __builtin_convertvector(f, bf2_t); return *(uint32_t*)&b; }
__device__ __forceinline__ bf16_t f2bf(float f) { return (bf16_t)(pk2(f, 0.f) & 0xffffu); }
__device__ __forceinline__ float bf2f(bf16_t b) { return __uint_as_float(((uint32_t)b) << 16); }
__device__ __forceinline__ float bflo(uint32_t u) { return __uint_as_float(u << 16); }
__device__ __forceinline__ float bfhi(uint32_t u) { return __uint_as_float(u & 0xffff0000u); }
__device__ __forceinline__ bf16x8 mk8(uint32_t a, uint32_t b, uint32_t c, uint32_t d) { uint4 u = make_uint4(a, b, c, d); return *(bf16x8*)&u; }
__device__ __forceinline__ bf16x8 pack8(f32x4 a, f32x4 b) { return mk8(pk2(a[0], a[1]), pk2(a[2], a[3]), pk2(b[0], b[1]), pk2(b[2], b[3])); }
__device__ __forceinline__ bf16x8 ld8(const bf16_t* p) { return *(const bf16x8*)p; }
__device__ __forceinline__ bf16x8 ld44(const bf16_t* lo, const bf16_t* hi) { uint2 a = *(const uint2*)lo, b = *(const uint2*)hi; return mk8(a.x, a.y, b.x, b.y); }
__device__ __forceinline__ float xr16_32_max(float v) { v = fmaxf(v, __shfl_xor(v, 16)); v = fmaxf(v, __shfl_xor(v, 32)); return v; }
__device__ __forceinline__ float xr16_32_sum(float v) { v += __shfl_xor(v, 16); v += __shfl_xor(v, 32); return v; }
__device__ __forceinline__ float wave_sum(float v) { for (int o = 1; o < 64; o <<= 1) v += __shfl_xor(v, o); return v; }
__device__ __forceinline__ void unpack8(uint4 u, float* f) { f[0] = bflo(u.x); f[1] = bfhi(u.x); f[2] = bflo(u.y); f[3] = bfhi(u.y); f[4] = bflo(u.z); f[5] = bfhi(u.z); f[6] = bflo(u.w); f[7] = bfhi(u.w); }
__device__ __forceinline__ float silu(float x) { return x / (1.f + __expf(-x)); }

constexpr int G_BK = 64, G_HT = 128 * 64;
__device__ __forceinline__ int lds_byte(int r, int c) { const int st = (r >> 4) * 2 + (c >> 5), rr = r & 15, cc = c & 31, ob = rr * 64 + cc * 2; return st * 1024 + (ob ^ (((ob >> 9) & 1) << 5)); }
__device__ __forceinline__ void stage_rc(int b, int& R, int& C) { const int st = b / 1024, sb = b % 1024, swz = sb ^ (((sb >> 9) & 1) << 5); R = (st >> 1) * 16 + swz / 64; C = (st & 1) * 32 + (swz % 64) / 2; }

template <class Epi>
__device__ __forceinline__ void gemm256_tile(const bf16_t* __restrict__ A, const bf16_t* __restrict__ Bt, const int K, const int brow, const int bcol, const bool pre, const int nrow, const int ncol, char* lds, const Epi& epi) {
    bf16_t* shm = (bf16_t*)lds;
#define SA(b, h) (shm + ((b) * 2 + (h)) * G_HT)
#define SB(b, h) (shm + (4 + (b) * 2 + (h)) * G_HT)
#define STAGE(P, BASE, br, kt) do { const long _g = (long)(br) * K + (long)(kt) * G_BK; \
    _Pragma("unroll") for (int _i = 0; _i < 2; ++_i) { const int _b = tid * 16 + _i * 8192; int _r, _c; stage_rc(_b, _r, _c); \
      __builtin_amdgcn_global_load_lds((const unsigned*)(BASE + _g + (long)_r * K + _c), (__attribute__((address_space(3))) unsigned*)((char*)(P) + _b), 16, 0, 0); } } while (0)
#define LDA(dst, b, h) _Pragma("unroll") for (int m = 0; m < 4; ++m) _Pragma("unroll") for (int k = 0; k < 2; ++k) \
    dst[m][k] = *reinterpret_cast<const bf16x8*>((char*)SA(b, h) + lds_byte(wr * 64 + m * 16 + fr, k * 32 + fq * 8))
#define LDB(dst, b, h) _Pragma("unroll") for (int n = 0; n < 2; ++n) _Pragma("unroll") for (int k = 0; k < 2; ++k) \
    dst[n][k] = *reinterpret_cast<const bf16x8*>((char*)SB(b, h) + lds_byte(wc * 32 + n * 16 + fr, k * 32 + fq * 8))
#define MMA(ai, bj, At_, Bt_) do { __builtin_amdgcn_s_setprio(1); \
    _Pragma("unroll") for (int m = 0; m < 4; ++m) _Pragma("unroll") for (int n = 0; n < 2; ++n) _Pragma("unroll") for (int k = 0; k < 2; ++k) \
      acc[ai][bj][m][n] = MFMA16(Bt_[n][k], At_[m][k], acc[ai][bj][m][n]); \
    __builtin_amdgcn_s_setprio(0); } while (0)
#define WAIT_V(n) asm volatile("s_waitcnt vmcnt(" #n ")" ::: "memory")
#define WAIT_L(n) asm volatile("s_waitcnt lgkmcnt(" #n ")" ::: "memory")
#define BAR __builtin_amdgcn_s_barrier()
#define SCHED __builtin_amdgcn_sched_barrier(0)
    const int tid = TIDX();
    const int wid = tid >> 6, lane = tid & 63, wr = wid >> 2, wc = wid & 3, fr = lane & 15, fq = lane >> 4;
    constexpr int HALF = 128;
    f32x4 acc[2][2][4][2];
#pragma unroll
    for (int a = 0; a < 2; ++a)
#pragma unroll
        for (int b = 0; b < 2; ++b)
#pragma unroll
            for (int m = 0; m < 4; ++m)
#pragma unroll
                for (int n = 0; n < 2; ++n) acc[a][b][m][n] = (f32x4){0.f, 0.f, 0.f, 0.f};
    bf16x8 At[4][2], B0[2][2], B1[2][2];
    const int nt = K / G_BK;
    asm volatile("s_waitcnt vmcnt(0) lgkmcnt(0)" ::: "memory");
    __syncthreads();
    if (!pre) {
        STAGE(SB(0, 0), Bt, bcol, 0); STAGE(SA(0, 0), A, brow, 0);
        STAGE(SB(0, 1), Bt, bcol + HALF, 0); STAGE(SA(0, 1), A, brow + HALF, 0);
    }
    if (wr == 1) BAR;
    WAIT_V(4); BAR;
    STAGE(SB(1, 0), Bt, bcol, 1); STAGE(SA(1, 0), A, brow, 1); STAGE(SB(1, 1), Bt, bcol + HALF, 1);
    WAIT_V(6); BAR;
    for (int t = 0; t < nt - 2; t += 2) {
        LDB(B0, 0, 0); SCHED; LDA(At, 0, 0); STAGE(SA(1, 1), A, brow + HALF, t + 1);
        WAIT_L(8); BAR; WAIT_L(0); MMA(0, 0, At, B0); BAR; SCHED;
        LDB(B1, 0, 1); STAGE(SB(0, 0), Bt, bcol, t + 2);
        BAR; WAIT_L(0); MMA(0, 1, At, B1); BAR;
        LDA(At, 0, 1); STAGE(SA(0, 0), A, brow, t + 2);
        BAR; WAIT_L(0); MMA(1, 0, At, B0); BAR; SCHED;
        STAGE(SB(0, 1), Bt, bcol + HALF, t + 2);
        WAIT_V(6); BAR; MMA(1, 1, At, B1); BAR;
        LDB(B0, 1, 0); SCHED; LDA(At, 1, 0); STAGE(SA(0, 1), A, brow + HALF, t + 2);
        WAIT_L(8); BAR; WAIT_L(0); MMA(0, 0, At, B0); BAR; SCHED;
        LDB(B1, 1, 1); STAGE(SB(1, 0), Bt, bcol, t + 3);
        BAR; WAIT_L(0); MMA(0, 1, At, B1); BAR;
        LDA(At, 1, 1); STAGE(SA(1, 0), A, brow, t + 3);
        BAR; WAIT_L(0); MMA(1, 0, At, B0); BAR; SCHED;
        STAGE(SB(1, 1), Bt, bcol + HALF, t + 3);
        WAIT_V(6); BAR; MMA(1, 1, At, B1); BAR;
    }
    { LDB(B0, 0, 0); LDA(At, 0, 0); STAGE(SA(1, 1), A, brow + HALF, nt - 1);
      BAR; WAIT_L(0); MMA(0, 0, At, B0); BAR;
      LDB(B1, 0, 1); BAR; WAIT_L(0); MMA(0, 1, At, B1); BAR;
      LDA(At, 0, 1); WAIT_V(4); BAR; WAIT_L(0); MMA(1, 0, At, B0); MMA(1, 1, At, B1); BAR; }
    { LDB(B0, 1, 0); LDA(At, 1, 0); WAIT_V(2); BAR; WAIT_L(0); MMA(0, 0, At, B0); BAR;
      LDB(B1, 1, 1); WAIT_V(0); BAR; WAIT_L(0); MMA(0, 1, At, B1); BAR;
      LDA(At, 1, 1); BAR; WAIT_L(0); MMA(1, 0, At, B0); MMA(1, 1, At, B1); BAR; }
    if (wr == 0) BAR;
    if (nrow >= 0) {
        STAGE(SB(0, 0), Bt, ncol, 0); STAGE(SA(0, 0), A, nrow, 0);
        STAGE(SB(0, 1), Bt, ncol + HALF, 0); STAGE(SA(0, 1), A, nrow + HALF, 0);
    }
    epi(acc, brow, bcol, wr, wc, fr, fq);
#undef SA
#undef SB
#undef STAGE
#undef LDA
#undef LDB
#undef MMA
}

__device__ __forceinline__ bool gemm_tile_coord(int i, int G, int c, int nM, int nN, int& pm, int& pn) {
    const int nwg = nM * nN; const long L = (long)i * G + c; if (L >= nwg) return false;
    int wgid = (int)L; { const int q = nwg / 8, r = nwg % 8, xcd = wgid % 8, off = wgid / 8; wgid = (xcd < r ? xcd * (q + 1) : r * (q + 1) + (xcd - r) * q) + off; }
    const int nig = 8 * nN, gid = wgid / nig, fm = gid * 8, gsz = (nM - fm) < 8 ? (nM - fm) : 8;
    pm = fm + ((wgid % nig) % gsz); pn = (wgid % nig) / gsz; return true;
}
template <class Epi>
__device__ __forceinline__ void gemm_phase(const bf16_t* A, const bf16_t* Bt, int K, int nM, int nN, char* lds, const Epi& epi, const int coff = 0) {
    const int G = gridDim.x, c = (BIDX() + G - coff) % G;
    int pm, pn; bool have = gemm_tile_coord(0, G, c, nM, nN, pm, pn), pre = false;
    for (int i = 0; have; ++i) {
        int qm = 0, qn = 0; const bool nxt = gemm_tile_coord(i + 1, G, c, nM, nN, qm, qn);
        gemm256_tile(A, Bt, K, pm * 256, pn * 256, pre, (Epi::PRESTAGE && nxt) ? qm * 256 : -1, qn * 256, lds, epi);
        pre = Epi::PRESTAGE && nxt; have = nxt; pm = qm; pn = qn;
    }
}

#define EPI_ARGS f32x4 (&acc)[2][2][4][2], int brow, int bcol, int wr, int wc, int fr, int fq
#define EPI_LOOP _Pragma("unroll") for (int ai = 0; ai < 2; ++ai) _Pragma("unroll") for (int bj = 0; bj < 2; ++bj) _Pragma("unroll") for (int m = 0; m < 4; ++m) _Pragma("unroll") for (int n = 0; n < 2; ++n)
#define EPI_ROW (brow + 128 * ai + 64 * wr + 16 * m + fr)
#define EPI_COL (bcol + 128 * bj + 32 * wc + 16 * n + 4 * fq)

struct EpiBf16 {
    static constexpr bool PRESTAGE = true;
    bf16_t* C; int ldc;
    __device__ __forceinline__ void operator()(EPI_ARGS) const {
        EPI_LOOP { const f32x4 v = acc[ai][bj][m][n]; *(uint2*)(C + (size_t)EPI_ROW * ldc + EPI_COL) = make_uint2(pk2(v[0], v[1]), pk2(v[2], v[3])); }
    }
};
struct EpiMemKV {
    static constexpr bool PRESTAGE = false;
    float* outk; float* outv; bf16_t* mk; bf16_t* mvt;
    __device__ __forceinline__ void operator()(EPI_ARGS) const {
        EPI_LOOP {
            const int row = EPI_ROW, col = EPI_COL; const f32x4 v = acc[ai][bj][m][n];
            if (bcol == 0) { *(f32x4*)(outk + (size_t)row * 256 + col) = v; *(uint2*)(mk + (size_t)row * 256 + col) = make_uint2(pk2(v[0], v[1]), pk2(v[2], v[3])); }
            else { const int c = col - 256, b = row >> 8, mm = row & 255; *(f32x4*)(outv + (size_t)row * 256 + c) = v;
#pragma unroll
                for (int q = 0; q < 4; ++q) mvt[(size_t)((b * 4 + (c >> 6)) * 64 + (c & 63) + q) * 256 + mm] = f2bf(v[q]); }
        }
    }
};
struct EpiResid {
    static constexpr bool PRESTAGE = false;
    const bf16_t* X; bf16_t* Zb;
    __device__ __forceinline__ void operator()(EPI_ARGS) const {
#pragma unroll
        for (int ai = 0; ai < 2; ++ai)
#pragma unroll
            for (int bj = 0; bj < 2; ++bj) {
#pragma unroll
                for (int m = 0; m < 4; ++m)
#pragma unroll
                    for (int n = 0; n < 2; ++n) { const unsigned o = (unsigned)EPI_ROW * 1024u + (unsigned)EPI_COL; const uint2 x = *(const uint2*)(X + o); const f32x4 v = acc[ai][bj][m][n];
                        *(uint2*)(Zb + o) = make_uint2(pk2(ALPHA * bflo(x.x) + v[0], ALPHA * bfhi(x.x) + v[1]), pk2(ALPHA * bflo(x.y) + v[2], ALPHA * bfhi(x.y) + v[3])); }
                __builtin_amdgcn_sched_barrier(0);
            }
    }
};
struct EpiGU {
    static constexpr bool PRESTAGE = false;
    bf16_t* ACT;
    __device__ __forceinline__ void operator()(EPI_ARGS) const {
#pragma unroll
        for (int ai = 0; ai < 2; ++ai)
#pragma unroll
            for (int bj = 0; bj < 2; ++bj)
#pragma unroll
                for (int m = 0; m < 4; ++m) {
                    const int row = brow + 128 * ai + 64 * wr + 16 * m + fr, ocol = (bcol >> 1) + 64 * bj + 16 * wc + 4 * fq;
                    const f32x4 gt = acc[ai][bj][m][0], up = acc[ai][bj][m][1];
                    *(uint2*)(ACT + (size_t)row * DFF + ocol) = make_uint2(pk2(silu(gt[0]) * up[0], silu(gt[1]) * up[1]), pk2(silu(gt[2]) * up[2], silu(gt[3]) * up[3]));
                    __builtin_amdgcn_sched_barrier(0);
                }
    }
};
struct EpiProj1 {
    static constexpr bool PRESTAGE = false;
    bf16_t* QM; bf16_t* KBP; bf16_t* KBS; bf16_t* VTP; bf16_t* VTS; float* out; const float2* ropeD;
    __device__ __forceinline__ void operator()(EPI_ARGS) const {
        EPI_LOOP {
            const int row = EPI_ROW, col = EPI_COL;
            f32x4 v = acc[ai][bj][m][n];
            const int region = col < 768 ? 0 : (col < 1536 ? 1 : (col < 2304 ? 2 : 3));
            if (region <= 1) {
                const bool rot = ((wc & 1) == 0) && (n == 0);
                if (rot) {
                    f32x4 pr; pr[0] = __shfl_xor(v[0], 32); pr[1] = __shfl_xor(v[1], 32); pr[2] = __shfl_xor(v[2], 32); pr[3] = __shfl_xor(v[3], 32);
                    const int pos = row < TP ? (row & 4095) : 1024 + ((row - TP) & 63);
                    const float4* cs = (const float4*)(ropeD + pos * 8 + 4 * (fq & 1));
                    const float4 c01 = cs[0], c23 = cs[1];
                    const float cc[4] = {c01.x, c01.z, c23.x, c23.z}, sn[4] = {c01.y, c01.w, c23.y, c23.w};
#pragma unroll
                    for (int q = 0; q < 4; ++q) v[q] = fq < 2 ? v[q] * cc[q] - pr[q] * sn[q] : pr[q] * sn[q] + v[q] * cc[q];
                }
                const uint2 pk = make_uint2(pk2(v[0], v[1]), pk2(v[2], v[3]));
                if (region == 0) *(uint2*)(QM + (size_t)row * 1024 + col) = pk;
                else {
                    const int kc = col - 768;
                    if (row < TP) { *(uint2*)(KBP + (size_t)row * 768 + kc) = pk; *(f32x4*)(out + O_DKP + (size_t)row * 768 + kc) = v; }
                    else { const int rs = row - TP, b = rs >> 6, s = rs & 63; *(uint2*)(KBS + (size_t)(b * 1088 + 1024 + s) * 768 + kc) = pk; *(f32x4*)(out + O_DKS + (size_t)rs * 768 + kc) = v; }
                }
            } else if (region == 2) {
                const int vc = col - 1536, h = vc >> 7, dim = vc & 127;
                if (row < TP) {
                    const int b = row >> 12, s = row & 4095;
                    *(f32x4*)(out + O_DVP + (size_t)row * 768 + vc) = v;
#pragma unroll
                    for (int q = 0; q < 4; ++q) VTP[((size_t)(b * 6 + h) * 128 + dim + q) * 4096 + s] = f2bf(v[q]);
                } else {
                    const int rs = row - TP, b = rs >> 6, s = rs & 63;
                    *(f32x4*)(out + O_DVS + (size_t)rs * 768 + vc) = v;
#pragma unroll
                    for (int q = 0; q < 4; ++q) VTS[((size_t)(b * 6 + h) * 128 + dim + q) * 1088 + 1024 + s] = f2bf(v[q]);
                }
            } else {
                *(uint2*)(QM + (size_t)row * 1024 + 768 + (col - 2304)) = make_uint2(pk2(v[0], v[1]), pk2(v[2], v[3]));
            }
        }
    }
};

__device__ __forceinline__ void transpose_tile(const float* __restrict__ src, int lds_, bf16_t* __restrict__ dst, int ldd, int k0, int n0, int mode, int which, float* tile, int tid) {
#pragma unroll
    for (int i = 0; i < 4; ++i) {
        const int k = (tid >> 4) + 16 * i, n4 = (tid & 15) * 4;
        const float4 v = *(const float4*)(src + (size_t)(k0 + k) * lds_ + n0 + n4);
        float* t = tile + k * 65 + n4; t[0] = v.x; t[1] = v.y; t[2] = v.z; t[3] = v.w;
    }
    __syncthreads();
    const int n = tid >> 2, kq = (tid & 3) * 16;
    uint32_t w[8];
#pragma unroll
    for (int q = 0; q < 8; ++q) w[q] = pk2(tile[(kq + 2 * q) * 65 + n], tile[(kq + 2 * q + 1) * 65 + n]);
    const int c = n0 + n;
    const int row = mode == 0 ? c : (256 * (c >> 7) + 128 * ((c >> 6) & 1) + 32 * ((c >> 4) & 3) + 16 * which + (c & 15));
    uint4* d = (uint4*)(dst + (size_t)row * ldd + k0 + kq);
    d[0] = make_uint4(w[0], w[1], w[2], w[3]); d[1] = make_uint4(w[4], w[5], w[6], w[7]);
    __syncthreads();
}

__device__ __forceinline__ void phase_prep(const Params& p, char* lds) {
    char* ws = p.ws;
    const int nb = gridDim.x, bid = BIDX(), tid = TIDX(), half = tid >> 8, tl = tid & 255;
    float* tile = (float*)lds + half * 4224;
    constexpr int T0 = 832, T1 = T0 + 640, T2 = T1 + 256, T3 = T2 + 512, T4 = T3 + 1408, T5 = T4 + 1408, T6 = T5 + 1408;
    for (int it2 = bid; it2 < T6 / 2; it2 += nb) {
        const int it = 2 * it2 + half;
        if (it < T0) { const int kt = it / 52, nt = it % 52; transpose_tile(p.in[8], NRET, (bf16_t*)(ws + W_WRET), 1024, kt * 64, nt * 64, 0, 0, tile, tl); }
        else if (it < T1) { const int r = it - T0, kt = r / 40, nt = r % 40; transpose_tile(p.in[10], NDIFF, (bf16_t*)(ws + W_WDIFF), 1024, kt * 64, nt * 64, 0, 0, tile, tl); }
        else if (it < T2) { const int r = it - T1, l = r >> 7, q = r & 127, kt = q >> 3, nt = q & 7; transpose_tile(p.in[16] + (size_t)l * 1024 * 512, 512, (bf16_t*)(ws + W_WMKV) + (size_t)l * 512 * 1024, 1024, kt * 64, nt * 64, 0, 0, tile, tl); }
        else if (it < T3) { const int r = it - T2, l = r >> 8, q = r & 255, kt = q >> 4, nt = q & 15; transpose_tile(p.in[17] + (size_t)l * 1024 * 1024, 1024, (bf16_t*)(ws + W_WO) + (size_t)l * 1024 * 1024, 1024, kt * 64, nt * 64, 0, 0, tile, tl); }
        else if (it < T5) { const int wh = it >= T4; const int r = it - (wh ? T4 : T3), l = r / 704, q = r % 704, kt = q / 44, nt = q % 44;
            transpose_tile(p.in[wh ? 21 : 20] + (size_t)l * 1024 * DFF, DFF, (bf16_t*)(ws + W_WGU) + (size_t)l * 5632 * 1024, 1024, kt * 64, nt * 64, 1, wh, tile, tl); }
        else { const int r = it - T5, l = r / 704, q = r % 704, kt = q >> 4, nt = q & 15; transpose_tile(p.in[22] + (size_t)l * DFF * 1024, 1024, (bf16_t*)(ws + W_WD) + (size_t)l * 1024 * DFF, DFF, kt * 64, nt * 64, 0, 0, tile, tl); }
    }
    const size_t gt = (size_t)bid * NTHR + tid, gs = (size_t)nb * NTHR;
    { uint2* dst = (uint2*)(ws + W_XB); const float4* xp = (const float4*)p.in[0]; const float4* xs = (const float4*)p.in[1];
      const size_t n4 = (size_t)TT * 256, np4 = (size_t)TP * 256;
      for (size_t i = gt; i < n4; i += gs) { const float4 v = i < np4 ? xp[i] : xs[i - np4]; dst[i] = make_uint2(pk2(v.x, v.y), pk2(v.z, v.w)); } }
    { uint2* dst = (uint2*)(ws + W_MB); const float4* s = (const float4*)p.in[2];
      for (size_t i = gt; i < 2048ull * 256; i += gs) { const float4 v = s[i]; dst[i] = make_uint2(pk2(v.x, v.y), pk2(v.z, v.w)); } }
    { uint2* dst = (uint2*)(ws + W_MK); const float4* s = (const float4*)p.in[6];
      for (size_t i = gt; i < 2ull * 16 * 16384; i += gs) { const size_t l = i / (16 * 16384), rem = i - l * 16 * 16384; const float4 v = s[i]; dst[(l * 24 + 8) * 16384 + rem] = make_uint2(pk2(v.x, v.y), pk2(v.z, v.w)); } }
    { bf16_t* dst = (bf16_t*)(ws + W_MVT); const float* s = p.in[7];
      for (size_t i = gt; i < 2ull * 16 * 65536; i += gs) {
          const int m = i & 255, dim = (i >> 8) & 63, h = (i >> 14) & 3, b = (i >> 16) & 15, l = (int)(i >> 20);
          dst[((size_t)((l * 24 + 8 + b) * 4 + h) * 64 + dim) * 256 + m] = f2bf(s[((size_t)(l * 16 + b) * 256 + m) * 256 + h * 64 + dim]); } }
    { float2* rr = (float2*)(ws + W_ROPER); float2* rd = (float2*)(ws + W_ROPED);
      for (size_t i = gt; i < 4096ull * 64; i += gs) { const int pos = (int)(i >> 6), f = (int)(i & 63); const float inv = expf(-logf(10000.f) * (float)f * 2.0f / 128.f); float sn, cs; sincosf((float)pos * inv, &sn, &cs); rr[i] = make_float2(cs, sn); }
      for (size_t i = gt; i < 4096ull * 8; i += gs) { const int pos = (int)(i >> 3), f = (int)(i & 7); const float inv = expf(-logf(500000.f) * (float)f * 2.0f / 16.f); float sn, cs; sincosf((float)pos * inv, &sn, &cs); rd[i] = make_float2(cs, sn); } }
    if (bid == 0 && tid < 64) ((int*)(ws + W_CTRL))[tid] = 0;
}

__device__ __forceinline__ void ret_chain(const Params& p, int h, int sl, int nsteps, int rowbase, int posbase, const float* init, bf16_t* rs, float* fin, char* lds) {
    const int tid = TIDX(), lane = tid & 63, w = tid >> 6, g = lane >> 4, lc = lane & 15;
    const float log_g = logf(1.f - exp2f(-5.f - (float)h));
    const float gch = expf(64.f * log_g);
    const float kscale = 0.08838834764831845f;
    const bf16_t* proj = (const bf16_t*)(p.ws + W_RA);
    const float2* ropeR = (const float2*)(p.ws + W_ROPER);
    f32x4 acc[2];
#pragma unroll
    for (int jj = 0; jj < 2; ++jj)
#pragma unroll
        for (int r = 0; r < 4; ++r) { const int d = 16 * w + 4 * g + r, e = sl * 32 + 16 * jj + lc; acc[jj][r] = init ? init[d * 128 + e] : 0.f; }
    const float zeta = expf((float)(63 - (tid >> 3)) * log_g) * kscale;
    uint4 ka0, kb0, vv0, ka1, kb1, vv1, ka2, kb2, vv2, ka3, kb3, vv3;
    float4 ca0[4], ca1[4], ca2[4], ca3[4];
    const int kj = tid >> 3, kdg = tid & 7, vj = (tid >> 2) & 63, veg = tid & 3;
#define RC_LOAD(c_, K1, K2, VV, CS) do { const bf16_t* s_ = proj + (size_t)(rowbase + (c_) * 64 + kj) * NRET + 768 + h * 128 + kdg * 8; K1 = *(const uint4*)s_; K2 = *(const uint4*)(s_ + 64); \
        { const float4* cs_ = (const float4*)(ropeR + (size_t)(posbase + (c_) * 64 + kj) * 64 + kdg * 8); CS[0] = cs_[0]; CS[1] = cs_[1]; CS[2] = cs_[2]; CS[3] = cs_[3]; } \
        VV = *(const uint4*)(proj + (size_t)(rowbase + (c_) * 64 + vj) * NRET + 1536 + h * 128 + sl * 32 + veg * 8); } while (0)
#define RC_STEP(c_, K1, K2, VV, CS) if ((c_) < nsteps) { const int c = (c_); \
        bf16_t* Kt = (bf16_t*)(lds + (c & 1) * 18432); \
        bf16_t* Vt = (bf16_t*)(lds + 36864 + (c & 1) * 4608); \
        { \
            float x1[8], x2[8]; unpack8(K1, x1); unpack8(K2, x2); \
            _Pragma("unroll") for (int e2 = 0; e2 < 4; ++e2) { \
                const float4 t = CS[e2]; \
                { const float a = x1[2 * e2], b = x2[2 * e2]; Kt[(kdg * 8 + 2 * e2) * 72 + kj] = f2bf((a * t.x - b * t.y) * zeta); Kt[(64 + kdg * 8 + 2 * e2) * 72 + kj] = f2bf((a * t.y + b * t.x) * zeta); } \
                { const float a = x1[2 * e2 + 1], b = x2[2 * e2 + 1]; Kt[(kdg * 8 + 2 * e2 + 1) * 72 + kj] = f2bf((a * t.z - b * t.w) * zeta); Kt[(64 + kdg * 8 + 2 * e2 + 1) * 72 + kj] = f2bf((a * t.w + b * t.z) * zeta); } \
            } \
        } \
        if (tid < 256) { const uint32_t u[4] = {VV.x, VV.y, VV.z, VV.w}; \
          _Pragma("unroll") for (int e2 = 0; e2 < 4; ++e2) { Vt[(veg * 8 + 2 * e2) * 72 + vj] = (bf16_t)(u[e2] & 0xffff); Vt[(veg * 8 + 2 * e2 + 1) * 72 + vj] = (bf16_t)(u[e2] >> 16); } } \
        if (c + 4 < nsteps) RC_LOAD(c + 4, K1, K2, VV, CS); \
        __syncthreads(); \
        bf16_t* rsc = rs + (size_t)c * 16384; \
        _Pragma("unroll") for (int jj = 0; jj < 2; ++jj) { \
            const int d = 16 * w + 4 * g, e = sl * 32 + 16 * jj + lc; \
            *(uint2*)(rsc + e * 128 + d) = make_uint2(pk2(acc[jj][0], acc[jj][1]), pk2(acc[jj][2], acc[jj][3])); \
            acc[jj] = acc[jj] * gch; \
        } \
        _Pragma("unroll") for (int s = 0; s < 2; ++s) { \
            const bf16x8 a = ld8(Kt + (16 * w + lc) * 72 + 32 * s + 8 * g); \
            _Pragma("unroll") for (int jj = 0; jj < 2; ++jj) acc[jj] = MFMA16(a, ld8(Vt + (16 * jj + lc) * 72 + 32 * s + 8 * g), acc[jj]); \
        } \
    }
    RC_LOAD(0, ka0, kb0, vv0, ca0);
    if (1 < nsteps) RC_LOAD(1, ka1, kb1, vv1, ca1);
    if (2 < nsteps) RC_LOAD(2, ka2, kb2, vv2, ca2);
    if (3 < nsteps) RC_LOAD(3, ka3, kb3, vv3, ca3);
    for (int c4 = 0; c4 < nsteps; c4 += 4) {
        RC_STEP(c4, ka0, kb0, vv0, ca0)
        RC_STEP(c4 + 1, ka1, kb1, vv1, ca1)
        RC_STEP(c4 + 2, ka2, kb2, vv2, ca2)
        RC_STEP(c4 + 3, ka3, kb3, vv3, ca3)
    }
#pragma unroll
    for (int jj = 0; jj < 2; ++jj)
#pragma unroll
        for (int r = 0; r < 4; ++r) { const int d = 16 * w + 4 * g + r, e = sl * 32 + 16 * jj + lc; fin[d * 128 + e] = acc[jj][r]; }
    __syncthreads();
#undef RC_LOAD
#undef RC_STEP
}
__device__ __forceinline__ void ret_out(const Params& p, int u2, char* lds_) {
    const int tid_ = TIDX(), half = tid_ >> 8, tid = tid_ & 255, lane = tid & 63, w = tid >> 6, g = lane >> 4, lc = lane & 15;
    const int u = 2 * u2 + half; char* lds = lds_ + half * 53248;
    int b, h, rowbase, pos0;
    if (u < 3072) { const int chain = u >> 6, c = u & 63; b = chain / 6; h = chain % 6; rowbase = b * 4096 + c * 64; pos0 = c * 64; }
    else { const int cs = u - 3072; b = cs / 6; h = cs % 6; rowbase = TP + b * 64; pos0 = 1024; }
    const float log_g = logf(1.f - exp2f(-5.f - (float)h));
    const float log2g = log_g * 1.44269504089f;
    const float kscale = 0.08838834764831845f;
    const bf16_t* proj = (const bf16_t*)(p.ws + W_RA);
    const float2* ropeR = (const float2*)(p.ws + W_ROPER);
    const bf16_t* rsu = (const bf16_t*)(p.out + O_DKP) + (size_t)u * 16384;
    bf16_t* H = (bf16_t*)(p.ws + W_H);
    bf16_t* Qs = (bf16_t*)lds; bf16_t* Ks = (bf16_t*)(lds + 17408); bf16_t* Vt = (bf16_t*)(lds + 34816);
#pragma unroll
    for (int q = 0; q < 2; ++q) {
        const int it = tid + 256 * q, j = it >> 3, dg = it & 7;
        const bf16_t* s = proj + (size_t)(rowbase + j) * NRET + h * 128 + dg * 8;
        const uint4 q1 = *(const uint4*)s, q2 = *(const uint4*)(s + 64), kk1 = *(const uint4*)(s + 768), kk2 = *(const uint4*)(s + 768 + 64);
        const float4* cs = (const float4*)(ropeR + (size_t)(pos0 + j) * 64 + dg * 8);
        float a1[8], a2[8], b1[8], b2[8]; unpack8(q1, a1); unpack8(q2, a2); unpack8(kk1, b1); unpack8(kk2, b2);
        float qo1[8], qo2[8], ko1[8], ko2[8];
#pragma unroll
        for (int e2 = 0; e2 < 4; ++e2) {
            const float4 t = cs[e2];
            qo1[2 * e2] = a1[2 * e2] * t.x - a2[2 * e2] * t.y; qo2[2 * e2] = a1[2 * e2] * t.y + a2[2 * e2] * t.x;
            qo1[2 * e2 + 1] = a1[2 * e2 + 1] * t.z - a2[2 * e2 + 1] * t.w; qo2[2 * e2 + 1] = a1[2 * e2 + 1] * t.w + a2[2 * e2 + 1] * t.z;
            ko1[2 * e2] = (b1[2 * e2] * t.x - b2[2 * e2] * t.y) * kscale; ko2[2 * e2] = (b1[2 * e2] * t.y + b2[2 * e2] * t.x) * kscale;
            ko1[2 * e2 + 1] = (b1[2 * e2 + 1] * t.z - b2[2 * e2 + 1] * t.w) * kscale; ko2[2 * e2 + 1] = (b1[2 * e2 + 1] * t.w + b2[2 * e2 + 1] * t.z) * kscale;
        }
        *(uint4*)(Qs + j * 136 + dg * 8) = make_uint4(pk2(qo1[0], qo1[1]), pk2(qo1[2], qo1[3]), pk2(qo1[4], qo1[5]), pk2(qo1[6], qo1[7]));
        *(uint4*)(Qs + j * 136 + 64 + dg * 8) = make_uint4(pk2(qo2[0], qo2[1]), pk2(qo2[2], qo2[3]), pk2(qo2[4], qo2[5]), pk2(qo2[6], qo2[7]));
        *(uint4*)(Ks + j * 136 + dg * 8) = make_uint4(pk2(ko1[0], ko1[1]), pk2(ko1[2], ko1[3]), pk2(ko1[4], ko1[5]), pk2(ko1[6], ko1[7]));
        *(uint4*)(Ks + j * 136 + 64 + dg * 8) = make_uint4(pk2(ko2[0], ko2[1]), pk2(ko2[2], ko2[3]), pk2(ko2[4], ko2[5]), pk2(ko2[6], ko2[7]));
    }
#pragma unroll
    for (int q = 0; q < 4; ++q) {
        const int it = tid + 256 * q, j = it >> 4, eg = it & 15;
        const uint4 v = *(const uint4*)(proj + (size_t)(rowbase + j) * NRET + 1536 + h * 128 + eg * 8);
        const uint32_t uu[4] = {v.x, v.y, v.z, v.w};
#pragma unroll
        for (int e2 = 0; e2 < 4; ++e2) { Vt[(eg * 8 + 2 * e2) * 72 + j] = (bf16_t)(uu[e2] & 0xffff); Vt[(eg * 8 + 2 * e2 + 1) * 72 + j] = (bf16_t)(uu[e2] >> 16); }
    }
    __syncthreads();
    bf16x8 qf[4];
#pragma unroll
    for (int s = 0; s < 4; ++s) qf[s] = ld8(Qs + (16 * w + lc) * 136 + 32 * s + 8 * g);
    f32x4 st[4];
#pragma unroll
    for (int t = 0; t < 4; ++t) {
        st[t] = (f32x4){0.f, 0.f, 0.f, 0.f};
#pragma unroll
        for (int s = 0; s < 4; ++s) st[t] = MFMA16(ld8(Ks + (16 * t + lc) * 136 + 32 * s + 8 * g), qf[s], st[t]);
    }
    const int ii = 16 * w + lc;
#pragma unroll
    for (int t = 0; t < 4; ++t)
#pragma unroll
        for (int r = 0; r < 4; ++r) { const int j = 16 * t + 4 * g + r; st[t][r] *= exp2f(fabsf((float)(ii - j)) * log2g); }
    f32x4 o[8], oc[8];
#pragma unroll
    for (int et = 0; et < 8; ++et) { o[et] = (f32x4){0.f, 0.f, 0.f, 0.f}; oc[et] = (f32x4){0.f, 0.f, 0.f, 0.f}; }
#pragma unroll
    for (int s = 0; s < 2; ++s) {
        const bf16x8 pb = pack8(st[2 * s], st[2 * s + 1]);
#pragma unroll
        for (int et = 0; et < 8; ++et) { const bf16_t* vr = Vt + (16 * et + lc) * 72 + 32 * s + 4 * g; o[et] = MFMA16(ld44(vr, vr + 16), pb, o[et]); }
    }
#pragma unroll
    for (int et = 0; et < 8; ++et)
#pragma unroll
        for (int s = 0; s < 4; ++s) oc[et] = MFMA16(ld8(rsu + (16 * et + lc) * 128 + 32 * s + 8 * g), qf[s], oc[et]);
    const float xi = exp2f((float)(ii + 1) * log2g);
    float sum = 0.f;
#pragma unroll
    for (int et = 0; et < 8; ++et)
#pragma unroll
        for (int r = 0; r < 4; ++r) { o[et][r] += xi * oc[et][r]; sum += o[et][r]; }
    const float mean = xr16_32_sum(sum) * (1.f / 128.f);
    float sq = 0.f;
#pragma unroll
    for (int et = 0; et < 8; ++et)
#pragma unroll
        for (int r = 0; r < 4; ++r) { const float dd = o[et][r] - mean; sq += dd * dd; }
    const float rstd = rsqrtf(xr16_32_sum(sq) * (1.f / 128.f) + 1e-5f);
    const size_t row = (size_t)rowbase + ii;
    const float* gn = p.in[9] + h * 128;
#pragma unroll
    for (int et = 0; et < 8; ++et) {
        const int e = 16 * et + 4 * g;
        const uint2 gt = *(const uint2*)(proj + row * NRET + 2304 + h * 128 + e);
        const float4 gg = *(const float4*)(gn + e);
        const float y0 = (o[et][0] - mean) * rstd * gg.x * silu(bflo(gt.x)), y1 = (o[et][1] - mean) * rstd * gg.y * silu(bfhi(gt.x));
        const float y2 = (o[et][2] - mean) * rstd * gg.z * silu(bflo(gt.y)), y3 = (o[et][3] - mean) * rstd * gg.w * silu(bfhi(gt.y));
        *(uint2*)(H + row * 1024 + h * 128 + e) = make_uint2(pk2(y0, y1), pk2(y2, y3));
    }
    __syncthreads();
}

__device__ __forceinline__ void glds16_asm(const void* gsrc, unsigned lds_dst) {
    unsigned keep;
    asm volatile("s_mov_b32 %0, m0\n\ts_mov_b32 m0, %2\n\ts_nop 0\n\tglobal_load_lds_dwordx4 %1, off\n\ts_mov_b32 m0, %0" : "=&s"(keep) : "v"(gsrc), "s"(lds_dst) : "memory");
}
__device__ __forceinline__ void mem_attn(const Params& p, int unit, int layer, char* lds) {
    const int tid = TIDX(), lane = tid & 63, w = tid >> 6, g = lane >> 4, lc = lane & 15;
    const bf16_t* Q; int ldq;
    if (layer == 0) { Q = (const bf16_t*)(p.ws + W_RA) + 3072; ldq = NRET; } else { Q = (const bf16_t*)(p.ws + W_QM) + 768; ldq = 1024; }
    int bb, h, r0, npass; bool all8;
    if (unit < 256) { const int b = unit >> 5; h = (unit >> 3) & 3; bb = b; r0 = b * 4096 + (unit & 7) * 512; npass = 4; all8 = true; }
    else { const int us = unit - 256, b = us >> 2; h = us & 3; bb = 8 + b; r0 = TP + b * 64; npass = 1; all8 = false; }
    const bf16_t* mk = (const bf16_t*)(p.ws + W_MK) + (size_t)(layer * 24 + bb) * 65536 + h * 64;
    const bf16_t* mv = (const bf16_t*)(p.ws + W_MVT) + (size_t)((layer * 24 + bb) * 4 + h) * 16384;
    bf16_t* H = (bf16_t*)(p.ws + W_H);
    const float sc = 0.125f * 1.44269504089f;
    asm volatile("s_waitcnt vmcnt(0) lgkmcnt(0)" ::: "memory");
    __syncthreads();
    {
        const unsigned lds_w = (unsigned)__builtin_amdgcn_readfirstlane((int)(unsigned)(size_t)(LAS char*)lds + (tid & ~63) * 16);
#pragma unroll
        for (int i = 0; i < 4; ++i) {
            const int kr = (tid >> 3) + 64 * i, kc = (tid & 7) ^ ((kr >> 1) & 7);
            glds16_asm(mk + (size_t)kr * 256 + kc * 8, lds_w + i * 8192);
            const int vr = (tid >> 5) + 16 * i, vc = (tid & 31) ^ (vr & 15);
            glds16_asm(mv + (size_t)vr * 256 + vc * 8, lds_w + 32768 + i * 8192);
        }
    }
    const bf16_t* Ks = (const bf16_t*)lds; const bf16_t* Vs = (const bf16_t*)(lds + 32768);
    const bool act = all8 || w < 4;
    const size_t rowb = (size_t)r0 + 16 * (all8 ? w : (w & 3)) + lc;
    bf16x8 qf[2];
#pragma unroll
    for (int s = 0; s < 2; ++s) qf[s] = ld8(Q + rowb * ldq + h * 64 + 32 * s + 8 * g);
#pragma unroll
    for (int s = 0; s < 2; ++s) asm volatile("" : "+v"(qf[s]));
    asm volatile("s_waitcnt vmcnt(0)" ::: "memory");
    __syncthreads();
    for (int it = 0; it < npass; ++it) {
        const size_t row = rowb + (size_t)it * 128;
        bf16x8 qn[2];
        if (it + 1 < npass) {
#pragma unroll
            for (int s = 0; s < 2; ++s) qn[s] = ld8(Q + (row + 128) * ldq + h * 64 + 32 * s + 8 * g);
        }
        if (act) {
            f32x4 st[16];
            float mx = -3.0e38f;
#pragma unroll
            for (int t = 0; t < 16; ++t) {
                st[t] = (f32x4){0.f, 0.f, 0.f, 0.f};
#pragma unroll
                for (int s = 0; s < 2; ++s) st[t] = MFMA16(ld8(Ks + (16 * t + lc) * 64 + ((4 * s + g) ^ ((lc >> 1) & 7)) * 8), qf[s], st[t]);
                mx = fmaxf(mx, fmaxf(fmaxf(st[t][0], st[t][1]), fmaxf(st[t][2], st[t][3])));
            }
            mx = xr16_32_max(mx) * sc;
            float sum = 0.f;
#pragma unroll
            for (int t = 0; t < 16; ++t)
#pragma unroll
                for (int r = 0; r < 4; ++r) { st[t][r] = __builtin_amdgcn_exp2f(st[t][r] * sc - mx); sum += st[t][r]; }
            const float inv = 1.f / xr16_32_sum(sum);
            f32x4 o[4];
#pragma unroll
            for (int dt = 0; dt < 4; ++dt) o[dt] = (f32x4){0.f, 0.f, 0.f, 0.f};
#pragma unroll
            for (int s = 0; s < 8; ++s) {
                const bf16x8 pb = pack8(st[2 * s] * inv, st[2 * s + 1] * inv);
#pragma unroll
                for (int dt = 0; dt < 4; ++dt) { const bf16_t* vr = Vs + (16 * dt + lc) * 256 + (g & 1) * 4; o[dt] = MFMA16(ld44(vr + ((4 * s + (g >> 1)) ^ lc) * 8, vr + ((4 * s + (g >> 1) + 2) ^ lc) * 8), pb, o[dt]); }
            }
#pragma unroll
            for (int dt = 0; dt < 4; ++dt) *(uint2*)(H + row * 1024 + 768 + h * 64 + 16 * dt + 4 * g) = make_uint2(pk2(o[dt][0], o[dt][1]), pk2(o[dt][2], o[dt][3]));
        }
        if (it + 1 < npass) { qf[0] = qn[0]; qf[1] = qn[1]; }
    }
    __syncthreads();
}

__device__ __forceinline__ void diff_attn(const Params& p, int rowq0, int h, const bf16_t* Kp, const bf16_t* Vp, int ldv, int nkt, int nkt_lo, bool hi_active, float lam, char* lds) {
    const int tid = TIDX(), lane = tid & 63, w = tid >> 6, g = lane >> 4, lc = lane & 15;
    const bf16_t* QM = (const bf16_t*)(p.ws + W_QM);
    bf16_t* H = (bf16_t*)(p.ws + W_H);
    const size_t row = (size_t)rowq0 + 16 * (hi_active ? w : (w & 3)) + lc;
    const int my_nkt = w < 4 ? nkt_lo : (hi_active ? nkt : 0);
    const float sc = 0.125f * 1.44269504089f;
    bf16x8 qf[2][2];
#pragma unroll
    for (int c = 0; c < 2; ++c)
#pragma unroll
        for (int s = 0; s < 2; ++s) qf[c][s] = ld8(QM + row * 1024 + h * 128 + c * 64 + 32 * s + 8 * g);
    f32x4 o[2][8];
    float m[2] = {0.f, 0.f};
    f32x4 osum[2] = {(f32x4){0.f, 0.f, 0.f, 0.f}, (f32x4){0.f, 0.f, 0.f, 0.f}};
    const bf16x8 onesA = mk8(0x3F803F80u, 0x3F803F80u, 0x3F803F80u, 0x3F803F80u);
#pragma unroll
    for (int c = 0; c < 2; ++c)
#pragma unroll
        for (int dt = 0; dt < 8; ++dt) o[c][dt] = (f32x4){0.f, 0.f, 0.f, 0.f};
    const int kkey = tid >> 4, kdc = tid & 15;
    const int vdim = tid >> 3, vkc = tid & 7;
    const bf16_t* kg0 = Kp + (size_t)kkey * 768 + (kdc ^ (kkey & 15)) * 8;
    const bf16_t* vg0 = Vp + (size_t)vdim * ldv + (vkc ^ (vdim & 7)) * 8;
    const unsigned lds_w = (unsigned)__builtin_amdgcn_readfirstlane((int)(unsigned)(size_t)(LAS char*)lds + (tid & ~63) * 16);
#define DA_ISSUE(vt_) do { const int st_ = (vt_) & 3; const int tt_ = (vt_) < nkt ? (vt_) : nkt - 1; \
        const bf16_t* kg_ = kg0 + (size_t)tt_ * (64 * 768); const bf16_t* vg_ = vg0 + tt_ * 64; const unsigned dst_ = lds_w + st_ * 32768; \
        glds16_asm(kg_, dst_); glds16_asm(kg_ + 32 * 768, dst_ + 8192); glds16_asm(vg_, dst_ + 16384); glds16_asm(vg_ + (size_t)64 * ldv, dst_ + 16384 + 8192); } while (0)
#pragma unroll
    for (int c = 0; c < 2; ++c)
#pragma unroll
        for (int s = 0; s < 2; ++s) asm volatile("" : "+v"(qf[c][s]));
    asm volatile("s_waitcnt vmcnt(0) lgkmcnt(0)" ::: "memory");
    __syncthreads();
    DA_ISSUE(0); DA_ISSUE(1); DA_ISSUE(2);
    asm volatile("s_waitcnt vmcnt(8)" ::: "memory");
    __builtin_amdgcn_s_barrier();
    for (int kt = 0; kt < nkt; ++kt) {
        DA_ISSUE(kt + 3);
        if (kt < my_nkt) {
            const bf16_t* Ks = (const bf16_t*)(lds + (kt & 3) * 32768); const bf16_t* Vt = (const bf16_t*)(lds + (kt & 3) * 32768 + 16384);
            f32x4 st[2][4];
            __builtin_amdgcn_s_setprio(1);
#pragma unroll
            for (int c = 0; c < 2; ++c)
#pragma unroll
                for (int t = 0; t < 4; ++t) {
                    st[c][t] = (f32x4){0.f, 0.f, 0.f, 0.f};
#pragma unroll
                    for (int s = 0; s < 2; ++s) st[c][t] = MFMA16(ld8(Ks + (16 * t + lc) * 128 + ((c * 8 + 4 * s + g) ^ lc) * 8), qf[c][s], st[c][t]);
                }
            __builtin_amdgcn_s_setprio(0);
#pragma unroll
            for (int c = 0; c < 2; ++c) {
                const float mneg = -m[c];
#pragma unroll
                for (int t = 0; t < 4; ++t)
#pragma unroll
                    for (int r = 0; r < 4; ++r) st[c][t][r] = __builtin_fmaf(st[c][t][r], sc, mneg);
                float mx = -3.0e38f;
#pragma unroll
                for (int t = 0; t < 4; ++t) mx = fmaxf(mx, fmaxf(fmaxf(st[c][t][0], st[c][t][1]), fmaxf(st[c][t][2], st[c][t][3])));
                mx = xr16_32_max(mx);
                const bool first = kt == 0;
                if (first || __builtin_amdgcn_ballot_w64(mx > 8.f) != 0ull) {
                    const float d = first ? mx : fmaxf(mx, 0.f);
                    m[c] += d;
                    if (!first) {
                        const float al = __builtin_amdgcn_exp2f(-d);
                        osum[c] = osum[c] * al;
#pragma unroll
                        for (int dt = 0; dt < 8; ++dt) o[c][dt] = o[c][dt] * al;
                    }
#pragma unroll
                    for (int t = 0; t < 4; ++t)
#pragma unroll
                        for (int r = 0; r < 4; ++r) st[c][t][r] -= d;
                }
#pragma unroll
                for (int t = 0; t < 4; ++t)
#pragma unroll
                    for (int r = 0; r < 4; ++r) st[c][t][r] = __builtin_amdgcn_exp2f(st[c][t][r]);
            }
            __builtin_amdgcn_s_setprio(1);
#pragma unroll
            for (int s = 0; s < 2; ++s) {
                const bf16x8 pb0 = pack8(st[0][2 * s], st[0][2 * s + 1]), pb1 = pack8(st[1][2 * s], st[1][2 * s + 1]);
                osum[0] = MFMA16(onesA, pb0, osum[0]); osum[1] = MFMA16(onesA, pb1, osum[1]);
#pragma unroll
                for (int dt = 0; dt < 8; ++dt) {
                    const bf16_t* vr = Vt + (16 * dt + lc) * 64 + (g & 1) * 4;
                    const bf16x8 va = ld44(vr + ((4 * s + (g >> 1)) ^ (lc & 7)) * 8, vr + ((4 * s + (g >> 1) + 2) ^ (lc & 7)) * 8);
                    o[0][dt] = MFMA16(va, pb0, o[0][dt]); o[1][dt] = MFMA16(va, pb1, o[1][dt]);
                }
            }
            __builtin_amdgcn_s_setprio(0);
        }
        asm volatile("s_waitcnt vmcnt(8) lgkmcnt(0)" ::: "memory");
        __builtin_amdgcn_s_barrier();
    }
    asm volatile("s_waitcnt vmcnt(0)" ::: "memory");
    if (my_nkt > 0) {
        const float i0 = 1.f / osum[0][0], i1 = lam / osum[1][0];
        float sq = 0.f;
#pragma unroll
        for (int dt = 0; dt < 8; ++dt)
#pragma unroll
            for (int r = 0; r < 4; ++r) { const float v = o[0][dt][r] * i0 - o[1][dt][r] * i1; o[0][dt][r] = v; sq += v * v; }
        const float rs = rsqrtf(xr16_32_sum(sq) * (1.f / 128.f) + 1e-5f) * (1.f - LAM_INIT);
        const float* sg = p.in[15];
#pragma unroll
        for (int dt = 0; dt < 8; ++dt) {
            const int e = 16 * dt + 4 * g;
            const float4 gg = *(const float4*)(sg + e);
            *(uint2*)(H + row * 1024 + h * 128 + e) = make_uint2(pk2(o[0][dt][0] * rs * gg.x, o[0][dt][1] * rs * gg.y), pk2(o[0][dt][2] * rs * gg.z, o[0][dt][3] * rs * gg.w));
        }
    }
#undef DA_ISSUE
}

__device__ __forceinline__ void phase_ln(const Params& p, const float* gam, const float* bet, const bf16_t* Zb, bf16_t* Xd, bool fin) {
    const int lane = TIDX() & 63, w = TIDX() >> 6;
    float4 gg[4], bb[4];
#pragma unroll
    for (int i = 0; i < 4; ++i) { gg[i] = ((const float4*)gam)[lane + 64 * i]; bb[i] = ((const float4*)bet)[lane + 64 * i]; }
    for (int row = BIDX() * 8 + w; row < TT; row += gridDim.x * 8) {
        const uint2* z = (const uint2*)(Zb + (size_t)row * 1024);
        float4 v[4]; float s = 0.f;
#pragma unroll
        for (int i = 0; i < 4; ++i) { const uint2 u = z[lane + 64 * i]; v[i] = make_float4(bflo(u.x), bfhi(u.x), bflo(u.y), bfhi(u.y)); s += (v[i].x + v[i].y) + (v[i].z + v[i].w); }
        const float mean = wave_sum(s) * (1.f / 1024.f);
        float q = 0.f;
#pragma unroll
        for (int i = 0; i < 4; ++i) { v[i].x -= mean; v[i].y -= mean; v[i].z -= mean; v[i].w -= mean; q += (v[i].x * v[i].x + v[i].y * v[i].y) + (v[i].z * v[i].z + v[i].w * v[i].w); }
        const float rstd = rsqrtf(wave_sum(q) * (1.f / 1024.f) + 1e-5f);
        uint2* xd = (uint2*)(Xd + (size_t)row * 1024);
        float4* yo = (float4*)(p.out + (size_t)row * 1024);
#pragma unroll
        for (int i = 0; i < 4; ++i) {
            float4 y; y.x = v[i].x * rstd * gg[i].x + bb[i].x; y.y = v[i].y * rstd * gg[i].y + bb[i].y; y.z = v[i].z * rstd * gg[i].z + bb[i].z; y.w = v[i].w * rstd * gg[i].w + bb[i].w;
            if (fin) yo[lane + 64 * i] = y; else xd[lane + 64 * i] = make_uint2(pk2(y.x, y.y), pk2(y.z, y.w));
        }
    }
}

__device__ __forceinline__ int next_unit(int* ctr, char* lds) {
    int* slot = (int*)(lds + LDS_MAIN);
    if (TIDX() == 0) *slot = atomicAdd(ctr, 1);
    __syncthreads();
    const int u = *slot;
    __syncthreads();
    return u;
}


#define XB_TMO      128
#define XB_XCNT(j)  (256  + 64 * (j))
#define XB_XSUB(j)  (1280 + 64 * (j))
#define XB_XGEN(j)  (2304 + 64 * (j))
#define XB_TOP      3328
#define XB_TOPGEN   3392
#define XCD_BAR_WORDS 3456
#define XB_SPIN_CAP (1u << 18)
__device__ __forceinline__ unsigned xb_ld(unsigned* p)              { return __hip_atomic_load(p, __ATOMIC_RELAXED, __HIP_MEMORY_SCOPE_AGENT); }
__device__ __forceinline__ unsigned xb_add(unsigned* p, unsigned v) { return __hip_atomic_fetch_add(p, v, __ATOMIC_RELAXED, __HIP_MEMORY_SCOPE_AGENT); }
__device__ __forceinline__ unsigned xb_xcc_id() { return (unsigned)__builtin_amdgcn_s_getreg((3 << 11) | 20) & 0xFu; }
#define XB_SPIN(cond, bar) do { unsigned _sp = 0; while (cond) { __builtin_amdgcn_s_sleep(1); \
    if ((++_sp & 255u) == 0u) { if (xb_ld(&(bar)[XB_TMO])) break; if (_sp > XB_SPIN_CAP) { atomicAdd(&(bar)[XB_TMO], 1u); break; } } } } while (0)
struct XcdBarrier { unsigned* bar; unsigned x; volatile LAS unsigned* st; };
__device__ __forceinline__ XcdBarrier xcd_barrier_post(unsigned* bar, volatile LAS unsigned* st) {
    XcdBarrier b; b.bar = bar; b.x = xb_xcc_id(); b.st = st;
    if (TIDX() == 0) (void)xb_add(&bar[XB_XCNT(b.x)], 1u);
    return b;
}
__device__ __forceinline__ void xcd_barrier_complete(unsigned* bar, unsigned x, unsigned& nloc, unsigned& nx) {
    const unsigned G = gridDim.x * gridDim.y * gridDim.z;
    unsigned sum, cnt, mine, sp = 0u;
    for (;;) {
        sum = 0u; cnt = 0u; mine = 0u;
#pragma unroll
        for (unsigned j = 0; j < 16; ++j) { const unsigned c = xb_ld(&bar[XB_XCNT(j)]); sum += c; cnt += (c > 0u) ? 1u : 0u; mine = (j == x) ? c : mine; }
        if (sum == G) break;
        __builtin_amdgcn_s_sleep(1);
        if ((++sp & 255u) == 0u) { if (xb_ld(&bar[XB_TMO])) break; if (sp > XB_SPIN_CAP) { atomicAdd(&bar[XB_TMO], 1u); break; } }
    }
    nloc = mine > 0u ? mine : 1u; nx = cnt > 0u ? cnt : 1u;
}
__device__ __forceinline__ void xcd_barrier(const XcdBarrier& b) {
    asm volatile("s_waitcnt vmcnt(0)" ::: "memory");
    __syncthreads();
    if (TIDX() == 0) {
        unsigned* bar = b.bar;
        __builtin_amdgcn_s_waitcnt(0);
        unsigned nloc = b.st[0], nx = b.st[1];
        if (nloc == 0u) { xcd_barrier_complete(bar, b.x, nloc, nx); b.st[0] = nloc; b.st[1] = nx; }
        const unsigned old = xb_add(&bar[XB_XSUB(b.x)], 1u);
        const unsigned gen = old / nloc;
        if (old + 1u == (gen + 1u) * nloc) {
            __builtin_amdgcn_fence(__ATOMIC_RELEASE, "agent");
            asm volatile("s_waitcnt vmcnt(0)" ::: "memory");
            const unsigned og = xb_add(&bar[XB_TOP], 1u);
            const unsigned tg = og / nx;
            if (og + 1u == (tg + 1u) * nx) xb_add(&bar[XB_TOPGEN], 1u);
            else XB_SPIN(xb_ld(&bar[XB_TOPGEN]) == tg, bar);
            __builtin_amdgcn_fence(__ATOMIC_ACQUIRE, "agent");
            xb_add(&bar[XB_XGEN(b.x)], 1u);
            asm volatile("s_waitcnt vmcnt(0)" ::: "memory");
        } else {
            XB_SPIN(xb_ld(&bar[XB_XGEN(b.x)]) == gen, bar);
            __builtin_amdgcn_fence(__ATOMIC_ACQUIRE, "agent");
            asm volatile("s_waitcnt vmcnt(0)" ::: "memory");
        }
    }
    __syncthreads();
}

__device__ __forceinline__ void run_phase(const Params& p_, const int ph, const int l, char* lds, const int cslot = 0) {
    Params p = p_;
    asm volatile("" : "+s"(p.ws), "+s"(p.out));
    char* ws = p.ws;
    bf16_t* XB = (bf16_t*)(ws + W_XB); bf16_t* Hb = (bf16_t*)(ws + W_H); bf16_t* RA = (bf16_t*)(ws + W_RA);
    int* ctr = (int*)(ws + W_CTRL);
    switch (ph) {
    case 0: phase_prep(p, lds); break;
    case 1: {
        gemm_phase(XB, (const bf16_t*)(ws + W_WRET), 1024, TT / 256, NRET / 256, lds, EpiBf16{RA, NRET});
        for (int ll = 0; ll < 2; ++ll)
            gemm_phase((const bf16_t*)(ws + W_MB), (const bf16_t*)(ws + W_WMKV) + (size_t)ll * 512 * 1024, 1024, 8, 2, lds,
                       EpiMemKV{p.out + O_MKP + (size_t)ll * 524288, p.out + O_MVP + (size_t)ll * 524288, (bf16_t*)(ws + W_MK) + (size_t)ll * 24 * 65536, (bf16_t*)(ws + W_MVT) + (size_t)ll * 24 * 65536},
                       (1716 % 256 + 16 * ll) % (int)gridDim.x);
    } break;
    case 2: {
        bf16_t* RS = (bf16_t*)(p.out + O_DKP);
        for (;;) {
            const int u = next_unit(ctr + 0 + cslot, lds);
            if (u >= 192 + 384 + 320) break;
            if (u < 576) {
                const bool pr = u < 192; const int us = pr ? u : u - 192, chain = us >> 2, sl = us & 3, b = chain / 6, h = chain % 6;
                ret_chain(p, h, sl, pr ? 64 : 1, pr ? b * 4096 : TP + b * 64, pr ? 0 : 1024, pr ? nullptr : p.in[3] + (size_t)chain * 16384,
                          RS + (pr ? (size_t)chain * 64 : (size_t)(3072 + chain)) * 16384, p.out + (pr ? O_RSP : O_RSS) + (size_t)chain * 16384, lds);
            }
            else mem_attn(p, u - 576, 0, lds);
        }
    } break;
    case 3: for (int u2 = BIDX(); u2 < 1584; u2 += gridDim.x) ret_out(p, u2, lds); break;
    case 4: gemm_phase(Hb, (const bf16_t*)(ws + W_WO) + (size_t)l * 1024 * 1024, 1024, TT / 256, 4, lds, EpiResid{XB, RA}); break;
    case 5: phase_ln(p, p.in[18] + l * 1024, p.in[19] + l * 1024, RA, Hb, false); break;
    case 6: gemm_phase(Hb, (const bf16_t*)(ws + W_WGU) + (size_t)l * 5632 * 1024, 1024, TT / 256, 22, lds, EpiGU{RA}); break;
    case 7: gemm_phase(RA, (const bf16_t*)(ws + W_WD) + (size_t)l * 1024 * DFF, DFF, TT / 256, 4, lds, EpiResid{Hb, XB}); break;
    case 8: phase_ln(p, p.in[23] + l * 1024, p.in[24] + l * 1024, XB, XB, l == 1); break;
    case 9: {
        { uint2* dst = (uint2*)(ws + W_KBS); const float4* s = (const float4*)p.in[4];
          const int skip = (int)gridDim.x > 80 ? 40 : 0, cb = BIDX() - skip, ncb = (int)gridDim.x - skip;
          const size_t per = 1024ull * 192, gt = (size_t)cb * NTHR + TIDX(), gs = (size_t)ncb * NTHR;
          if (cb >= 0) for (size_t i = gt; i < 16 * per; i += gs) { const size_t b = i / per, rem = i - b * per; const float4 v = s[i]; dst[b * (1088ull * 192) + rem] = make_uint2(pk2(v.x, v.y), pk2(v.z, v.w)); } }
        { const int tid = TIDX(), half = tid >> 8;
          const int skip = (int)gridDim.x > 80 ? 40 : 0, cb = BIDX() - skip, ncb = (int)gridDim.x - skip;
          if (cb >= 0) for (int it2 = cb; it2 < 1536; it2 += ncb) {
              const int it = 2 * it2 + half, bh = it >> 5, q = it & 31, jt = q >> 1, dt = q & 1, b = bh / 6, h = bh % 6;
              transpose_tile(p.in[5] + (size_t)b * 1024 * 768 + h * 128, 768, (bf16_t*)(ws + W_VTS) + (size_t)bh * 128 * 1088, 1088, jt * 64, dt * 64, 0, 0, (float*)lds + half * 4224, tid & 255);
          } }
        gemm_phase(XB, (const bf16_t*)(ws + W_WDIFF), 1024, TT / 256, NDIFF / 256, lds,
                   EpiProj1{(bf16_t*)(ws + W_QM), (bf16_t*)(ws + W_KBP), (bf16_t*)(ws + W_KBS), (bf16_t*)(ws + W_VTP), (bf16_t*)(ws + W_VTS), p.out, (const float2*)(ws + W_ROPED)});
    } break;
    case 10: {
        float lam;
        { const int lane = TIDX() & 63; const float a = wave_sum(p.in[11][lane] * p.in[12][lane]), b = wave_sum(p.in[13][lane] * p.in[14][lane]); lam = expf(a) - expf(b) + LAM_INIT; }
        for (;;) {
            const int u = next_unit(ctr + 1 + cslot, lds);
            if (u >= 1536 + 96 + 320) break;
            if (u < 1632) {
                const bool pr = u >= 96; const int up = u - 96, qp = 31 - up / 48, bh = pr ? up % 48 : u, b = bh / 6, h = bh % 6;
                diff_attn(p, pr ? b * 4096 + qp * 128 : TP + b * 64, h,
                          pr ? (const bf16_t*)(ws + W_KBP) + (size_t)b * 4096 * 768 + h * 128 : (const bf16_t*)(ws + W_KBS) + (size_t)b * 1088 * 768 + h * 128,
                          pr ? (const bf16_t*)(ws + W_VTP) + (size_t)bh * 128 * 4096 : (const bf16_t*)(ws + W_VTS) + (size_t)bh * 128 * 1088,
                          pr ? 4096 : 1088, pr ? 2 * qp + 2 : 17, pr ? 2 * qp + 1 : 17, pr, lam, lds);
            }
            else mem_attn(p, u - 1632, 1, lds);
        }
    } break;
    default: break;
    }
}

#ifndef PROBE_PH
#define PROBE_PH -1
#endif
extern "C" __global__ void __launch_bounds__(512, 2) mega_fwd(Params p) {
    extern __shared__ __attribute__((aligned(16))) char lds[];
    cg::grid_group grid = cg::this_grid();
    volatile LAS unsigned* xst = (volatile LAS unsigned*)(lds + LDS_MAIN + 16);
    if (TIDX() == 0) { xst[0] = 0u; xst[1] = 0u; }
    __syncthreads();
    (void)xcd_barrier_post((unsigned*)(p.ws + W_CTRL), xst);
#define XBAR() do { XcdBarrier xb_; xb_.bar = (unsigned*)(p.ws + W_CTRL); xb_.x = xb_xcc_id(); xb_.st = (volatile LAS unsigned*)(lds + LDS_MAIN + 16); xcd_barrier(xb_); } while (0)
    run_phase(p, 0, 0, lds);
    if (p.ph_lo != 0) grid.sync();
    XBAR();
#if PROBE_PH == 0
    run_phase(p, 0, 0, lds); XBAR();
#endif
    run_phase(p, 1, 0, lds); XBAR();
    run_phase(p, 2, 0, lds); XBAR();
#if PROBE_PH == 2
    run_phase(p, 2, 0, lds, 2); XBAR();
#endif
    run_phase(p, 3, 0, lds); XBAR();
#if PROBE_PH == 3
    run_phase(p, 3, 0, lds); XBAR();
#endif
    run_phase(p, 4, 0, lds); XBAR();
    run_phase(p, 5, 0, lds); XBAR();
    run_phase(p, 6, 0, lds); XBAR();
    run_phase(p, 7, 0, lds); XBAR();
    run_phase(p, 8, 0, lds); XBAR();
    run_phase(p, 9, 1, lds); XBAR();
    run_phase(p, 10, 1, lds); XBAR();
    run_phase(p, 4, 1, lds); XBAR();
    run_phase(p, 5, 1, lds); XBAR();
    run_phase(p, 6, 1, lds); XBAR();
    run_phase(p, 7, 1, lds); XBAR();
    run_phase(p, 8, 1, lds);
}

#ifndef PROBE_PH
#define PROBE_PH -1
#endif
#ifndef MULTI_LAUNCH
#define MULTI_LAUNCH 0
#endif
#if MULTI_LAUNCH
extern "C" __global__ void __launch_bounds__(512, 2) phase_kernel(Params p) {
    extern __shared__ __attribute__((aligned(16))) char lds[];
    switch (p.ph_lo) {
    case 0: run_phase(p, 0, 0, lds); break;
    case 1: run_phase(p, 1, 0, lds); break;
    case 2: run_phase(p, 2, 0, lds); break;
    case 3: run_phase(p, 3, 0, lds); break;
    case 4: run_phase(p, 4, p.ph_hi, lds); break;
    case 5: run_phase(p, 5, p.ph_hi, lds); break;
    case 6: run_phase(p, 6, p.ph_hi, lds); break;
    case 7: run_phase(p, 7, p.ph_hi, lds); break;
    case 8: run_phase(p, 8, p.ph_hi, lds); break;
    case 9: run_phase(p, 9, 1, lds); break;
    case 10: run_phase(p, 10, 1, lds); break;
    default: break;
    }
}
#endif

extern "C" void kernel_launch(void* const* d_in, const int* in_sizes, int n_in, void* d_out, int out_size, void* d_ws, size_t ws_size, hipStream_t stream) {
    static int grid = 0;
#if MULTI_LAUNCH
    const void* kfn = (const void*)phase_kernel;
#else
    const void* kfn = (const void*)mega_fwd;
#endif
    if (grid == 0) {
        int dev = 0, cus = 0, per_cu = 0;
        (void)hipGetDevice(&dev);
        (void)hipDeviceGetAttribute(&cus, hipDeviceAttributeMultiprocessorCount, dev);
        (void)hipFuncSetAttribute(kfn, hipFuncAttributeMaxDynamicSharedMemorySize, LDS_BYTES);
        (void)hipOccupancyMaxActiveBlocksPerMultiprocessor(&per_cu, kfn, NTHR, LDS_BYTES);
        if (per_cu < 1) { fprintf(stderr, "kernel_launch: occupancy query reports %d blocks per CU\n", per_cu); per_cu = 1; }
        grid = cus;
        if (ws_size < W_END) { fprintf(stderr, "kernel_launch: workspace too small: %zu < %zu\n", ws_size, (size_t)W_END); grid = -1; }
    }
    if (grid < 0) return;
    (void)hipMemsetAsync((char*)d_ws + W_CTRL, 0, 16384, stream);
    Params p{};
    for (int i = 0; i < 25; ++i) p.in[i] = (const float*)d_in[i];
    p.out = (float*)d_out; p.ws = (char*)d_ws; p.ph_lo = 0; p.ph_hi = 16;
#if MULTI_LAUNCH
    static const int seq[16][2] = {{0,0},{1,0},{2,0},{3,0},{4,0},{5,0},{6,0},{7,0},{8,0},{9,1},{10,1},{4,1},{5,1},{6,1},{7,1},{8,1}};
    for (int i = 0; i < 16; ++i) {
        p.ph_lo = seq[i][0]; p.ph_hi = seq[i][1];
        hipLaunchKernelGGL(phase_kernel, dim3(grid), dim3(NTHR), LDS_BYTES, stream, p);
    }
#else
    void* args[] = {&p};
    hipError_t e = hipLaunchCooperativeKernel(kfn, dim3(grid), dim3(NTHR), args, LDS_BYTES, stream);
    if (e != hipSuccess) fprintf(stderr, "cooperative launch failed: %s (grid %d)\n", hipGetErrorString(e), grid);
#endif
}
```

```cpp
#include <hip/hip_runtime.h>
#include <hip/hip_cooperative_groups.h>
#include <stdint.h>
#include <stdio.h>
namespace cg = cooperative_groups;

typedef unsigned short bf16_t;
typedef short bf16x8 __attribute__((ext_vector_type(8)));
typedef float f32x4 __attribute__((ext_vector_type(4)));
typedef float f32x16 __attribute__((ext_vector_type(16)));
#define LAS __attribute__((address_space(3)))

#define MFMA32(a, b, c) __builtin_amdgcn_mfma_f32_32x32x16_bf16(a, b, c, 0, 0, 0)
#define MFMA16(a, b, c) __builtin_amdgcn_mfma_f32_16x16x32_bf16(a, b, c, 0, 0, 0)

constexpr int TP = 32768, TS = 1024, TT = TP + TS;
constexpr int NRET = 3328, NDIFF = 2560, DFF = 2816;
constexpr float ALPHA = 1.41421356237f;
constexpr float LAM_INIT = 0.35550907f;
constexpr int NTHR = 512;
constexpr int LDS_MAIN = 131072, LDS_BYTES = LDS_MAIN + 256;

constexpr size_t O_YP = 0, O_RSP = 34603008, O_RSS = 35389440, O_DKP = 36962304, O_DVP = 62128128,
                 O_DKS = 87293952, O_DVS = 88080384, O_MKP = 88866816, O_MVP = 89915392;
constexpr size_t W_CTRL = 0;
constexpr size_t W_ROPER = 16384;
constexpr size_t W_ROPED = W_ROPER + 4096ull * 64 * 8;
constexpr size_t W_WRET = W_ROPED + 4096ull * 8 * 8;
constexpr size_t W_WDIFF = W_WRET + (size_t)NRET * 1024 * 2;
constexpr size_t W_WMKV = W_WDIFF + (size_t)NDIFF * 1024 * 2;
constexpr size_t W_WO = W_WMKV + 2ull * 512 * 1024 * 2;
constexpr size_t W_WGU = W_WO + 2ull * 1024 * 1024 * 2;
constexpr size_t W_WD = W_WGU + 2ull * 5632 * 1024 * 2;
constexpr size_t W_MB = W_WD + 2ull * 1024 * 2816 * 2;
constexpr size_t W_MK = W_MB + 2048ull * 1024 * 2;
constexpr size_t W_MVT = W_MK + 2ull * 24 * 65536 * 2;
constexpr size_t W_XB = W_MVT + 2ull * 24 * 65536 * 2;
constexpr size_t W_H = W_XB + (size_t)TT * 1024 * 2;
constexpr size_t W_RA = W_H + (size_t)TT * 1024 * 2;
constexpr size_t W_END = W_RA + (size_t)TT * NRET * 2;
constexpr size_t W_QM = W_RA;
constexpr size_t W_KBP = W_QM + (size_t)TT * 1024 * 2;
constexpr size_t W_KBS = W_KBP + 8ull * 4096 * 768 * 2;
constexpr size_t W_VTP = W_KBS + 16ull * 1088 * 768 * 2;
constexpr size_t W_VTS = W_VTP + 8ull * 6 * 128 * 4096 * 2;
static_assert(W_VTS + 16ull * 6 * 128 * 1088 * 2 <= W_END, "layer-1 overlay too big");

struct Params {
    const float* in[25];
    float* out;
    char* ws;
    int ph_lo, ph_hi;
};

__device__ __forceinline__ int TIDX() { int t = threadIdx.x; asm volatile("" : "+v"(t)); return t; }
__device__ __forceinline__ int BIDX() { int t = blockIdx.x; asm volatile("" : "+s"(t)); return t; }
typedef __bf16 bf2_t __attribute__((ext_vector_type(2)));
typedef float f2_t __attribute__((ext_vector_type(2)));
__device__ __forceinline__ uint32_t pk2(float lo, float hi) { f2_t f = {lo, hi}; bf2_t b = __builtin_convertvector(f, bf2_t); return *(uint32_t*)&b; }
__device__ __forceinline__ bf16_t f2bf(float f) { return (bf16_t)(pk2(f, 0.f) & 0xffffu); }
__device__ __forceinline__ float bf2f(bf16_t b) { return __uint_as_float(((uint32_t)b) << 16); }
__device__ __forceinline__ float bflo(uint32_t u) { return __uint_as_float(u << 16); }
__device__ __forceinline__ float bfhi(uint32_t u) { return __uint_as_float(u & 0xffff0000u); }
__device__ __forceinline__ bf16x8 mk8(uint32_t a, uint32_t b, uint32_t c, uint32_t d) { uint4 u = make_uint4(a, b, c, d); return *(bf16x8*)&u; }
__device__ __forceinline__ bf16x8 pack8(f32x4 a, f32x4 b) { return mk8(pk2(a[0], a[1]), pk2(a[2], a[3]), pk2(b[0], b[1]), pk2(b[2], b[3])); }
__device__ __forceinline__ bf16x8 ld8(const bf16_t* p) { return *(const bf16x8*)p; }
__device__ __forceinline__ bf16x8 ld44(const bf16_t* lo, const bf16_t* hi) { uint2 a = *(const uint2*)lo, b = *(const uint2*)hi; return mk8(a.x, a.y, b.x, b.y); }
__device__ __forceinline__ float xr16_32_max(float v) { v = fmaxf(v, __shfl_xor(v, 16)); v = fmaxf(v, __shfl_xor(v, 32)); return v; }
__device__ __forceinline__ float xr16_32_sum(float v) { v += __shfl_xor(v, 16); v += __shfl_xor(v, 32); return v; }
__device__ __forceinline__ float wave_sum(float v) { for (int o = 1; o < 64; o <<= 1) v += __shfl_xor(v, o); return v; }
__device__ __forceinline__ void unpack8(uint4 u, float* f) { f[0] = bflo(u.x); f[1] = bfhi(u.x); f[2] = bflo(u.y); f[3] = bfhi(u.y); f[4] = bflo(u.z); f[5] = bfhi(u.z); f[6] = bflo(u.w); f[7] = bfhi(u.w); }
__device__ __forceinline__ float silu(float x) { return x / (1.f + __expf(-x)); }

constexpr int G_BK = 64, G_HT = 128 * 64;
__device__ __forceinline__ int lds_byte(int r, int c) { const int st = (r >> 4) * 2 + (c >> 5), rr = r & 15, cc = c & 31, ob = rr * 64 + cc * 2; return st * 1024 + (ob ^ (((ob >> 9) & 1) << 5)); }
__device__ __forceinline__ void stage_rc(int b, int& R, int& C) { const int st = b / 1024, sb = b % 1024, swz = sb ^ (((sb >> 9) & 1) << 5); R = (st >> 1) * 16 + swz / 64; C = (st & 1) * 32 + (swz % 64) / 2; }

template <class Epi>
__device__ __forceinline__ void gemm256_tile(const bf16_t* __restrict__ A, const bf16_t* __restrict__ Bt, const int K, const int brow, const int bcol, const bool pre, const int nrow, const int ncol, char* lds, const Epi& epi) {
    bf16_t* shm = (bf16_t*)lds;
#define SA(b, h) (shm + ((b) * 2 + (h)) * G_HT)
#define SB(b, h) (shm + (4 + (b) * 2 + (h)) * G_HT)
#define STAGE(P, BASE, br, kt) do { const long _g = (long)(br) * K + (long)(kt) * G_BK; \
    _Pragma("unroll") for (int _i = 0; _i < 2; ++_i) { const int _b = tid * 16 + _i * 8192; int _r, _c; stage_rc(_b, _r, _c); \
      __builtin_amdgcn_global_load_lds((const unsigned*)(BASE + _g + (long)_r * K + _c), (__attribute__((address_space(3))) unsigned*)((char*)(P) + _b), 16, 0, 0); } } while (0)
#define LDA(dst, b, h) _Pragma("unroll") for (int m = 0; m < 4; ++m) _Pragma("unroll") for (int k = 0; k < 2; ++k) \
    dst[m][k] = *reinterpret_cast<const bf16x8*>((char*)SA(b, h) + lds_byte(wr * 64 + m * 16 + fr, k * 32 + fq * 8))
#define LDB(dst, b, h) _Pragma("unroll") for (int n = 0; n < 2; ++n) _Pragma("unroll") for (int k = 0; k < 2; ++k) \
    dst[n][k] = *reinterpret_cast<const bf16x8*>((char*)SB(b, h) + lds_byte(wc * 32 + n * 16 + fr, k * 32 + fq * 8))
#define MMA(ai, bj, At_, Bt_) do { __builtin_amdgcn_s_setprio(1); \
    _Pragma("unroll") for (int m = 0; m < 4; ++m) _Pragma("unroll") for (int n = 0; n < 2; ++n) _Pragma("unroll") for (int k = 0; k < 2; ++k) \
      acc[ai][bj][m][n] = MFMA16(Bt_[n][k], At_[m][k], acc[ai][bj][m][n]); \
    __builtin_amdgcn_s_setprio(0); } while (0)
#define WAIT_V(n) asm volatile("s_waitcnt vmcnt(" #n ")" ::: "memory")
#define WAIT_L(n) asm volatile("s_waitcnt lgkmcnt(" #n ")" ::: "memory")
#define BAR __builtin_amdgcn_s_barrier()
#define SCHED __builtin_amdgcn_sched_barrier(0)
    const int tid = TIDX();
    const int wid = tid >> 6, lane = tid & 63, wr = wid >> 2, wc = wid & 3, fr = lane & 15, fq = lane >> 4;
    constexpr int HALF = 128;
    f32x4 acc[2][2][4][2];
#pragma unroll
    for (int a = 0; a < 2; ++a)
#pragma unroll
        for (int b = 0; b < 2; ++b)
#pragma unroll
            for (int m = 0; m < 4; ++m)
#pragma unroll
                for (int n = 0; n < 2; ++n) acc[a][b][m][n] = (f32x4){0.f, 0.f, 0.f, 0.f};
    bf16x8 At[4][2], B0[2][2], B1[2][2];
    const int nt = K / G_BK;
    asm volatile("s_waitcnt vmcnt(0) lgkmcnt(0)" ::: "memory");
    __syncthreads();
    if (!pre) {
        STAGE(SB(0, 0), Bt, bcol, 0); STAGE(SA(0, 0), A, brow, 0);
        STAGE(SB(0, 1), Bt, bcol + HALF, 0); STAGE(SA(0, 1), A, brow + HALF, 0);
    }
    if (wr == 1) BAR;
    WAIT_V(4); BAR;
    STAGE(SB(1, 0), Bt, bcol, 1); STAGE(SA(1, 0), A, brow, 1); STAGE(SB(1, 1), Bt, bcol + HALF, 1);
    WAIT_V(6); BAR;
    for (int t = 0; t < nt - 2; t += 2) {
        LDB(B0, 0, 0); SCHED; LDA(At, 0, 0); STAGE(SA(1, 1), A, brow + HALF, t + 1);
        WAIT_L(8); BAR; WAIT_L(0); MMA(0, 0, At, B0); BAR; SCHED;
        LDB(B1, 0, 1); STAGE(SB(0, 0), Bt, bcol, t + 2);
        BAR; WAIT_L(0); MMA(0, 1, At, B1); BAR;
        LDA(At, 0, 1); STAGE(SA(0, 0), A, brow, t + 2);
        BAR; WAIT_L(0); MMA(1, 0, At, B0); BAR; SCHED;
        STAGE(SB(0, 1), Bt, bcol + HALF, t + 2);
        WAIT_V(6); BAR; MMA(1, 1, At, B1); BAR;
        LDB(B0, 1, 0); SCHED; LDA(At, 1, 0); STAGE(SA(0, 1), A, brow + HALF, t + 2);
        WAIT_L(8); BAR; WAIT_L(0); MMA(0, 0, At, B0); BAR; SCHED;
        LDB(B1, 1, 1); STAGE(SB(1, 0), Bt, bcol, t + 3);
        BAR; WAIT_L(0); MMA(0, 1, At, B1); BAR;
        LDA(At, 1, 1); STAGE(SA(1, 0), A, brow, t + 3);
        BAR; WAIT_L(0); MMA(1, 0, At, B0); BAR; SCHED;
        STAGE(SB(1, 1), Bt, bcol + HALF, t + 3);
        WAIT_V(6); BAR; MMA(1, 1, At, B1); BAR;
    }
    { LDB(B0, 0, 0); LDA(At, 0, 0); STAGE(SA(1, 1), A, brow + HALF, nt - 1);
      BAR; WAIT_L(0); MMA(0, 0, At, B0); BAR;
      LDB(B1, 0, 1); BAR; WAIT_L(0); MMA(0, 1, At, B1); BAR;
      LDA(At, 0, 1); WAIT_V(4); BAR; WAIT_L(0); MMA(1, 0, At, B0); MMA(1, 1, At, B1); BAR; }
    { LDB(B0, 1, 0); LDA(At, 1, 0); WAIT_V(2); BAR; WAIT_L(0); MMA(0, 0, At, B0); BAR;
      LDB(B1, 1, 1); WAIT_V(0); BAR; WAIT_L(0); MMA(0, 1, At, B1); BAR;
      LDA(At, 1, 1); BAR; WAIT_L(0); MMA(1, 0, At, B0); MMA(1, 1, At, B1); BAR; }
    if (wr == 0) BAR;
    if (nrow >= 0) {
        STAGE(SB(0, 0), Bt, ncol, 0); STAGE(SA(0, 0), A, nrow, 0);
        STAGE(SB(0, 1), Bt, ncol + HALF, 0); STAGE(SA(0, 1), A, nrow + HALF, 0);
    }
    epi(acc, brow, bcol, wr, wc, fr, fq);
#undef SA
#undef SB
#undef STAGE
#undef LDA
#undef LDB
#undef MMA
}

__device__ __forceinline__ bool gemm_tile_coord(int i, int G, int c, int nM, int nN, int& pm, int& pn) {
    const int nwg = nM * nN; const long L = (long)i * G + c; if (L >= nwg) return false;
    int wgid = (int)L; { const int q = nwg / 8, r = nwg % 8, xcd = wgid % 8, off = wgid / 8; wgid = (xcd < r ? xcd * (q + 1) : r * (q + 1) + (xcd - r) * q) + off; }
    const int nig = 8 * nN, gid = wgid / nig, fm = gid * 8, gsz = (nM - fm) < 8 ? (nM - fm) : 8;
    pm = fm + ((wgid % nig) % gsz); pn = (wgid % nig) / gsz; return true;
}
template <class Epi>
__device__ __forceinline__ void gemm_phase(const bf16_t* A, const bf16_t* Bt, int K, int nM, int nN, char* lds, const Epi& epi, const int coff = 0) {
    const int G = gridDim.x, c = (BIDX() + G - coff) % G;
    int pm, pn; bool have = gemm_tile_coord(0, G, c, nM, nN, pm, pn), pre = false;
    for (int i = 0; have; ++i) {
        int qm = 0, qn = 0; const bool nxt = gemm_tile_coord(i + 1, G, c, nM, nN, qm, qn);
        gemm256_tile(A, Bt, K, pm * 256, pn * 256, pre, (Epi::PRESTAGE && nxt) ? qm * 256 : -1, qn * 256, lds, epi);
        pre = Epi::PRESTAGE && nxt; have = nxt; pm = qm; pn = qn;
    }
}

#define EPI_ARGS f32x4 (&acc)[2][2][4][2], int brow, int bcol, int wr, int wc, int fr, int fq
#define EPI_LOOP _Pragma("unroll") for (int ai = 0; ai < 2; ++ai) _Pragma("unroll") for (int bj = 0; bj < 2; ++bj) _Pragma("unroll") for (int m = 0; m < 4; ++m) _Pragma("unroll") for (int n = 0; n < 2; ++n)
#define EPI_ROW (brow + 128 * ai + 64 * wr + 16 * m + fr)
#define EPI_COL (bcol + 128 * bj + 32 * wc + 16 * n + 4 * fq)

struct EpiBf16 {
    static constexpr bool PRESTAGE = true;
    bf16_t* C; int ldc;
    __device__ __forceinline__ void operator()(EPI_ARGS) const {
        EPI_LOOP { const f32x4 v = acc[ai][bj][m][n]; *(uint2*)(C + (size_t)EPI_ROW * ldc + EPI_COL) = make_uint2(pk2(v[0], v[1]), pk2(v[2], v[3])); }
    }
};
struct EpiMemKV {
    static constexpr bool PRESTAGE = false;
    float* outk; float* outv; bf16_t* mk; bf16_t* mvt;
    __device__ __forceinline__ void operator()(EPI_ARGS) const {
        EPI_LOOP {
            const int row = EPI_ROW, col = EPI_COL; const f32x4 v = acc[ai][bj][m][n];
            if (bcol == 0) { *(f32x4*)(outk + (size_t)row * 256 + col) = v; *(uint2*)(mk + (size_t)row * 256 + col) = make_uint2(pk2(v[0], v[1]), pk2(v[2], v[3])); }
            else { const int c = col - 256, b = row >> 8, mm = row & 255; *(f32x4*)(outv + (size_t)row * 256 + c) = v;
#pragma unroll
                for (int q = 0; q < 4; ++q) mvt[(size_t)((b * 4 + (c >> 6)) * 64 + (c & 63) + q) * 256 + mm] = f2bf(v[q]); }
        }
    }
};
struct EpiResid {
    static constexpr bool PRESTAGE = false;
    const bf16_t* X; bf16_t* Zb;
    __device__ __forceinline__ void operator()(EPI_ARGS) const {
#pragma unroll
        for (int ai = 0; ai < 2; ++ai)
#pragma unroll
            for (int bj = 0; bj < 2; ++bj) {
#pragma unroll
                for (int m = 0; m < 4; ++m)
#pragma unroll
                    for (int n = 0; n < 2; ++n) { const unsigned o = (unsigned)EPI_ROW * 1024u + (unsigned)EPI_COL; const uint2 x = *(const uint2*)(X + o); const f32x4 v = acc[ai][bj][m][n];
                        *(uint2*)(Zb + o) = make_uint2(pk2(ALPHA * bflo(x.x) + v[0], ALPHA * bfhi(x.x) + v[1]), pk2(ALPHA * bflo(x.y) + v[2], ALPHA * bfhi(x.y) + v[3])); }
                __builtin_amdgcn_sched_barrier(0);
            }
    }
};
struct EpiGU {
    static constexpr bool PRESTAGE = false;
    bf16_t* ACT;
    __device__ __forceinline__ void operator()(EPI_ARGS) const {
#pragma unroll
        for (int ai = 0; ai < 2; ++ai)
#pragma unroll
            for (int bj = 0; bj < 2; ++bj)
#pragma unroll
                for (int m = 0; m < 4; ++m) {
                    const int row = brow + 128 * ai + 64 * wr + 16 * m + fr, ocol = (bcol >> 1) + 64 * bj + 16 * wc + 4 * fq;
                    const f32x4 gt = acc[ai][bj][m][0], up = acc[ai][bj][m][1];
                    *(uint2*)(ACT + (size_t)row * DFF + ocol) = make_uint2(pk2(silu(gt[0]) * up[0], silu(gt[1]) * up[1]), pk2(silu(gt[2]) * up[2], silu(gt[3]) * up[3]));
                    __builtin_amdgcn_sched_barrier(0);
                }
    }
};
struct EpiProj1 {
    static constexpr bool PRESTAGE = false;
    bf16_t* QM; bf16_t* KBP; bf16_t* KBS; bf16_t* VTP; bf16_t* VTS; float* out; const float2* ropeD;
    __device__ __forceinline__ void operator()(EPI_ARGS) const {
        EPI_LOOP {
            const int row = EPI_ROW, col = EPI_COL;
            f32x4 v = acc[ai][bj][m][n];
            const int region = col < 768 ? 0 : (col < 1536 ? 1 : (col < 2304 ? 2 : 3));
            if (region <= 1) {
                const bool rot = ((wc & 1) == 0) && (n == 0);
                if (rot) {
                    f32x4 pr; pr[0] = __shfl_xor(v[0], 32); pr[1] = __shfl_xor(v[1], 32); pr[2] = __shfl_xor(v[2], 32); pr[3] = __shfl_xor(v[3], 32);
                    const int pos = row < TP ? (row & 4095) : 1024 + ((row - TP) & 63);
                    const float4* cs = (const float4*)(ropeD + pos * 8 + 4 * (fq & 1));
                    const float4 c01 = cs[0], c23 = cs[1];
                    const float cc[4] = {c01.x, c01.z, c23.x, c23.z}, sn[4] = {c01.y, c01.w, c23.y, c23.w};
#pragma unroll
                    for (int q = 0; q < 4; ++q) v[q] = fq < 2 ? v[q] * cc[q] - pr[q] * sn[q] : pr[q] * sn[q] + v[q] * cc[q];
                }
                const uint2 pk = make_uint2(pk2(v[0], v[1]), pk2(v[2], v[3]));
                if (region == 0) *(uint2*)(QM + (size_t)row * 1024 + col) = pk;
                else {
                    const int kc = col - 768;
                    if (row < TP) { *(uint2*)(KBP + (size_t)row * 768 + kc) = pk; *(f32x4*)(out + O_DKP + (size_t)row * 768 + kc) = v; }
                    else { const int rs = row - TP, b = rs >> 6, s = rs & 63; *(uint2*)(KBS + (size_t)(b * 1088 + 1024 + s) * 768 + kc) = pk; *(f32x4*)(out + O_DKS + (size_t)rs * 768 + kc) = v; }
                }
            } else if (region == 2) {
                const int vc = col - 1536, h = vc >> 7, dim = vc & 127;
                if (row < TP) {
                    const int b = row >> 12, s = row & 4095;
                    *(f32x4*)(out + O_DVP + (size_t)row * 768 + vc) = v;
#pragma unroll
                    for (int q = 0; q < 4; ++q) VTP[((size_t)(b * 6 + h) * 128 + dim + q) * 4096 + s] = f2bf(v[q]);
                } else {
                    const int rs = row - TP, b = rs >> 6, s = rs & 63;
                    *(f32x4*)(out + O_DVS + (size_t)rs * 768 + vc) = v;
#pragma unroll
                    for (int q = 0; q < 4; ++q) VTS[((size_t)(b * 6 + h) * 128 + dim + q) * 1088 + 1024 + s] = f2bf(v[q]);
                }
            } else {
                *(uint2*)(QM + (size_t)row * 1024 + 768 + (col - 2304)) = make_uint2(pk2(v[0], v[1]), pk2(v[2], v[3]));
            }
        }
    }
};

__device__ __forceinline__ void transpose_tile(const float* __restrict__ src, int lds_, bf16_t* __restrict__ dst, int ldd, int k0, int n0, int mode, int which, float* tile, int tid) {
#pragma unroll
    for (int i = 0; i < 4; ++i) {
        const int k = (tid >> 4) + 16 * i, n4 = (tid & 15) * 4;
        const float4 v = *(const float4*)(src + (size_t)(k0 + k) * lds_ + n0 + n4);
        float* t = tile + k * 65 + n4; t[0] = v.x; t[1] = v.y; t[2] = v.z; t[3] = v.w;
    }
    __syncthreads();
    const int n = tid >> 2, kq = (tid & 3) * 16;
    uint32_t w[8];
#pragma unroll
    for (int q = 0; q < 8; ++q) w[q] = pk2(tile[(kq + 2 * q) * 65 + n], tile[(kq + 2 * q + 1) * 65 + n]);
    const int c = n0 + n;
    const int row = mode == 0 ? c : (256 * (c >> 7) + 128 * ((c >> 6) & 1) + 32 * ((c >> 4) & 3) + 16 * which + (c & 15));
    uint4* d = (uint4*)(dst + (size_t)row * ldd + k0 + kq);
    d[0] = make_uint4(w[0], w[1], w[2], w[3]); d[1] = make_uint4(w[4], w[5], w[6], w[7]);
    __syncthreads();
}

__device__ __forceinline__ void phase_prep(const Params& p, char* lds) {
    char* ws = p.ws;
    const int nb = gridDim.x, bid = BIDX(), tid = TIDX(), half = tid >> 8, tl = tid & 255;
    float* tile = (float*)lds + half * 4224;
    constexpr int T0 = 832, T1 = T0 + 640, T2 = T1 + 256, T3 = T2 + 512, T4 = T3 + 1408, T5 = T4 + 1408, T6 = T5 + 1408;
    for (int it2 = bid; it2 < T6 / 2; it2 += nb) {
        const int it = 2 * it2 + half;
        if (it < T0) { const int kt = it / 52, nt = it % 52; transpose_tile(p.in[8], NRET, (bf16_t*)(ws + W_WRET), 1024, kt * 64, nt * 64, 0, 0, tile, tl); }
        else if (it < T1) { const int r = it - T0, kt = r / 40, nt = r % 40; transpose_tile(p.in[10], NDIFF, (bf16_t*)(ws + W_WDIFF), 1024, kt * 64, nt * 64, 0, 0, tile, tl); }
        else if (it < T2) { const int r = it - T1, l = r >> 7, q = r & 127, kt = q >> 3, nt = q & 7; transpose_tile(p.in[16] + (size_t)l * 1024 * 512, 512, (bf16_t*)(ws + W_WMKV) + (size_t)l * 512 * 1024, 1024, kt * 64, nt * 64, 0, 0, tile, tl); }
        else if (it < T3) { const int r = it - T2, l = r >> 8, q = r & 255, kt = q >> 4, nt = q & 15; transpose_tile(p.in[17] + (size_t)l * 1024 * 1024, 1024, (bf16_t*)(ws + W_WO) + (size_t)l * 1024 * 1024, 1024, kt * 64, nt * 64, 0, 0, tile, tl); }
        else if (it < T5) { const int wh = it >= T4; const int r = it - (wh ? T4 : T3), l = r / 704, q = r % 704, kt = q / 44, nt = q % 44;
            transpose_tile(p.in[wh ? 21 : 20] + (size_t)l * 1024 * DFF, DFF, (bf16_t*)(ws + W_WGU) + (size_t)l * 5632 * 1024, 1024, kt * 64, nt * 64, 1, wh, tile, tl); }
        else { const int r = it - T5, l = r / 704, q = r % 704, kt = q >> 4, nt = q & 15; transpose_tile(p.in[22] + (size_t)l * DFF * 1024, 1024, (bf16_t*)(ws + W_WD) + (size_t)l * 1024 * DFF, DFF, kt * 64, nt * 64, 0, 0, tile, tl); }
    }
    const size_t gt = (size_t)bid * NTHR + tid, gs = (size_t)nb * NTHR;
    { uint2* dst = (uint2*)(ws + W_XB); const float4* xp = (const float4*)p.in[0]; const float4* xs = (const float4*)p.in[1];
      const size_t n4 = (size_t)TT * 256, np4 = (size_t)TP * 256;
      for (size_t i = gt; i < n4; i += gs) { const float4 v = i < np4 ? xp[i] : xs[i - np4]; dst[i] = make_uint2(pk2(v.x, v.y), pk2(v.z, v.w)); } }
    { uint2* dst = (uint2*)(ws + W_MB); const float4* s = (const float4*)p.in[2];
      for (size_t i = gt; i < 2048ull * 256; i += gs) { const float4 v = s[i]; dst[i] = make_uint2(pk2(v.x, v.y), pk2(v.z, v.w)); } }
    { uint2* dst = (uint2*)(ws + W_MK); const float4* s = (const float4*)p.in[6];
      for (size_t i = gt; i < 2ull * 16 * 16384; i += gs) { const size_t l = i / (16 * 16384), rem = i - l * 16 * 16384; const float4 v = s[i]; dst[(l * 24 + 8) * 16384 + rem] = make_uint2(pk2(v.x, v.y), pk2(v.z, v.w)); } }
    { bf16_t* dst = (bf16_t*)(ws + W_MVT); const float* s = p.in[7];
      for (size_t i = gt; i < 2ull * 16 * 65536; i += gs) {
          const int m = i & 255, dim = (i >> 8) & 63, h = (i >> 14) & 3, b = (i >> 16) & 15, l = (int)(i >> 20);
          dst[((size_t)((l * 24 + 8 + b) * 4 + h) * 64 + dim) * 256 + m] = f2bf(s[((size_t)(l * 16 + b) * 256 + m) * 256 + h * 64 + dim]); } }
    { float2* rr = (float2*)(ws + W_ROPER); float2* rd = (float2*)(ws + W_ROPED);
      for (size_t i = gt; i < 4096ull * 64; i += gs) { const int pos = (int)(i >> 6), f = (int)(i & 63); const float inv = expf(-logf(10000.f) * (float)f * 2.0f / 128.f); float sn, cs; sincosf((float)pos * inv, &sn, &cs); rr[i] = make_float2(cs, sn); }
      for (size_t i = gt; i < 4096ull * 8; i += gs) { const int pos = (int)(i >> 3), f = (int)(i & 7); const float inv = expf(-logf(500000.f) * (float)f * 2.0f / 16.f); float sn, cs; sincosf((float)pos * inv, &sn, &cs); rd[i] = make_float2(cs, sn); } }
    if (bid == 0 && tid < 64) ((int*)(ws + W_CTRL))[tid] = 0;
}

__device__ __forceinline__ void ret_chain(const Params& p, int h, int sl, int nsteps, int rowbase, int posbase, const float* init, bf16_t* rs, float* fin, char* lds) {
    const int tid = TIDX(), lane = tid & 63, w = tid >> 6, g = lane >> 4, lc = lane & 15;
    const float log_g = logf(1.f - exp2f(-5.f - (float)h));
    const float gch = expf(64.f * log_g);
    const float kscale = 0.08838834764831845f;
    const bf16_t* proj = (const bf16_t*)(p.ws + W_RA);
    const float2* ropeR = (const float2*)(p.ws + W_ROPER);
    f32x4 acc[2];
#pragma unroll
    for (int jj = 0; jj < 2; ++jj)
#pragma unroll
        for (int r = 0; r < 4; ++r) { const int d = 16 * w + 4 * g + r, e = sl * 32 + 16 * jj + lc; acc[jj][r] = init ? init[d * 128 + e] : 0.f; }
    const float zeta = expf((float)(63 - (tid >> 3)) * log_g) * kscale;
    uint4 ka0, kb0, vv0, ka1, kb1, vv1, ka2, kb2, vv2, ka3, kb3, vv3;
    float4 ca0[4], ca1[4], ca2[4], ca3[4];
    const int kj = tid >> 3, kdg = tid & 7, vj = (tid >> 2) & 63, veg = tid & 3;
#define RC_LOAD(c_, K1, K2, VV, CS) do { const bf16_t* s_ = proj + (size_t)(rowbase + (c_) * 64 + kj) * NRET + 768 + h * 128 + kdg * 8; K1 = *(const uint4*)s_; K2 = *(const uint4*)(s_ + 64); \
        { const float4* cs_ = (const float4*)(ropeR + (size_t)(posbase + (c_) * 64 + kj) * 64 + kdg * 8); CS[0] = cs_[0]; CS[1] = cs_[1]; CS[2] = cs_[2]; CS[3] = cs_[3]; } \
        VV = *(const uint4*)(proj + (size_t)(rowbase + (c_) * 64 + vj) * NRET + 1536 + h * 128 + sl * 32 + veg * 8); } while (0)
#define RC_STEP(c_, K1, K2, VV, CS) if ((c_) < nsteps) { const int c = (c_); \
        bf16_t* Kt = (bf16_t*)(lds + (c & 1) * 18432); \
        bf16_t* Vt = (bf16_t*)(lds + 36864 + (c & 1) * 4608); \
        { \
            float x1[8], x2[8]; unpack8(K1, x1); unpack8(K2, x2); \
            _Pragma("unroll") for (int e2 = 0; e2 < 4; ++e2) { \
                const float4 t = CS[e2]; \
                { const float a = x1[2 * e2], b = x2[2 * e2]; Kt[(kdg * 8 + 2 * e2) * 72 + kj] = f2bf((a * t.x - b * t.y) * zeta); Kt[(64 + kdg * 8 + 2 * e2) * 72 + kj] = f2bf((a * t.y + b * t.x) * zeta); } \
                { const float a = x1[2 * e2 + 1], b = x2[2 * e2 + 1]; Kt[(kdg * 8 + 2 * e2 + 1) * 72 + kj] = f2bf((a * t.z - b * t.w) * zeta); Kt[(64 + kdg * 8 + 2 * e2 + 1) * 72 + kj] = f2bf((a * t.w + b * t.z) * zeta); } \
            } \
        } \
        if (tid < 256) { const uint32_t u[4] = {VV.x, VV.y, VV.z, VV.w}; \
          _Pragma("unroll") for (int e2 = 0; e2 < 4; ++e2) { Vt[(veg * 8 + 2 * e2) * 72 + vj] = (bf16_t)(u[e2] & 0xffff); Vt[(veg * 8 + 2 * e2 + 1) * 72 + vj] = (bf16_t)(u[e2] >> 16); } } \
        if (c + 4 < nsteps) RC_LOAD(c + 4, K1, K2, VV, CS); \
        __syncthreads(); \
        bf16_t* rsc = rs + (size_t)c * 16384; \
        _Pragma("unroll") for (int jj = 0; jj < 2; ++jj) { \
            const int d = 16 * w + 4 * g, e = sl * 32 + 16 * jj + lc; \
            *(uint2*)(rsc + e * 128 + d) = make_uint2(pk2(acc[jj][0], acc[jj][1]), pk2(acc[jj][2], acc[jj][3])); \
            acc[jj] = acc[jj] * gch; \
        } \
        _Pragma("unroll") for (int s = 0; s < 2; ++s) { \
            const bf16x8 a = ld8(Kt + (16 * w + lc) * 72 + 32 * s + 8 * g); \
            _Pragma("unroll") for (int jj = 0; jj < 2; ++jj) acc[jj] = MFMA16(a, ld8(Vt + (16 * jj + lc) * 72 + 32 * s + 8 * g), acc[jj]); \
        } \
    }
    RC_LOAD(0, ka0, kb0, vv0, ca0);
    if (1 < nsteps) RC_LOAD(1, ka1, kb1, vv1, ca1);
    if (2 < nsteps) RC_LOAD(2, ka2, kb2, vv2, ca2);
    if (3 < nsteps) RC_LOAD(3, ka3, kb3, vv3, ca3);
    for (int c4 = 0; c4 < nsteps; c4 += 4) {
        RC_STEP(c4, ka0, kb0, vv0, ca0)
        RC_STEP(c4 + 1, ka1, kb1, vv1, ca1)
        RC_STEP(c4 + 2, ka2, kb2, vv2, ca2)
        RC_STEP(c4 + 3, ka3, kb3, vv3, ca3)
    }
#pragma unroll
    for (int jj = 0; jj < 2; ++jj)
#pragma unroll
        for (int r = 0; r < 4; ++r) { const int d = 16 * w + 4 * g + r, e = sl * 32 + 16 * jj + lc; fin[d * 128 + e] = acc[jj][r]; }
    __syncthreads();
#undef RC_LOAD
#undef RC_STEP
}
__device__ __forceinline__ void ret_out(const Params& p, int u2, char* lds_) {
    const int tid_ = TIDX(), half = tid_ >> 8, tid = tid_ & 255, lane = tid & 63, w = tid >> 6, g = lane >> 4, lc = lane & 15;
    const int u = 2 * u2 + half; char* lds = lds_ + half * 53248;
    int b, h, rowbase, pos0;
    if (u < 3072) { const int chain = u >> 6, c = u & 63; b = chain / 6; h = chain % 6; rowbase = b * 4096 + c * 64; pos0 = c * 64; }
    else { const int cs = u - 3072; b = cs / 6; h = cs % 6; rowbase = TP + b * 64; pos0 = 1024; }
    const float log_g = logf(1.f - exp2f(-5.f - (float)h));
    const float log2g = log_g * 1.44269504089f;
    const float kscale = 0.08838834764831845f;
    const bf16_t* proj = (const bf16_t*)(p.ws + W_RA);
    const float2* ropeR = (const float2*)(p.ws + W_ROPER);
    const bf16_t* rsu = (const bf16_t*)(p.out + O_DKP) + (size_t)u * 16384;
    bf16_t* H = (bf16_t*)(p.ws + W_H);
    bf16_t* Qs = (bf16_t*)lds; bf16_t* Ks = (bf16_t*)(lds + 17408); bf16_t* Vt = (bf16_t*)(lds + 34816);
#pragma unroll
    for (int q = 0; q < 2; ++q) {
        const int it = tid + 256 * q, j = it >> 3, dg = it & 7;
        const bf16_t* s = proj + (size_t)(rowbase + j) * NRET + h * 128 + dg * 8;
        const uint4 q1 = *(const uint4*)s, q2 = *(const uint4*)(s + 64), kk1 = *(const uint4*)(s + 768), kk2 = *(const uint4*)(s + 768 + 64);
        const float4* cs = (const float4*)(ropeR + (size_t)(pos0 + j) * 64 + dg * 8);
        float a1[8], a2[8], b1[8], b2[8]; unpack8(q1, a1); unpack8(q2, a2); unpack8(kk1, b1); unpack8(kk2, b2);
        float qo1[8], qo2[8], ko1[8], ko2[8];
#pragma unroll
        for (int e2 = 0; e2 < 4; ++e2) {
            const float4 t = cs[e2];
            qo1[2 * e2] = a1[2 * e2] * t.x - a2[2 * e2] * t.y; qo2[2 * e2] = a1[2 * e2] * t.y + a2[2 * e2] * t.x;
            qo1[2 * e2 + 1] = a1[2 * e2 + 1] * t.z - a2[2 * e2 + 1] * t.w; qo2[2 * e2 + 1] = a1[2 * e2 + 1] * t.w + a2[2 * e2 + 1] * t.z;
            ko1[2 * e2] = (b1[2 * e2] * t.x - b2[2 * e2] * t.y) * kscale; ko2[2 * e2] = (b1[2 * e2] * t.y + b2[2 * e2] * t.x) * kscale;
            ko1[2 * e2 + 1] = (b1[2 * e2 + 1] * t.z - b2[2 * e2 + 1] * t.w) * kscale; ko2[2 * e2 + 1] = (b1[2 * e2 + 1] * t.w + b2[2 * e2 + 1] * t.z) * kscale;
        }
        *(uint4*)(Qs + j * 136 + dg * 8) = make_uint4(pk2(qo1[0], qo1[1]), pk2(qo1[2], qo1[3]), pk2(qo1[4], qo1[5]), pk2(qo1[6], qo1[7]));
        *(uint4*)(Qs + j * 136 + 64 + dg * 8) = make_uint4(pk2(qo2[0], qo2[1]), pk2(qo2[2], qo2[3]), pk2(qo2[4], qo2[5]), pk2(qo2[6], qo2[7]));
        *(uint4*)(Ks + j * 136 + dg * 8) = make_uint4(pk2(ko1[0], ko1[1]), pk2(ko1[2], ko1[3]), pk2(ko1[4], ko1[5]), pk2(ko1[6], ko1[7]));
        *(uint4*)(Ks + j * 136 + 64 + dg * 8) = make_uint4(pk2(ko2[0], ko2[1]), pk2(ko2[2], ko2[3]), pk2(ko2[4], ko2[5]), pk2(ko2[6], ko2[7]));
    }
#pragma unroll
    for (int q = 0; q < 4; ++q) {
        const int it = tid + 256 * q, j = it >> 4, eg = it & 15;
        const uint4 v = *(const uint4*)(proj + (size_t)(rowbase + j) * NRET + 1536 + h * 128 + eg * 8);
        const uint32_t uu[4] = {v.x, v.y, v.z, v.w};
#pragma unroll
        for (int e2 = 0; e2 < 4; ++e2) { Vt[(eg * 8 + 2 * e2) * 72 + j] = (bf16_t)(uu[e2] & 0xffff); Vt[(eg * 8 + 2 * e2 + 1) * 72 + j] = (bf16_t)(uu[e2] >> 16); }
    }
    __syncthreads();
    bf16x8 qf[4];
#pragma unroll
    for (int s = 0; s < 4; ++s) qf[s] = ld8(Qs + (16 * w + lc) * 136 + 32 * s + 8 * g);
    f32x4 st[4];
#pragma unroll
    for (int t = 0; t < 4; ++t) {
        st[t] = (f32x4){0.f, 0.f, 0.f, 0.f};
#pragma unroll
        for (int s = 0; s < 4; ++s) st[t] = MFMA16(ld8(Ks + (16 * t + lc) * 136 + 32 * s + 8 * g), qf[s], st[t]);
    }
    const int ii = 16 * w + lc;
#pragma unroll
    for (int t = 0; t < 4; ++t)
#pragma unroll
        for (int r = 0; r < 4; ++r) { const int j = 16 * t + 4 * g + r; st[t][r] *= exp2f(fabsf((float)(ii - j)) * log2g); }
    f32x4 o[8], oc[8];
#pragma unroll
    for (int et = 0; et < 8; ++et) { o[et] = (f32x4){0.f, 0.f, 0.f, 0.f}; oc[et] = (f32x4){0.f, 0.f, 0.f, 0.f}; }
#pragma unroll
    for (int s = 0; s < 2; ++s) {
        const bf16x8 pb = pack8(st[2 * s], st[2 * s + 1]);
#pragma unroll
        for (int et = 0; et < 8; ++et) { const bf16_t* vr = Vt + (16 * et + lc) * 72 + 32 * s + 4 * g; o[et] = MFMA16(ld44(vr, vr + 16), pb, o[et]); }
    }
#pragma unroll
    for (int et = 0; et < 8; ++et)
#pragma unroll
        for (int s = 0; s < 4; ++s) oc[et] = MFMA16(ld8(rsu + (16 * et + lc) * 128 + 32 * s + 8 * g), qf[s], oc[et]);
    const float xi = exp2f((float)(ii + 1) * log2g);
    float sum = 0.f;
#pragma unroll
    for (int et = 0; et < 8; ++et)
#pragma unroll
        for (int r = 0; r < 4; ++r) { o[et][r] += xi * oc[et][r]; sum += o[et][r]; }
    const float mean = xr16_32_sum(sum) * (1.f / 128.f);
    float sq = 0.f;
#pragma unroll
    for (int et = 0; et < 8; ++et)
#pragma unroll
        for (int r = 0; r < 4; ++r) { const float dd = o[et][r] - mean; sq += dd * dd; }
    const float rstd = rsqrtf(xr16_32_sum(sq) * (1.f / 128.f) + 1e-5f);
    const size_t row = (size_t)rowbase + ii;
    const float* gn = p.in[9] + h * 128;
#pragma unroll
    for (int et = 0; et < 8; ++et) {
        const int e = 16 * et + 4 * g;
        const uint2 gt = *(const uint2*)(proj + row * NRET + 2304 + h * 128 + e);
        const float4 gg = *(const float4*)(gn + e);
        const float y0 = (o[et][0] - mean) * rstd * gg.x * silu(bflo(gt.x)), y1 = (o[et][1] - mean) * rstd * gg.y * silu(bfhi(gt.x));
        const float y2 = (o[et][2] - mean) * rstd * gg.z * silu(bflo(gt.y)), y3 = (o[et][3] - mean) * rstd * gg.w * silu(bfhi(gt.y));
        *(uint2*)(H + row * 1024 + h * 128 + e) = make_uint2(pk2(y0, y1), pk2(y2, y3));
    }
    __syncthreads();
}

__device__ __forceinline__ void glds16_asm(const void* gsrc, unsigned lds_dst) {
    unsigned keep;
    asm volatile("s_mov_b32 %0, m0\n\ts_mov_b32 m0, %2\n\ts_nop 0\n\tglobal_load_lds_dwordx4 %1, off\n\ts_mov_b32 m0, %0" : "=&s"(keep) : "v"(gsrc), "s"(lds_dst) : "memory");
}
__device__ __forceinline__ void mem_attn(const Params& p, int unit, int layer, char* lds) {
    const int tid = TIDX(), lane = tid & 63, w = tid >> 6, g = lane >> 4, lc = lane & 15;
    const bf16_t* Q; int ldq;
    if (layer == 0) { Q = (const bf16_t*)(p.ws + W_RA) + 3072; ldq = NRET; } else { Q = (const bf16_t*)(p.ws + W_QM) + 768; ldq = 1024; }
    int bb, h, r0, npass; bool all8;
    if (unit < 256) { const int b = unit >> 5; h = (unit >> 3) & 3; bb = b; r0 = b * 4096 + (unit & 7) * 512; npass = 4; all8 = true; }
    else { const int us = unit - 256, b = us >> 2; h = us & 3; bb = 8 + b; r0 = TP + b * 64; npass = 1; all8 = false; }
    const bf16_t* mk = (const bf16_t*)(p.ws + W_MK) + (size_t)(layer * 24 + bb) * 65536 + h * 64;
    const bf16_t* mv = (const bf16_t*)(p.ws + W_MVT) + (size_t)((layer * 24 + bb) * 4 + h) * 16384;
    bf16_t* H = (bf16_t*)(p.ws + W_H);
    const float sc = 0.125f * 1.44269504089f;
    asm volatile("s_waitcnt vmcnt(0) lgkmcnt(0)" ::: "memory");
    __syncthreads();
    {
        const unsigned lds_w = (unsigned)__builtin_amdgcn_readfirstlane((int)(unsigned)(size_t)(LAS char*)lds + (tid & ~63) * 16);
#pragma unroll
        for (int i = 0; i < 4; ++i) {
            const int kr = (tid >> 3) + 64 * i, kc = (tid & 7) ^ ((kr >> 1) & 7);
            glds16_asm(mk + (size_t)kr * 256 + kc * 8, lds_w + i * 8192);
            const int vr = (tid >> 5) + 16 * i, vc = (tid & 31) ^ (vr & 15);
            glds16_asm(mv + (size_t)vr * 256 + vc * 8, lds_w + 32768 + i * 8192);
        }
    }
    const bf16_t* Ks = (const bf16_t*)lds; const bf16_t* Vs = (const bf16_t*)(lds + 32768);
    const bool act = all8 || w < 4;
    const size_t rowb = (size_t)r0 + 16 * (all8 ? w : (w & 3)) + lc;
    bf16x8 qf[2];
#pragma unroll
    for (int s = 0; s < 2; ++s) qf[s] = ld8(Q + rowb * ldq + h * 64 + 32 * s + 8 * g);
#pragma unroll
    for (int s = 0; s < 2; ++s) asm volatile("" : "+v"(qf[s]));
    asm volatile("s_waitcnt vmcnt(0)" ::: "memory");
    __syncthreads();
    for (int it = 0; it < npass; ++it) {
        const size_t row = rowb + (size_t)it * 128;
        bf16x8 qn[2];
        if (it + 1 < npass) {
#pragma unroll
            for (int s = 0; s < 2; ++s) qn[s] = ld8(Q + (row + 128) * ldq + h * 64 + 32 * s + 8 * g);
        }
        if (act) {
            f32x4 st[16];
            float mx = -3.0e38f;
#pragma unroll
            for (int t = 0; t < 16; ++t) {
                st[t] = (f32x4){0.f, 0.f, 0.f, 0.f};
#pragma unroll
                for (int s = 0; s < 2; ++s) st[t] = MFMA16(ld8(Ks + (16 * t + lc) * 64 + ((4 * s + g) ^ ((lc >> 1) & 7)) * 8), qf[s], st[t]);
                mx = fmaxf(mx, fmaxf(fmaxf(st[t][0], st[t][1]), fmaxf(st[t][2], st[t][3])));
            }
            mx = xr16_32_max(mx) * sc;
            float sum = 0.f;
#pragma unroll
            for (int t = 0; t < 16; ++t)
#pragma unroll
                for (int r = 0; r < 4; ++r) { st[t][r] = __builtin_amdgcn_exp2f(st[t][r] * sc - mx); sum += st[t][r]; }
            const float inv = 1.f / xr16_32_sum(sum);
            f32x4 o[4];
#pragma unroll
            for (int dt = 0; dt < 4; ++dt) o[dt] = (f32x4){0.f, 0.f, 0.f, 0.f};
#pragma unroll
            for (int s = 0; s < 8; ++s) {
                const bf16x8 pb = pack8(st[2 * s] * inv, st[2 * s + 1] * inv);
#pragma unroll
                for (int dt = 0; dt < 4; ++dt) { const bf16_t* vr = Vs + (16 * dt + lc) * 256 + (g & 1) * 4; o[dt] = MFMA16(ld44(vr + ((4 * s + (g >> 1)) ^ lc) * 8, vr + ((4 * s + (g >> 1) + 2) ^ lc) * 8), pb, o[dt]); }
            }
#pragma unroll
            for (int dt = 0; dt < 4; ++dt) *(uint2*)(H + row * 1024 + 768 + h * 64 + 16 * dt + 4 * g) = make_uint2(pk2(o[dt][0], o[dt][1]), pk2(o[dt][2], o[dt][3]));
        }
        if (it + 1 < npass) { qf[0] = qn[0]; qf[1] = qn[1]; }
    }
    __syncthreads();
}

__device__ __forceinline__ void diff_attn(const Params& p, int rowq0, int h, const bf16_t* Kp, const bf16_t* Vp, int ldv, int nkt, int nkt_lo, bool hi_active, float lam, char* lds) {
    const int tid = TIDX(), lane = tid & 63, w = tid >> 6, g = lane >> 4, lc = lane & 15;
    const bf16_t* QM = (const bf16_t*)(p.ws + W_QM);
    bf16_t* H = (bf16_t*)(p.ws + W_H);
    const size_t row = (size_t)rowq0 + 16 * (hi_active ? w : (w & 3)) + lc;
    const int my_nkt = w < 4 ? nkt_lo : (hi_active ? nkt : 0);
    const float sc = 0.125f * 1.44269504089f;
    bf16x8 qf[2][2];
#pragma unroll
    for (int c = 0; c < 2; ++c)
#pragma unroll
        for (int s = 0; s < 2; ++s) qf[c][s] = ld8(QM + row * 1024 + h * 128 + c * 64 + 32 * s + 8 * g);
    f32x4 o[2][8];
    float m[2] = {0.f, 0.f};
    f32x4 osum[2] = {(f32x4){0.f, 0.f, 0.f, 0.f}, (f32x4){0.f, 0.f, 0.f, 0.f}};
    const bf16x8 onesA = mk8(0x3F803F80u, 0x3F803F80u, 0x3F803F80u, 0x3F803F80u);
#pragma unroll
    for (int c = 0; c < 2; ++c)
#pragma unroll
        for (int dt = 0; dt < 8; ++dt) o[c][dt] = (f32x4){0.f, 0.f, 0.f, 0.f};
    const int kkey = tid >> 4, kdc = tid & 15;
    const int vdim = tid >> 3, vkc = tid & 7;
    const bf16_t* kg0 = Kp + (size_t)kkey * 768 + (kdc ^ (kkey & 15)) * 8;
    const bf16_t* vg0 = Vp + (size_t)vdim * ldv + (vkc ^ (vdim & 7)) * 8;
    const unsigned lds_w = (unsigned)__builtin_amdgcn_readfirstlane((int)(unsigned)(size_t)(LAS char*)lds + (tid & ~63) * 16);
#define DA_ISSUE(vt_) do { const int st_ = (vt_) & 3; const int tt_ = (vt_) < nkt ? (vt_) : nkt - 1; \
        const bf16_t* kg_ = kg0 + (size_t)tt_ * (64 * 768); const bf16_t* vg_ = vg0 + tt_ * 64; const unsigned dst_ = lds_w + st_ * 32768; \
        glds16_asm(kg_, dst_); glds16_asm(kg_ + 32 * 768, dst_ + 8192); glds16_asm(vg_, dst_ + 16384); glds16_asm(vg_ + (size_t)64 * ldv, dst_ + 16384 + 8192); } while (0)
#pragma unroll
    for (int c = 0; c < 2; ++c)
#pragma unroll
        for (int s = 0; s < 2; ++s) asm volatile("" : "+v"(qf[c][s]));
    asm volatile("s_waitcnt vmcnt(0) lgkmcnt(0)" ::: "memory");
    __syncthreads();
    DA_ISSUE(0); DA_ISSUE(1); DA_ISSUE(2);
    asm volatile("s_waitcnt vmcnt(8)" ::: "memory");
    __builtin_amdgcn_s_barrier();
    for (int kt = 0; kt < nkt; ++kt) {
        DA_ISSUE(kt + 3);
        if (kt < my_nkt) {
            const bf16_t* Ks = (const bf16_t*)(lds + (kt & 3) * 32768); const bf16_t* Vt = (const bf16_t*)(lds + (kt & 3) * 32768 + 16384);
            f32x4 st[2][4];
#pragma unroll
            for (int c = 0; c < 2; ++c)
#pragma unroll
                for (int t = 0; t < 4; ++t) {
                    st[c][t] = (f32x4){0.f, 0.f, 0.f, 0.f};
#pragma unroll
                    for (int s = 0; s < 2; ++s) st[c][t] = MFMA16(ld8(Ks + (16 * t + lc) * 128 + ((c * 8 + 4 * s + g) ^ lc) * 8), qf[c][s], st[c][t]);
                }
#pragma unroll
            for (int c = 0; c < 2; ++c) {
                const float mneg = -m[c];
#pragma unroll
                for (int t = 0; t < 4; ++t)
#pragma unroll
                    for (int r = 0; r < 4; ++r) st[c][t][r] = __builtin_fmaf(st[c][t][r], sc, mneg);
                float mx = -3.0e38f;
#pragma unroll
                for (int t = 0; t < 4; ++t) mx = fmaxf(mx, fmaxf(fmaxf(st[c][t][0], st[c][t][1]), fmaxf(st[c][t][2], st[c][t][3])));
                mx = xr16_32_max(mx);
                const bool first = kt == 0;
                if (first || __builtin_amdgcn_ballot_w64(mx > 8.f) != 0ull) {
                    const float d = first ? mx : fmaxf(mx, 0.f);
                    m[c] += d;
                    if (!first) {
                        const float al = __builtin_amdgcn_exp2f(-d);
                        osum[c] = osum[c] * al;
#pragma unroll
                        for (int dt = 0; dt < 8; ++dt) o[c][dt] = o[c][dt] * al;
                    }
#pragma unroll
                    for (int t = 0; t < 4; ++t)
#pragma unroll
                        for (int r = 0; r < 4; ++r) st[c][t][r] -= d;
                }
#pragma unroll
                for (int t = 0; t < 4; ++t)
#pragma unroll
                    for (int r = 0; r < 4; ++r) st[c][t][r] = __builtin_amdgcn_exp2f(st[c][t][r]);
            }
#pragma unroll
            for (int s = 0; s < 2; ++s) {
                const bf16x8 pb0 = pack8(st[0][2 * s], st[0][2 * s + 1]), pb1 = pack8(st[1][2 * s], st[1][2 * s + 1]);
                osum[0] = MFMA16(onesA, pb0, osum[0]); osum[1] = MFMA16(onesA, pb1, osum[1]);
#pragma unroll
                for (int dt = 0; dt < 8; ++dt) {
                    const bf16_t* vr = Vt + (16 * dt + lc) * 64 + (g & 1) * 4;
                    const bf16x8 va = ld44(vr + ((4 * s + (g >> 1)) ^ (lc & 7)) * 8, vr + ((4 * s + (g >> 1) + 2) ^ (lc & 7)) * 8);
                    o[0][dt] = MFMA16(va, pb0, o[0][dt]); o[1][dt] = MFMA16(va, pb1, o[1][dt]);
                }
            }
        }
        asm volatile("s_waitcnt vmcnt(8) lgkmcnt(0)" ::: "memory");
        __builtin_amdgcn_s_barrier();
    }
    asm volatile("s_waitcnt vmcnt(0)" ::: "memory");
    if (my_nkt > 0) {
        const float i0 = 1.f / osum[0][0], i1 = lam / osum[1][0];
        float sq = 0.f;
#pragma unroll
        for (int dt = 0; dt < 8; ++dt)
#pragma unroll
            for (int r = 0; r < 4; ++r) { const float v = o[0][dt][r] * i0 - o[1][dt][r] * i1; o[0][dt][r] = v; sq += v * v; }
        const float rs = rsqrtf(xr16_32_sum(sq) * (1.f / 128.f) + 1e-5f) * (1.f - LAM_INIT);
        const float* sg = p.in[15];
#pragma unroll
        for (int dt = 0; dt < 8; ++dt) {
            const int e = 16 * dt + 4 * g;
            const float4 gg = *(const float4*)(sg + e);
            *(uint2*)(H + row * 1024 + h * 128 + e) = make_uint2(pk2(o[0][dt][0] * rs * gg.x, o[0][dt][1] * rs * gg.y), pk2(o[0][dt][2] * rs * gg.z, o[0][dt][3] * rs * gg.w));
        }
    }
#undef DA_ISSUE
}

__device__ __forceinline__ void phase_ln(const Params& p, const float* gam, const float* bet, const bf16_t* Zb, bf16_t* Xd, bool fin) {
    const int lane = TIDX() & 63, w = TIDX() >> 6;
    float4 gg[4], bb[4];
#pragma unroll
    for (int i = 0; i < 4; ++i) { gg[i] = ((const float4*)gam)[lane + 64 * i]; bb[i] = ((const float4*)bet)[lane + 64 * i]; }
    for (int row = BIDX() * 8 + w; row < TT; row += gridDim.x * 8) {
        const uint2* z = (const uint2*)(Zb + (size_t)row * 1024);
        float4 v[4]; float s = 0.f;
#pragma unroll
        for (int i = 0; i < 4; ++i) { const uint2 u = z[lane + 64 * i]; v[i] = make_float4(bflo(u.x), bfhi(u.x), bflo(u.y), bfhi(u.y)); s += (v[i].x + v[i].y) + (v[i].z + v[i].w); }
        const float mean = wave_sum(s) * (1.f / 1024.f);
        float q = 0.f;
#pragma unroll
        for (int i = 0; i < 4; ++i) { v[i].x -= mean; v[i].y -= mean; v[i].z -= mean; v[i].w -= mean; q += (v[i].x * v[i].x + v[i].y * v[i].y) + (v[i].z * v[i].z + v[i].w * v[i].w); }
        const float rstd = rsqrtf(wave_sum(q) * (1.f / 1024.f) + 1e-5f);
        uint2* xd = (uint2*)(Xd + (size_t)row * 1024);
        float4* yo = (float4*)(p.out + (size_t)row * 1024);
#pragma unroll
        for (int i = 0; i < 4; ++i) {
            float4 y; y.x = v[i].x * rstd * gg[i].x + bb[i].x; y.y = v[i].y * rstd * gg[i].y + bb[i].y; y.z = v[i].z * rstd * gg[i].z + bb[i].z; y.w = v[i].w * rstd * gg[i].w + bb[i].w;
            if (fin) yo[lane + 64 * i] = y; else xd[lane + 64 * i] = make_uint2(pk2(y.x, y.y), pk2(y.z, y.w));
        }
    }
}

__device__ __forceinline__ int next_unit(int* ctr, char* lds) {
    int* slot = (int*)(lds + LDS_MAIN);
    if (TIDX() == 0) *slot = atomicAdd(ctr, 1);
    __syncthreads();
    const int u = *slot;
    __syncthreads();
    return u;
}


#define XB_TMO      128
#define XB_XCNT(j)  (256  + 64 * (j))
#define XB_XSUB(j)  (1280 + 64 * (j))
#define XB_XGEN(j)  (2304 + 64 * (j))
#define XB_TOP      3328
#define XB_TOPGEN   3392
#define XCD_BAR_WORDS 3456
#define XB_SPIN_CAP (1u << 18)
__device__ __forceinline__ unsigned xb_ld(unsigned* p)              { return __hip_atomic_load(p, __ATOMIC_RELAXED, __HIP_MEMORY_SCOPE_AGENT); }
__device__ __forceinline__ unsigned xb_add(unsigned* p, unsigned v) { return __hip_atomic_fetch_add(p, v, __ATOMIC_RELAXED, __HIP_MEMORY_SCOPE_AGENT); }
__device__ __forceinline__ unsigned xb_xcc_id() { return (unsigned)__builtin_amdgcn_s_getreg((3 << 11) | 20) & 0xFu; }
#define XB_SPIN(cond, bar) do { unsigned _sp = 0; while (cond) { __builtin_amdgcn_s_sleep(1); \
    if ((++_sp & 255u) == 0u) { if (xb_ld(&(bar)[XB_TMO])) break; if (_sp > XB_SPIN_CAP) { atomicAdd(&(bar)[XB_TMO], 1u); break; } } } } while (0)
struct XcdBarrier { unsigned* bar; unsigned x; volatile LAS unsigned* st; };
__device__ __forceinline__ XcdBarrier xcd_barrier_post(unsigned* bar, volatile LAS unsigned* st) {
    XcdBarrier b; b.bar = bar; b.x = xb_xcc_id(); b.st = st;
    if (TIDX() == 0) (void)xb_add(&bar[XB_XCNT(b.x)], 1u);
    return b;
}
__device__ __forceinline__ void xcd_barrier_complete(unsigned* bar, unsigned x, unsigned& nloc, unsigned& nx) {
    const unsigned G = gridDim.x * gridDim.y * gridDim.z;
    unsigned sum, cnt, mine, sp = 0u;
    for (;;) {
        sum = 0u; cnt = 0u; mine = 0u;
#pragma unroll
        for (unsigned j = 0; j < 16; ++j) { const unsigned c = xb_ld(&bar[XB_XCNT(j)]); sum += c; cnt += (c > 0u) ? 1u : 0u; mine = (j == x) ? c : mine; }
        if (sum == G) break;
        __builtin_amdgcn_s_sleep(1);
        if ((++sp & 255u) == 0u) { if (xb_ld(&bar[XB_TMO])) break; if (sp > XB_SPIN_CAP) { atomicAdd(&bar[XB_TMO], 1u); break; } }
    }
    nloc = mine > 0u ? mine : 1u; nx = cnt > 0u ? cnt : 1u;
}
__device__ __forceinline__ void xcd_barrier(const XcdBarrier& b) {
    asm volatile("s_waitcnt vmcnt(0)" ::: "memory");
    __syncthreads();
    if (TIDX() == 0) {
        unsigned* bar = b.bar;
        __builtin_amdgcn_s_waitcnt(0);
        unsigned nloc = b.st[0], nx = b.st[1];
        if (nloc == 0u) { xcd_barrier_complete(bar, b.x, nloc, nx); b.st[0] = nloc; b.st[1] = nx; }
        const unsigned old = xb_add(&bar[XB_XSUB(b.x)], 1u);
        const unsigned gen = old / nloc;
        if (old + 1u == (gen + 1u) * nloc) {
            __builtin_amdgcn_fence(__ATOMIC_RELEASE, "agent");
            asm volatile("s_waitcnt vmcnt(0)" ::: "memory");
            const unsigned og = xb_add(&bar[XB_TOP], 1u);
            const unsigned tg = og / nx;
            if (og + 1u == (tg + 1u) * nx) xb_add(&bar[XB_TOPGEN], 1u);
            else XB_SPIN(xb_ld(&bar[XB_TOPGEN]) == tg, bar);
            __builtin_amdgcn_fence(__ATOMIC_ACQUIRE, "agent");
            xb_add(&bar[XB_XGEN(b.x)], 1u);
            asm volatile("s_waitcnt vmcnt(0)" ::: "memory");
        } else {
            XB_SPIN(xb_ld(&bar[XB_XGEN(b.x)]) == gen, bar);
            __builtin_amdgcn_fence(__ATOMIC_ACQUIRE, "agent");
            asm volatile("s_waitcnt vmcnt(0)" ::: "memory");
        }
    }
    __syncthreads();
}

constexpr int MA_P2 = 160;
__device__ __forceinline__ void run_phase(const Params& p_, const int ph, const int l, char* lds, const int cslot = 0) {
    Params p = p_;
    asm volatile("" : "+s"(p.ws), "+s"(p.out));
    char* ws = p.ws;
    bf16_t* XB = (bf16_t*)(ws + W_XB); bf16_t* Hb = (bf16_t*)(ws + W_H); bf16_t* RA = (bf16_t*)(ws + W_RA);
    int* ctr = (int*)(ws + W_CTRL);
    switch (ph) {
    case 0: phase_prep(p, lds); break;
    case 1: {
        gemm_phase(XB, (const bf16_t*)(ws + W_WRET), 1024, TT / 256, NRET / 256, lds, EpiBf16{RA, NRET});
        for (int ll = 0; ll < 2; ++ll)
            gemm_phase((const bf16_t*)(ws + W_MB), (const bf16_t*)(ws + W_WMKV) + (size_t)ll * 512 * 1024, 1024, 8, 2, lds,
                       EpiMemKV{p.out + O_MKP + (size_t)ll * 524288, p.out + O_MVP + (size_t)ll * 524288, (bf16_t*)(ws + W_MK) + (size_t)ll * 24 * 65536, (bf16_t*)(ws + W_MVT) + (size_t)ll * 24 * 65536},
                       (1716 % 256 + 16 * ll) % (int)gridDim.x);
    } break;
    case 2: {
        bf16_t* RS = (bf16_t*)(p.out + O_DKP);
        for (;;) {
            const int u = next_unit(ctr + 0 + cslot, lds);
            if (u >= 192 + 384 + MA_P2) break;
            if (u < 576) {
                const bool pr = u < 192; const int us = pr ? u : u - 192, chain = us >> 2, sl = us & 3, b = chain / 6, h = chain % 6;
                ret_chain(p, h, sl, pr ? 64 : 1, pr ? b * 4096 : TP + b * 64, pr ? 0 : 1024, pr ? nullptr : p.in[3] + (size_t)chain * 16384,
                          RS + (pr ? (size_t)chain * 64 : (size_t)(3072 + chain)) * 16384, p.out + (pr ? O_RSP : O_RSS) + (size_t)chain * 16384, lds);
            }
            else mem_attn(p, u - 576, 0, lds);
        }
    } break;
    case 3: {
        for (int u2 = BIDX(); u2 < 1584; u2 += gridDim.x) ret_out(p, u2, lds);
        const int busy = (int)gridDim.x <= 1584 ? 1584 % (int)gridDim.x : 0;
        if (BIDX() >= busy)
            for (;;) { const int u = next_unit(ctr + 2, lds); if (u >= 320 - MA_P2) break; mem_attn(p, MA_P2 + u, 0, lds); }
    } break;
    case 4: gemm_phase(Hb, (const bf16_t*)(ws + W_WO) + (size_t)l * 1024 * 1024, 1024, TT / 256, 4, lds, EpiResid{XB, RA}); break;
    case 5: phase_ln(p, p.in[18] + l * 1024, p.in[19] + l * 1024, RA, Hb, false); break;
    case 6: gemm_phase(Hb, (const bf16_t*)(ws + W_WGU) + (size_t)l * 5632 * 1024, 1024, TT / 256, 22, lds, EpiGU{RA}); break;
    case 7: gemm_phase(RA, (const bf16_t*)(ws + W_WD) + (size_t)l * 1024 * DFF, DFF, TT / 256, 4, lds, EpiResid{Hb, XB}); break;
    case 8: phase_ln(p, p.in[23] + l * 1024, p.in[24] + l * 1024, XB, XB, l == 1); break;
    case 9: {
        { uint2* dst = (uint2*)(ws + W_KBS); const float4* s = (const float4*)p.in[4];
          const int skip = (int)gridDim.x > 80 ? 40 : 0, cb = BIDX() - skip, ncb = (int)gridDim.x - skip;
          const size_t per = 1024ull * 192, gt = (size_t)cb * NTHR + TIDX(), gs = (size_t)ncb * NTHR;
          if (cb >= 0) for (size_t i = gt; i < 16 * per; i += gs) { const size_t b = i / per, rem = i - b * per; const float4 v = s[i]; dst[b * (1088ull * 192) + rem] = make_uint2(pk2(v.x, v.y), pk2(v.z, v.w)); } }
        { const int tid = TIDX(), half = tid >> 8;
          const int skip = (int)gridDim.x > 80 ? 40 : 0, cb = BIDX() - skip, ncb = (int)gridDim.x - skip;
          if (cb >= 0) for (int it2 = cb; it2 < 1536; it2 += ncb) {
              const int it = 2 * it2 + half, bh = it >> 5, q = it & 31, jt = q >> 1, dt = q & 1, b = bh / 6, h = bh % 6;
              transpose_tile(p.in[5] + (size_t)b * 1024 * 768 + h * 128, 768, (bf16_t*)(ws + W_VTS) + (size_t)bh * 128 * 1088, 1088, jt * 64, dt * 64, 0, 0, (float*)lds + half * 4224, tid & 255);
          } }
        gemm_phase(XB, (const bf16_t*)(ws + W_WDIFF), 1024, TT / 256, NDIFF / 256, lds,
                   EpiProj1{(bf16_t*)(ws + W_QM), (bf16_t*)(ws + W_KBP), (bf16_t*)(ws + W_KBS), (bf16_t*)(ws + W_VTP), (bf16_t*)(ws + W_VTS), p.out, (const float2*)(ws + W_ROPED)});
    } break;
    case 10: {
        float lam;
        { const int lane = TIDX() & 63; const float a = wave_sum(p.in[11][lane] * p.in[12][lane]), b = wave_sum(p.in[13][lane] * p.in[14][lane]); lam = expf(a) - expf(b) + LAM_INIT; }
        for (;;) {
            const int u = next_unit(ctr + 1 + cslot, lds);
            if (u >= 1536 + 96 + 320) break;
            if (u < 1632) {
                const bool pr = u >= 96; const int up = u - 96, qp = 31 - up / 48, bh = pr ? up % 48 : u, b = bh / 6, h = bh % 6;
                diff_attn(p, pr ? b * 4096 + qp * 128 : TP + b * 64, h,
                          pr ? (const bf16_t*)(ws + W_KBP) + (size_t)b * 4096 * 768 + h * 128 : (const bf16_t*)(ws + W_KBS) + (size_t)b * 1088 * 768 + h * 128,
                          pr ? (const bf16_t*)(ws + W_VTP) + (size_t)bh * 128 * 4096 : (const bf16_t*)(ws + W_VTS) + (size_t)bh * 128 * 1088,
                          pr ? 4096 : 1088, pr ? 2 * qp + 2 : 17, pr ? 2 * qp + 1 : 17, pr, lam, lds);
            }
            else mem_attn(p, u - 1632, 1, lds);
        }
    } break;
    default: break;
    }
}

#ifndef PROBE_PH
#define PROBE_PH -1
#endif
extern "C" __global__ void __launch_bounds__(512, 2) mega_fwd(Params p) {
    extern __shared__ __attribute__((aligned(16))) char lds[];
    cg::grid_group grid = cg::this_grid();
    volatile LAS unsigned* xst = (volatile LAS unsigned*)(lds + LDS_MAIN + 16);
    if (TIDX() == 0) { xst[0] = 0u; xst[1] = 0u; }
    __syncthreads();
    (void)xcd_barrier_post((unsigned*)(p.ws + W_CTRL), xst);
#define XBAR() do { XcdBarrier xb_; xb_.bar = (unsigned*)(p.ws + W_CTRL); xb_.x = xb_xcc_id(); xb_.st = (volatile LAS unsigned*)(lds + LDS_MAIN + 16); xcd_barrier(xb_); } while (0)
    run_phase(p, 0, 0, lds);
    if (p.ph_lo != 0) grid.sync();
    XBAR();
#if PROBE_PH == 0
    run_phase(p, 0, 0, lds); XBAR();
#endif
    run_phase(p, 1, 0, lds); XBAR();
    run_phase(p, 2, 0, lds); XBAR();
#if PROBE_PH == 2
    run_phase(p, 2, 0, lds, 2); XBAR();
#endif
    run_phase(p, 3, 0, lds); XBAR();
#if PROBE_PH == 3
    run_phase(p, 3, 0, lds); XBAR();
#endif
    run_phase(p, 4, 0, lds); XBAR();
    run_phase(p, 5, 0, lds); XBAR();
    run_phase(p, 6, 0, lds); XBAR();
    run_phase(p, 7, 0, lds); XBAR();
    run_phase(p, 8, 0, lds); XBAR();
    run_phase(p, 9, 1, lds); XBAR();
    run_phase(p, 10, 1, lds); XBAR();
    run_phase(p, 4, 1, lds); XBAR();
    run_phase(p, 5, 1, lds); XBAR();
    run_phase(p, 6, 1, lds); XBAR();
    run_phase(p, 7, 1, lds); XBAR();
    run_phase(p, 8, 1, lds);
}

#ifndef PROBE_PH
#define PROBE_PH -1
#endif
#ifndef MULTI_LAUNCH
#define MULTI_LAUNCH 0
#endif
#if MULTI_LAUNCH
extern "C" __global__ void __launch_bounds__(512, 2) phase_kernel(Params p) {
    extern __shared__ __attribute__((aligned(16))) char lds[];
    switch (p.ph_lo) {
    case 0: run_phase(p, 0, 0, lds); break;
    case 1: run_phase(p, 1, 0, lds); break;
    case 2: run_phase(p, 2, 0, lds); break;
    case 3: run_phase(p, 3, 0, lds); break;
    case 4: run_phase(p, 4, p.ph_hi, lds); break;
    case 5: run_phase(p, 5, p.ph_hi, lds); break;
    case 6: run_phase(p, 6, p.ph_hi, lds); break;
    case 7: run_phase(p, 7, p.ph_hi, lds); break;
    case 8: run_phase(p, 8, p.ph_hi, lds); break;
    case 9: run_phase(p, 9, 1, lds); break;
    case 10: run_phase(p, 10, 1, lds); break;
    default: break;
    }
}
#endif

extern "C" void kernel_launch(void* const* d_in, const int* in_sizes, int n_in, void* d_out, int out_size, void* d_ws, size_t ws_size, hipStream_t stream) {
    static int grid = 0;
#if MULTI_LAUNCH
    const void* kfn = (const void*)phase_kernel;
#else
    const void* kfn = (const void*)mega_fwd;
#endif
    if (grid == 0) {
        int dev = 0, cus = 0, per_cu = 0;
        (void)hipGetDevice(&dev);
        (void)hipDeviceGetAttribute(&cus, hipDeviceAttributeMultiprocessorCount, dev);
        (void)hipFuncSetAttribute(kfn, hipFuncAttributeMaxDynamicSharedMemorySize, LDS_BYTES);
        (void)hipOccupancyMaxActiveBlocksPerMultiprocessor(&per_cu, kfn, NTHR, LDS_BYTES);
        if (per_cu < 1) { fprintf(stderr, "kernel_launch: occupancy query reports %d blocks per CU\n", per_cu); per_cu = 1; }
        grid = cus;
        if (ws_size < W_END) { fprintf(stderr, "kernel_launch: workspace too small: %zu < %zu\n", ws_size, (size_t)W_END); grid = -1; }
    }
    if (grid < 0) return;
    (void)hipMemsetAsync((char*)d_ws + W_CTRL, 0, 16384, stream);
    Params p{};
    for (int i = 0; i < 25; ++i) p.in[i] = (const float*)d_in[i];
    p.out = (float*)d_out; p.ws = (char*)d_ws; p.ph_lo = 0; p.ph_hi = 16;
#if MULTI_LAUNCH
    static const int seq[16][2] = {{0,0},{1,0},{2,0},{3,0},{4,0},{5,0},{6,0},{7,0},{8,0},{9,1},{10,1},{4,1},{5,1},{6,1},{7,1},{8,1}};
    for (int i = 0; i < 16; ++i) {
        p.ph_lo = seq[i][0]; p.ph_hi = seq[i][1];
        hipLaunchKernelGGL(phase_kernel, dim3(grid), dim3(NTHR), LDS_BYTES, stream, p);
    }
#else
    void* args[] = {&p};
    hipError_t e = hipLaunchCooperativeKernel(kfn, dim3(grid), dim3(NTHR), args, LDS_BYTES, stream);
    if (e != hipSuccess) fprintf(stderr, "cooperative launch failed: %s (grid %d)\n", hipGetErrorString(e), grid);
#endif
}
```

```cpp
#include <hip/hip_runtime.h>
#include <hip/hip_cooperative_groups.h>
#include <stdint.h>
#include <stdio.h>
namespace cg = cooperative_groups;

typedef unsigned short bf16_t;
typedef short bf16x8 __attribute__((ext_vector_type(8)));
typedef float f32x4 __attribute__((ext_vector_type(4)));
typedef float f32x16 __attribute__((ext_vector_type(16)));
#define LAS __attribute__((address_space(3)))

#define MFMA32(a, b, c) __builtin_amdgcn_mfma_f32_32x32x16_bf16(a, b, c, 0, 0, 0)
#define MFMA16(a, b, c) __builtin_amdgcn_mfma_f32_16x16x32_bf16(a, b, c, 0, 0, 0)

constexpr int TP = 32768, TS = 1024, TT = TP + TS;
constexpr int NRET = 3328, NDIFF = 2560, DFF = 2816;
constexpr float ALPHA = 1.41421356237f;
constexpr float LAM_INIT = 0.35550907f;
constexpr int NTHR = 512;
constexpr int LDS_MAIN = 131072, LDS_BYTES = LDS_MAIN + 256;

constexpr size_t O_YP = 0, O_RSP = 34603008, O_RSS = 35389440, O_DKP = 36962304, O_DVP = 62128128,
                 O_DKS = 87293952, O_DVS = 88080384, O_MKP = 88866816, O_MVP = 89915392;
constexpr size_t W_CTRL = 0;
constexpr size_t W_ROPER = 16384;
constexpr size_t W_ROPED = W_ROPER + 4096ull * 64 * 8;
constexpr size_t W_WRET = W_ROPED + 4096ull * 8 * 8;
constexpr size_t W_WDIFF = W_WRET + (size_t)NRET * 1024 * 2;
constexpr size_t W_WMKV = W_WDIFF + (size_t)NDIFF * 1024 * 2;
constexpr size_t W_WO = W_WMKV + 2ull * 512 * 1024 * 2;
constexpr size_t W_WGU = W_WO + 2ull * 1024 * 1024 * 2;
constexpr size_t W_WD = W_WGU + 2ull * 5632 * 1024 * 2;
constexpr size_t W_MB = W_WD + 2ull * 1024 * 2816 * 2;
constexpr size_t W_MK = W_MB + 2048ull * 1024 * 2;
constexpr size_t W_MVT = W_MK + 2ull * 24 * 65536 * 2;
constexpr size_t W_XB = W_MVT + 2ull * 24 * 65536 * 2;
constexpr size_t W_H = W_XB + (size_t)TT * 1024 * 2;
constexpr size_t W_RA = W_H + (size_t)TT * 1024 * 2;
constexpr size_t W_END = W_RA + (size_t)TT * NRET * 2;
constexpr size_t W_QM = W_RA;
constexpr size_t W_KBP = W_QM + (size_t)TT * 1024 * 2;
constexpr size_t W_KBS = W_KBP + 8ull * 4096 * 768 * 2;
constexpr size_t W_VTP = W_KBS + 16ull * 1088 * 768 * 2;
constexpr size_t W_VTS = W_VTP + 8ull * 6 * 128 * 4096 * 2;
static_assert(W_VTS + 16ull * 6 * 128 * 1088 * 2 <= W_END, "layer-1 overlay too big");

struct Params {
    const float* in[25];
    float* out;
    char* ws;
    int ph_lo, ph_hi;
};

__device__ __forceinline__ int TIDX() { int t = threadIdx.x; asm volatile("" : "+v"(t)); return t; }
__device__ __forceinline__ int BIDX() { int t = blockIdx.x; asm volatile("" : "+s"(t)); return t; }
typedef __bf16 bf2_t __attribute__((ext_vector_type(2)));
typedef float f2_t __attribute__((ext_vector_type(2)));
__device__ __forceinline__ uint32_t pk2(float lo, float hi) { f2_t f = {lo, hi}; bf2_t b = __builtin_convertvector(f, bf2_t); return *(uint32_t*)&b; }
__device__ __forceinline__ bf16_t f2bf(float f) { return (bf16_t)(pk2(f, 0.f) & 0xffffu); }
__device__ __forceinline__ float bf2f(bf16_t b) { return __uint_as_float(((uint32_t)b) << 16); }
__device__ __forceinline__ float bflo(uint32_t u) { return __uint_as_float(u << 16); }
__device__ __forceinline__ float bfhi(uint32_t u) { return __uint_as_float(u & 0xffff0000u); }
__device__ __forceinline__ bf16x8 mk8(uint32_t a, uint32_t b, uint32_t c, uint32_t d) { uint4 u = make_uint4(a, b, c, d); return *(bf16x8*)&u; }
__device__ __forceinline__ bf16x8 pack8(f32x4 a, f32x4 b) { return mk8(pk2(a[0], a[1]), pk2(a[2], a[3]), pk2(b[0], b[1]), pk2(b[2], b[3])); }
__device__ __forceinline__ bf16x8 ld8(const bf16_t* p) { return *(const bf16x8*)p; }
__device__ __forceinline__ bf16x8 ld44(const bf16_t* lo, const bf16_t* hi) { uint2 a = *(const uint2*)lo, b = *(const uint2*)hi; return mk8(a.x, a.y, b.x, b.y); }
__device__ __forceinline__ float xr16_32_max(float v) { v = fmaxf(v, __shfl_xor(v, 16)); v = fmaxf(v, __shfl_xor(v, 32)); return v; }
__device__ __forceinline__ float xr16_32_sum(float v) { v += __shfl_xor(v, 16); v += __shfl_xor(v, 32); return v; }
__device__ __forceinline__ float wave_sum(float v) { for (int o = 1; o < 64; o <<= 1) v += __shfl_xor(v, o); return v; }
__device__ __forceinline__ void unpack8(uint4 u, float* f) { f[0] = bflo(u.x); f[1] = bfhi(u.x); f[2] = bflo(u.y); f[3] = bfhi(u.y); f[4] = bflo(u.z); f[5] = bfhi(u.z); f[6] = bflo(u.w); f[7] = bfhi(u.w); }
__device__ __forceinline__ float silu(float x) { return x / (1.f + __expf(-x)); }

constexpr int G_BK = 64, G_HT = 128 * 64;
__device__ __forceinline__ int lds_byte(int r, int c) { const int st = (r >> 4) * 2 + (c >> 5), rr = r & 15, cc = c & 31, ob = rr * 64 + cc * 2; return st * 1024 + (ob ^ (((ob >> 9) & 1) << 5)); }
__device__ __forceinline__ void stage_rc(int b, int& R, int& C) { const int st = b / 1024, sb = b % 1024, swz = sb ^ (((sb >> 9) & 1) << 5); R = (st >> 1) * 16 + swz / 64; C = (st & 1) * 32 + (swz % 64) / 2; }

template <class Epi>
__device__ __forceinline__ void gemm256_tile(const bf16_t* __restrict__ A, const bf16_t* __restrict__ Bt, const int K, const int brow, const int bcol, const bool pre, const int nrow, const int ncol, char* lds, const Epi& epi) {
    bf16_t* shm = (bf16_t*)lds;
#define SA(b, h) (shm + ((b) * 2 + (h)) * G_HT)
#define SB(b, h) (shm + (4 + (b) * 2 + (h)) * G_HT)
#define STAGE(P, BASE, br, kt) do { const long _g = (long)(br) * K + (long)(kt) * G_BK; \
    _Pragma("unroll") for (int _i = 0; _i < 2; ++_i) { const int _b = tid * 16 + _i * 8192; int _r, _c; stage_rc(_b, _r, _c); \
      __builtin_amdgcn_global_load_lds((const unsigned*)(BASE + _g + (long)_r * K + _c), (__attribute__((address_space(3))) unsigned*)((char*)(P) + _b), 16, 0, 0); } } while (0)
#define LDA(dst, b, h) _Pragma("unroll") for (int m = 0; m < 4; ++m) _Pragma("unroll") for (int k = 0; k < 2; ++k) \
    dst[m][k] = *reinterpret_cast<const bf16x8*>((char*)SA(b, h) + lds_byte(wr * 64 + m * 16 + fr, k * 32 + fq * 8))
#define LDB(dst, b, h) _Pragma("unroll") for (int n = 0; n < 2; ++n) _Pragma("unroll") for (int k = 0; k < 2; ++k) \
    dst[n][k] = *reinterpret_cast<const bf16x8*>((char*)SB(b, h) + lds_byte(wc * 32 + n * 16 + fr, k * 32 + fq * 8))
#define MMA(ai, bj, At_, Bt_) do { __builtin_amdgcn_s_setprio(1); \
    _Pragma("unroll") for (int m = 0; m < 4; ++m) _Pragma("unroll") for (int n = 0; n < 2; ++n) _Pragma("unroll") for (int k = 0; k < 2; ++k) \
      acc[ai][bj][m][n] = MFMA16(Bt_[n][k], At_[m][k], acc[ai][bj][m][n]); \
    __builtin_amdgcn_s_setprio(0); } while (0)
#define WAIT_V(n) asm volatile("s_waitcnt vmcnt(" #n ")" ::: "memory")
#define WAIT_L(n) asm volatile("s_waitcnt lgkmcnt(" #n ")" ::: "memory")
#define BAR __builtin_amdgcn_s_barrier()
#define SCHED __builtin_amdgcn_sched_barrier(0)
    const int tid = TIDX();
    const int wid = tid >> 6, lane = tid & 63, wr = wid >> 2, wc = wid & 3, fr = lane & 15, fq = lane >> 4;
    constexpr int HALF = 128;
    f32x4 acc[2][2][4][2];
#pragma unroll
    for (int a = 0; a < 2; ++a)
#pragma unroll
        for (int b = 0; b < 2; ++b)
#pragma unroll
            for (int m = 0; m < 4; ++m)
#pragma unroll
                for (int n = 0; n < 2; ++n) acc[a][b][m][n] = (f32x4){0.f, 0.f, 0.f, 0.f};
    bf16x8 At[4][2], B0[2][2], B1[2][2];
    const int nt = K / G_BK;
    asm volatile("s_waitcnt vmcnt(0) lgkmcnt(0)" ::: "memory");
    __syncthreads();
    if (!pre) {
        STAGE(SB(0, 0), Bt, bcol, 0); STAGE(SA(0, 0), A, brow, 0);
        STAGE(SB(0, 1), Bt, bcol + HALF, 0); STAGE(SA(0, 1), A, brow + HALF, 0);
    }
    if (wr == 1) BAR;
    WAIT_V(4); BAR;
    STAGE(SB(1, 0), Bt, bcol, 1); STAGE(SA(1, 0), A, brow, 1); STAGE(SB(1, 1), Bt, bcol + HALF, 1);
    WAIT_V(6); BAR;
    for (int t = 0; t < nt - 2; t += 2) {
        LDB(B0, 0, 0); SCHED; LDA(At, 0, 0); STAGE(SA(1, 1), A, brow + HALF, t + 1);
        WAIT_L(8); BAR; WAIT_L(0); MMA(0, 0, At, B0); BAR; SCHED;
        LDB(B1, 0, 1); STAGE(SB(0, 0), Bt, bcol, t + 2);
        BAR; WAIT_L(0); MMA(0, 1, At, B1); BAR;
        LDA(At, 0, 1); STAGE(SA(0, 0), A, brow, t + 2);
        BAR; WAIT_L(0); MMA(1, 0, At, B0); BAR; SCHED;
        STAGE(SB(0, 1), Bt, bcol + HALF, t + 2);
        WAIT_V(6); BAR; MMA(1, 1, At, B1); BAR;
        LDB(B0, 1, 0); SCHED; LDA(At, 1, 0); STAGE(SA(0, 1), A, brow + HALF, t + 2);
        WAIT_L(8); BAR; WAIT_L(0); MMA(0, 0, At, B0); BAR; SCHED;
        LDB(B1, 1, 1); STAGE(SB(1, 0), Bt, bcol, t + 3);
        BAR; WAIT_L(0); MMA(0, 1, At, B1); BAR;
        LDA(At, 1, 1); STAGE(SA(1, 0), A, brow, t + 3);
        BAR; WAIT_L(0); MMA(1, 0, At, B0); BAR; SCHED;
        STAGE(SB(1, 1), Bt, bcol + HALF, t + 3);
        WAIT_V(6); BAR; MMA(1, 1, At, B1); BAR;
    }
    { LDB(B0, 0, 0); LDA(At, 0, 0); STAGE(SA(1, 1), A, brow + HALF, nt - 1);
      BAR; WAIT_L(0); MMA(0, 0, At, B0); BAR;
      LDB(B1, 0, 1); BAR; WAIT_L(0); MMA(0, 1, At, B1); BAR;
      LDA(At, 0, 1); WAIT_V(4); BAR; WAIT_L(0); MMA(1, 0, At, B0); MMA(1, 1, At, B1); BAR; }
    { LDB(B0, 1, 0); LDA(At, 1, 0); WAIT_V(2); BAR; WAIT_L(0); MMA(0, 0, At, B0); BAR;
      LDB(B1, 1, 1); WAIT_V(0); BAR; WAIT_L(0); MMA(0, 1, At, B1); BAR;
      LDA(At, 1, 1); BAR; WAIT_L(0); MMA(1, 0, At, B0); MMA(1, 1, At, B1); BAR; }
    if (wr == 0) BAR;
    if (nrow >= 0) {
        STAGE(SB(0, 0), Bt, ncol, 0); STAGE(SA(0, 0), A, nrow, 0);
        STAGE(SB(0, 1), Bt, ncol + HALF, 0); STAGE(SA(0, 1), A, nrow + HALF, 0);
    }
    epi(acc, brow, bcol, wr, wc, fr, fq);
#undef SA
#undef SB
#undef STAGE
#undef LDA
#undef LDB
#undef MMA
}

__device__ __forceinline__ bool gemm_tile_coord(int i, int G, int c, int nM, int nN, int& pm, int& pn) {
    const int nwg = nM * nN; const long L = (long)i * G + c; if (L >= nwg) return false;
    int wgid = (int)L; { const int q = nwg / 8, r = nwg % 8, xcd = wgid % 8, off = wgid / 8; wgid = (xcd < r ? xcd * (q + 1) : r * (q + 1) + (xcd - r) * q) + off; }
    const int nig = 8 * nN, gid = wgid / nig, fm = gid * 8, gsz = (nM - fm) < 8 ? (nM - fm) : 8;
    pm = fm + ((wgid % nig) % gsz); pn = (wgid % nig) / gsz; return true;
}
template <class Epi>
__device__ __forceinline__ void gemm_phase(const bf16_t* A, const bf16_t* Bt, int K, int nM, int nN, char* lds, const Epi& epi, const int coff = 0) {
    const int G = gridDim.x, c = (BIDX() + G - coff) % G;
    int pm, pn; bool have = gemm_tile_coord(0, G, c, nM, nN, pm, pn), pre = false;
    for (int i = 0; have; ++i) {
        int qm = 0, qn = 0; const bool nxt = gemm_tile_coord(i + 1, G, c, nM, nN, qm, qn);
        gemm256_tile(A, Bt, K, pm * 256, pn * 256, pre, (Epi::PRESTAGE && nxt) ? qm * 256 : -1, qn * 256, lds, epi);
        pre = Epi::PRESTAGE && nxt; have = nxt; pm = qm; pn = qn;
    }
}

#define EPI_ARGS f32x4 (&acc)[2][2][4][2], int brow, int bcol, int wr, int wc, int fr, int fq
#define EPI_LOOP _Pragma("unroll") for (int ai = 0; ai < 2; ++ai) _Pragma("unroll") for (int bj = 0; bj < 2; ++bj) _Pragma("unroll") for (int m = 0; m < 4; ++m) _Pragma("unroll") for (int n = 0; n < 2; ++n)
#define EPI_ROW (brow + 128 * ai + 64 * wr + 16 * m + fr)
#define EPI_COL (bcol + 128 * bj + 32 * wc + 16 * n + 4 * fq)

struct EpiBf16 {
    static constexpr bool PRESTAGE = true;
    bf16_t* C; int ldc;
    __device__ __forceinline__ void operator()(EPI_ARGS) const {
        EPI_LOOP { const f32x4 v = acc[ai][bj][m][n]; *(uint2*)(C + (size_t)EPI_ROW * ldc + EPI_COL) = make_uint2(pk2(v[0], v[1]), pk2(v[2], v[3])); }
    }
};
struct EpiMemKV {
    static constexpr bool PRESTAGE = false;
    float* outk; float* outv; bf16_t* mk; bf16_t* mvt;
    __device__ __forceinline__ void operator()(EPI_ARGS) const {
        EPI_LOOP {
            const int row = EPI_ROW, col = EPI_COL; const f32x4 v = acc[ai][bj][m][n];
            if (bcol == 0) { *(f32x4*)(outk + (size_t)row * 256 + col) = v; *(uint2*)(mk + (size_t)row * 256 + col) = make_uint2(pk2(v[0], v[1]), pk2(v[2], v[3])); }
            else { const int c = col - 256, b = row >> 8, mm = row & 255; *(f32x4*)(outv + (size_t)row * 256 + c) = v;
#pragma unroll
                for (int q = 0; q < 4; ++q) mvt[(size_t)((b * 4 + (c >> 6)) * 64 + (c & 63) + q) * 256 + mm] = f2bf(v[q]); }
        }
    }
};
struct EpiResid {
    static constexpr bool PRESTAGE = false;
    const bf16_t* X; bf16_t* Zb;
    __device__ __forceinline__ void operator()(EPI_ARGS) const {
#pragma unroll
        for (int ai = 0; ai < 2; ++ai)
#pragma unroll
            for (int bj = 0; bj < 2; ++bj) {
#pragma unroll
                for (int m = 0; m < 4; ++m)
#pragma unroll
                    for (int n = 0; n < 2; ++n) { const unsigned o = (unsigned)EPI_ROW * 1024u + (unsigned)EPI_COL; const uint2 x = *(const uint2*)(X + o); const f32x4 v = acc[ai][bj][m][n];
                        *(uint2*)(Zb + o) = make_uint2(pk2(ALPHA * bflo(x.x) + v[0], ALPHA * bfhi(x.x) + v[1]), pk2(ALPHA * bflo(x.y) + v[2], ALPHA * bfhi(x.y) + v[3])); }
                __builtin_amdgcn_sched_barrier(0);
            }
    }
};
struct EpiGU {
    static constexpr bool PRESTAGE = false;
    bf16_t* ACT;
    __device__ __forceinline__ void operator()(EPI_ARGS) const {
#pragma unroll
        for (int ai = 0; ai < 2; ++ai)
#pragma unroll
            for (int bj = 0; bj < 2; ++bj)
#pragma unroll
                for (int m = 0; m < 4; ++m) {
                    const int row = brow + 128 * ai + 64 * wr + 16 * m + fr, ocol = (bcol >> 1) + 64 * bj + 16 * wc + 4 * fq;
                    const f32x4 gt = acc[ai][bj][m][0], up = acc[ai][bj][m][1];
                    *(uint2*)(ACT + (size_t)row * DFF + ocol) = make_uint2(pk2(silu(gt[0]) * up[0], silu(gt[1]) * up[1]), pk2(silu(gt[2]) * up[2], silu(gt[3]) * up[3]));
                    __builtin_amdgcn_sched_barrier(0);
                }
    }
};
struct EpiProj1 {
    static constexpr bool PRESTAGE = false;
    bf16_t* QM; bf16_t* KBP; bf16_t* KBS; bf16_t* VTP; bf16_t* VTS; float* out; const float2* ropeD;
    __device__ __forceinline__ void operator()(EPI_ARGS) const {
        EPI_LOOP {
            const int row = EPI_ROW, col = EPI_COL;
            f32x4 v = acc[ai][bj][m][n];
            const int region = col < 768 ? 0 : (col < 1536 ? 1 : (col < 2304 ? 2 : 3));
            if (region <= 1) {
                const bool rot = ((wc & 1) == 0) && (n == 0);
                if (rot) {
                    f32x4 pr; pr[0] = __shfl_xor(v[0], 32); pr[1] = __shfl_xor(v[1], 32); pr[2] = __shfl_xor(v[2], 32); pr[3] = __shfl_xor(v[3], 32);
                    const int pos = row < TP ? (row & 4095) : 1024 + ((row - TP) & 63);
                    const float4* cs = (const float4*)(ropeD + pos * 8 + 4 * (fq & 1));
                    const float4 c01 = cs[0], c23 = cs[1];
                    const float cc[4] = {c01.x, c01.z, c23.x, c23.z}, sn[4] = {c01.y, c01.w, c23.y, c23.w};
#pragma unroll
                    for (int q = 0; q < 4; ++q) v[q] = fq < 2 ? v[q] * cc[q] - pr[q] * sn[q] : pr[q] * sn[q] + v[q] * cc[q];
                }
                const uint2 pk = make_uint2(pk2(v[0], v[1]), pk2(v[2], v[3]));
                if (region == 0) *(uint2*)(QM + (size_t)row * 1024 + col) = pk;
                else {
                    const int kc = col - 768;
                    if (row < TP) { *(uint2*)(KBP + (size_t)row * 768 + kc) = pk; *(f32x4*)(out + O_DKP + (size_t)row * 768 + kc) = v; }
                    else { const int rs = row - TP, b = rs >> 6, s = rs & 63; *(uint2*)(KBS + (size_t)(b * 1088 + 1024 + s) * 768 + kc) = pk; *(f32x4*)(out + O_DKS + (size_t)rs * 768 + kc) = v; }
                }
            } else if (region == 2) {
                const int vc = col - 1536, h = vc >> 7, dim = vc & 127;
                if (row < TP) {
                    const int b = row >> 12, s = row & 4095;
                    *(f32x4*)(out + O_DVP + (size_t)row * 768 + vc) = v;
#pragma unroll
                    for (int q = 0; q < 4; ++q) VTP[((size_t)(b * 6 + h) * 128 + dim + q) * 4096 + s] = f2bf(v[q]);
                } else {
                    const int rs = row - TP, b = rs >> 6, s = rs & 63;
                    *(f32x4*)(out + O_DVS + (size_t)rs * 768 + vc) = v;
#pragma unroll
                    for (int q = 0; q < 4; ++q) VTS[((size_t)(b * 6 + h) * 128 + dim + q) * 1088 + 1024 + s] = f2bf(v[q]);
                }
            } else {
                *(uint2*)(QM + (size_t)row * 1024 + 768 + (col - 2304)) = make_uint2(pk2(v[0], v[1]), pk2(v[2], v[3]));
            }
        }
    }
};

struct TrDesc { const float* src; bf16_t* dst; int lds_, ldd, k0, n0, mode, which; };
__device__ __forceinline__ void tr_load(const TrDesc& d, float4 (&r)[4], int tid) {
#pragma unroll
    for (int i = 0; i < 4; ++i) { const int k = (tid >> 4) + 16 * i, n4 = (tid & 15) * 4; r[i] = *(const float4*)(d.src + (size_t)(d.k0 + k) * d.lds_ + d.n0 + n4); }
}
__device__ __forceinline__ void tr_finish(const TrDesc& d, const float4 (&r)[4], float* tile, int tid) {
#pragma unroll
    for (int i = 0; i < 4; ++i) { const int k = (tid >> 4) + 16 * i, n4 = (tid & 15) * 4; float* t = tile + k * 65 + n4; t[0] = r[i].x; t[1] = r[i].y; t[2] = r[i].z; t[3] = r[i].w; }
    __syncthreads();
    const int n = tid >> 2, kq = (tid & 3) * 16;
    uint32_t w[8];
#pragma unroll
    for (int q = 0; q < 8; ++q) w[q] = pk2(tile[(kq + 2 * q) * 65 + n], tile[(kq + 2 * q + 1) * 65 + n]);
    const int c = d.n0 + n;
    const int row = d.mode == 0 ? c : (256 * (c >> 7) + 128 * ((c >> 6) & 1) + 32 * ((c >> 4) & 3) + 16 * d.which + (c & 15));
    uint4* o = (uint4*)(d.dst + (size_t)row * d.ldd + d.k0 + kq);
    o[0] = make_uint4(w[0], w[1], w[2], w[3]); o[1] = make_uint4(w[4], w[5], w[6], w[7]);
    __syncthreads();
}
__device__ __forceinline__ TrDesc tr_desc0(const Params& p, int it) {
    char* ws = p.ws;
    constexpr int T0 = 832, T1 = T0 + 640, T2 = T1 + 256, T3 = T2 + 512, T4 = T3 + 1408, T5 = T4 + 1408;
    if (it < T0) { const int kt = it / 52, nt = it % 52; return TrDesc{p.in[8], (bf16_t*)(ws + W_WRET), NRET, 1024, kt * 64, nt * 64, 0, 0}; }
    if (it < T1) { const int r = it - T0, kt = r / 40, nt = r % 40; return TrDesc{p.in[10], (bf16_t*)(ws + W_WDIFF), NDIFF, 1024, kt * 64, nt * 64, 0, 0}; }
    if (it < T2) { const int r = it - T1, l = r >> 7, q = r & 127, kt = q >> 3, nt = q & 7; return TrDesc{p.in[16] + (size_t)l * 1024 * 512, (bf16_t*)(ws + W_WMKV) + (size_t)l * 512 * 1024, 512, 1024, kt * 64, nt * 64, 0, 0}; }
    if (it < T3) { const int r = it - T2, l = r >> 8, q = r & 255, kt = q >> 4, nt = q & 15; return TrDesc{p.in[17] + (size_t)l * 1024 * 1024, (bf16_t*)(ws + W_WO) + (size_t)l * 1024 * 1024, 1024, 1024, kt * 64, nt * 64, 0, 0}; }
    if (it < T5) { const int wh = it >= T4; const int r = it - (wh ? T4 : T3), l = r / 704, q = r % 704, kt = q / 44, nt = q % 44;
        return TrDesc{p.in[wh ? 21 : 20] + (size_t)l * 1024 * DFF, (bf16_t*)(ws + W_WGU) + (size_t)l * 5632 * 1024, DFF, 1024, kt * 64, nt * 64, 1, wh}; }
    { const int r = it - T5, l = r / 704, q = r % 704, kt = q >> 4, nt = q & 15; return TrDesc{p.in[22] + (size_t)l * DFF * 1024, (bf16_t*)(ws + W_WD) + (size_t)l * 1024 * DFF, 1024, DFF, kt * 64, nt * 64, 0, 0}; }
}
__device__ __forceinline__ TrDesc tr_desc9(const Params& p, int it) {
    const int bh = it >> 5, q = it & 31, jt = q >> 1, dt = q & 1, b = bh / 6, h = bh % 6;
    return TrDesc{p.in[5] + (size_t)b * 1024 * 768 + h * 128, (bf16_t*)(p.ws + W_VTS) + (size_t)bh * 128 * 1088, 768, 1088, jt * 64, dt * 64, 0, 0};
}

__device__ __forceinline__ void phase_prep(const Params& p, char* lds) {
    char* ws = p.ws;
    const int nb = gridDim.x, bid = BIDX(), tid = TIDX(), half = tid >> 8, tl = tid & 255;
    float* tile = (float*)lds + half * 4224;
    constexpr int T6 = 832 + 640 + 256 + 512 + 3 * 1408;
    if (bid < T6 / 2) {
        TrDesc dc = tr_desc0(p, 2 * bid + half); float4 r[4]; tr_load(dc, r, tl);
        for (int it2 = bid; it2 < T6 / 2; it2 += nb) {
            const bool has = it2 + nb < T6 / 2;
            TrDesc dn = dc; float4 rn[4];
            if (has) { dn = tr_desc0(p, 2 * (it2 + nb) + half); tr_load(dn, rn, tl); }
            tr_finish(dc, r, tile, tl);
            if (has) { dc = dn;
#pragma unroll
                for (int i = 0; i < 4; ++i) r[i] = rn[i]; }
        }
    }
    const size_t gt = (size_t)bid * NTHR + tid, gs = (size_t)nb * NTHR;
    { uint2* dst = (uint2*)(ws + W_XB); const float4* xp = (const float4*)p.in[0]; const float4* xs = (const float4*)p.in[1];
      const size_t n4 = (size_t)TT * 256, np4 = (size_t)TP * 256;
      for (size_t i = gt; i < n4; i += gs) { const float4 v = i < np4 ? xp[i] : xs[i - np4]; dst[i] = make_uint2(pk2(v.x, v.y), pk2(v.z, v.w)); } }
    { uint2* dst = (uint2*)(ws + W_MB); const float4* s = (const float4*)p.in[2];
      for (size_t i = gt; i < 2048ull * 256; i += gs) { const float4 v = s[i]; dst[i] = make_uint2(pk2(v.x, v.y), pk2(v.z, v.w)); } }
    { uint2* dst = (uint2*)(ws + W_MK); const float4* s = (const float4*)p.in[6];
      for (size_t i = gt; i < 2ull * 16 * 16384; i += gs) { const size_t l = i / (16 * 16384), rem = i - l * 16 * 16384; const float4 v = s[i]; dst[(l * 24 + 8) * 16384 + rem] = make_uint2(pk2(v.x, v.y), pk2(v.z, v.w)); } }
    { bf16_t* dst = (bf16_t*)(ws + W_MVT); const float* s = p.in[7];
      for (size_t i = gt; i < 2ull * 16 * 65536; i += gs) {
          const int m = i & 255, dim = (i >> 8) & 63, h = (i >> 14) & 3, b = (i >> 16) & 15, l = (int)(i >> 20);
          dst[((size_t)((l * 24 + 8 + b) * 4 + h) * 64 + dim) * 256 + m] = f2bf(s[((size_t)(l * 16 + b) * 256 + m) * 256 + h * 64 + dim]); } }
    { float2* rr = (float2*)(ws + W_ROPER); float2* rd = (float2*)(ws + W_ROPED);
      for (size_t i = gt; i < 4096ull * 64; i += gs) { const int pos = (int)(i >> 6), f = (int)(i & 63); const float inv = expf(-logf(10000.f) * (float)f * 2.0f / 128.f); float sn, cs; sincosf((float)pos * inv, &sn, &cs); rr[i] = make_float2(cs, sn); }
      for (size_t i = gt; i < 4096ull * 8; i += gs) { const int pos = (int)(i >> 3), f = (int)(i & 7); const float inv = expf(-logf(500000.f) * (float)f * 2.0f / 16.f); float sn, cs; sincosf((float)pos * inv, &sn, &cs); rd[i] = make_float2(cs, sn); } }
    if (bid == 0 && tid < 64) ((int*)(ws + W_CTRL))[tid] = 0;
}

__device__ __forceinline__ void ret_chain(const Params& p, int h, int sl, int nsteps, int rowbase, int posbase, const float* init, bf16_t* rs, float* fin, char* lds) {
    const int tid = TIDX(), lane = tid & 63, w = tid >> 6, g = lane >> 4, lc = lane & 15;
    const float log_g = logf(1.f - exp2f(-5.f - (float)h));
    const float gch = expf(64.f * log_g);
    const float kscale = 0.08838834764831845f;
    const bf16_t* proj = (const bf16_t*)(p.ws + W_RA);
    const float2* ropeR = (const float2*)(p.ws + W_ROPER);
    f32x4 acc[2];
#pragma unroll
    for (int jj = 0; jj < 2; ++jj)
#pragma unroll
        for (int r = 0; r < 4; ++r) { const int d = 16 * w + 4 * g + r, e = sl * 32 + 16 * jj + lc; acc[jj][r] = init ? init[d * 128 + e] : 0.f; }
    const float zeta = expf((float)(63 - (tid >> 3)) * log_g) * kscale;
    uint4 ka0, kb0, vv0, ka1, kb1, vv1, ka2, kb2, vv2, ka3, kb3, vv3;
    float4 ca0[4], ca1[4], ca2[4], ca3[4];
    const int kj = tid >> 3, kdg = tid & 7, vj = (tid >> 2) & 63, veg = tid & 3;
#define RC_LOAD(c_, K1, K2, VV, CS) do { const bf16_t* s_ = proj + (size_t)(rowbase + (c_) * 64 + kj) * NRET + 768 + h * 128 + kdg * 8; K1 = *(const uint4*)s_; K2 = *(const uint4*)(s_ + 64); \
        { const float4* cs_ = (const float4*)(ropeR + (size_t)(posbase + (c_) * 64 + kj) * 64 + kdg * 8); CS[0] = cs_[0]; CS[1] = cs_[1]; CS[2] = cs_[2]; CS[3] = cs_[3]; } \
        VV = *(const uint4*)(proj + (size_t)(rowbase + (c_) * 64 + vj) * NRET + 1536 + h * 128 + sl * 32 + veg * 8); } while (0)
#define RC_STEP(c_, K1, K2, VV, CS) if ((c_) < nsteps) { const int c = (c_); \
        bf16_t* Kt = (bf16_t*)(lds + (c & 1) * 18432); \
        bf16_t* Vt = (bf16_t*)(lds + 36864 + (c & 1) * 4608); \
        { \
            float x1[8], x2[8]; unpack8(K1, x1); unpack8(K2, x2); \
            _Pragma("unroll") for (int e2 = 0; e2 < 4; ++e2) { \
                const float4 t = CS[e2]; \
                { const float a = x1[2 * e2], b = x2[2 * e2]; Kt[(kdg * 8 + 2 * e2) * 72 + kj] = f2bf((a * t.x - b * t.y) * zeta); Kt[(64 + kdg * 8 + 2 * e2) * 72 + kj] = f2bf((a * t.y + b * t.x) * zeta); } \
                { const float a = x1[2 * e2 + 1], b = x2[2 * e2 + 1]; Kt[(kdg * 8 + 2 * e2 + 1) * 72 + kj] = f2bf((a * t.z - b * t.w) * zeta); Kt[(64 + kdg * 8 + 2 * e2 + 1) * 72 + kj] = f2bf((a * t.w + b * t.z) * zeta); } \
            } \
        } \
        if (tid < 256) { const uint32_t u[4] = {VV.x, VV.y, VV.z, VV.w}; \
          _Pragma("unroll") for (int e2 = 0; e2 < 4; ++e2) { Vt[(veg * 8 + 2 * e2) * 72 + vj] = (bf16_t)(u[e2] & 0xffff); Vt[(veg * 8 + 2 * e2 + 1) * 72 + vj] = (bf16_t)(u[e2] >> 16); } } \
        if (c + 4 < nsteps) RC_LOAD(c + 4, K1, K2, VV, CS); \
        __syncthreads(); \
        bf16_t* rsc = rs + (size_t)c * 16384; \
        _Pragma("unroll") for (int jj = 0; jj < 2; ++jj) { \
            const int d = 16 * w + 4 * g, e = sl * 32 + 16 * jj + lc; \
            *(uint2*)(rsc + e * 128 + d) = make_uint2(pk2(acc[jj][0], acc[jj][1]), pk2(acc[jj][2], acc[jj][3])); \
            acc[jj] = acc[jj] * gch; \
        } \
        _Pragma("unroll") for (int s = 0; s < 2; ++s) { \
            const bf16x8 a = ld8(Kt + (16 * w + lc) * 72 + 32 * s + 8 * g); \
            _Pragma("unroll") for (int jj = 0; jj < 2; ++jj) acc[jj] = MFMA16(a, ld8(Vt + (16 * jj + lc) * 72 + 32 * s + 8 * g), acc[jj]); \
        } \
    }
    RC_LOAD(0, ka0, kb0, vv0, ca0);
    if (1 < nsteps) RC_LOAD(1, ka1, kb1, vv1, ca1);
    if (2 < nsteps) RC_LOAD(2, ka2, kb2, vv2, ca2);
    if (3 < nsteps) RC_LOAD(3, ka3, kb3, vv3, ca3);
    for (int c4 = 0; c4 < nsteps; c4 += 4) {
        RC_STEP(c4, ka0, kb0, vv0, ca0)
        RC_STEP(c4 + 1, ka1, kb1, vv1, ca1)
        RC_STEP(c4 + 2, ka2, kb2, vv2, ca2)
        RC_STEP(c4 + 3, ka3, kb3, vv3, ca3)
    }
#pragma unroll
    for (int jj = 0; jj < 2; ++jj)
#pragma unroll
        for (int r = 0; r < 4; ++r) { const int d = 16 * w + 4 * g + r, e = sl * 32 + 16 * jj + lc; fin[d * 128 + e] = acc[jj][r]; }
    __syncthreads();
#undef RC_LOAD
#undef RC_STEP
}
__device__ __forceinline__ void ret_out(const Params& p, int u2, char* lds_) {
    const int tid_ = TIDX(), half = tid_ >> 8, tid = tid_ & 255, lane = tid & 63, w = tid >> 6, g = lane >> 4, lc = lane & 15;
    const int u = 2 * u2 + half; char* lds = lds_ + half * 53248;
    int b, h, rowbase, pos0;
    if (u < 3072) { const int chain = u >> 6, c = u & 63; b = chain / 6; h = chain % 6; rowbase = b * 4096 + c * 64; pos0 = c * 64; }
    else { const int cs = u - 3072; b = cs / 6; h = cs % 6; rowbase = TP + b * 64; pos0 = 1024; }
    const float log_g = logf(1.f - exp2f(-5.f - (float)h));
    const float log2g = log_g * 1.44269504089f;
    const float kscale = 0.08838834764831845f;
    const bf16_t* proj = (const bf16_t*)(p.ws + W_RA);
    const float2* ropeR = (const float2*)(p.ws + W_ROPER);
    const bf16_t* rsu = (const bf16_t*)(p.out + O_DKP) + (size_t)u * 16384;
    bf16_t* H = (bf16_t*)(p.ws + W_H);
    bf16_t* Qs = (bf16_t*)lds; bf16_t* Ks = (bf16_t*)(lds + 17408); bf16_t* Vt = (bf16_t*)(lds + 34816);
#pragma unroll
    for (int q = 0; q < 2; ++q) {
        const int it = tid + 256 * q, j = it >> 3, dg = it & 7;
        const bf16_t* s = proj + (size_t)(rowbase + j) * NRET + h * 128 + dg * 8;
        const uint4 q1 = *(const uint4*)s, q2 = *(const uint4*)(s + 64), kk1 = *(const uint4*)(s + 768), kk2 = *(const uint4*)(s + 768 + 64);
        const float4* cs = (const float4*)(ropeR + (size_t)(pos0 + j) * 64 + dg * 8);
        float a1[8], a2[8], b1[8], b2[8]; unpack8(q1, a1); unpack8(q2, a2); unpack8(kk1, b1); unpack8(kk2, b2);
        float qo1[8], qo2[8], ko1[8], ko2[8];
#pragma unroll
        for (int e2 = 0; e2 < 4; ++e2) {
            const float4 t = cs[e2];
            qo1[2 * e2] = a1[2 * e2] * t.x - a2[2 * e2] * t.y; qo2[2 * e2] = a1[2 * e2] * t.y + a2[2 * e2] * t.x;
            qo1[2 * e2 + 1] = a1[2 * e2 + 1] * t.z - a2[2 * e2 + 1] * t.w; qo2[2 * e2 + 1] = a1[2 * e2 + 1] * t.w + a2[2 * e2 + 1] * t.z;
            ko1[2 * e2] = (b1[2 * e2] * t.x - b2[2 * e2] * t.y) * kscale; ko2[2 * e2] = (b1[2 * e2] * t.y + b2[2 * e2] * t.x) * kscale;
            ko1[2 * e2 + 1] = (b1[2 * e2 + 1] * t.z - b2[2 * e2 + 1] * t.w) * kscale; ko2[2 * e2 + 1] = (b1[2 * e2 + 1] * t.w + b2[2 * e2 + 1] * t.z) * kscale;
        }
        *(uint4*)(Qs + j * 136 + dg * 8) = make_uint4(pk2(qo1[0], qo1[1]), pk2(qo1[2], qo1[3]), pk2(qo1[4], qo1[5]), pk2(qo1[6], qo1[7]));
        *(uint4*)(Qs + j * 136 + 64 + dg * 8) = make_uint4(pk2(qo2[0], qo2[1]), pk2(qo2[2], qo2[3]), pk2(qo2[4], qo2[5]), pk2(qo2[6], qo2[7]));
        *(uint4*)(Ks + j * 136 + dg * 8) = make_uint4(pk2(ko1[0], ko1[1]), pk2(ko1[2], ko1[3]), pk2(ko1[4], ko1[5]), pk2(ko1[6], ko1[7]));
        *(uint4*)(Ks + j * 136 + 64 + dg * 8) = make_uint4(pk2(ko2[0], ko2[1]), pk2(ko2[2], ko2[3]), pk2(ko2[4], ko2[5]), pk2(ko2[6], ko2[7]));
    }
#pragma unroll
    for (int q = 0; q < 4; ++q) {
        const int it = tid + 256 * q, j = it >> 4, eg = it & 15;
        const uint4 v = *(const uint4*)(proj + (size_t)(rowbase + j) * NRET + 1536 + h * 128 + eg * 8);
        const uint32_t uu[4] = {v.x, v.y, v.z, v.w};
#pragma unroll
        for (int e2 = 0; e2 < 4; ++e2) { Vt[(eg * 8 + 2 * e2) * 72 + j] = (bf16_t)(uu[e2] & 0xffff); Vt[(eg * 8 + 2 * e2 + 1) * 72 + j] = (bf16_t)(uu[e2] >> 16); }
    }
    __syncthreads();
    bf16x8 qf[4];
#pragma unroll
    for (int s = 0; s < 4; ++s) qf[s] = ld8(Qs + (16 * w + lc) * 136 + 32 * s + 8 * g);
    f32x4 st[4];
#pragma unroll
    for (int t = 0; t < 4; ++t) {
        st[t] = (f32x4){0.f, 0.f, 0.f, 0.f};
#pragma unroll
        for (int s = 0; s < 4; ++s) st[t] = MFMA16(ld8(Ks + (16 * t + lc) * 136 + 32 * s + 8 * g), qf[s], st[t]);
    }
    const int ii = 16 * w + lc;
#pragma unroll
    for (int t = 0; t < 4; ++t)
#pragma unroll
        for (int r = 0; r < 4; ++r) { const int j = 16 * t + 4 * g + r; st[t][r] *= exp2f(fabsf((float)(ii - j)) * log2g); }
    f32x4 o[8], oc[8];
#pragma unroll
    for (int et = 0; et < 8; ++et) { o[et] = (f32x4){0.f, 0.f, 0.f, 0.f}; oc[et] = (f32x4){0.f, 0.f, 0.f, 0.f}; }
#pragma unroll
    for (int s = 0; s < 2; ++s) {
        const bf16x8 pb = pack8(st[2 * s], st[2 * s + 1]);
#pragma unroll
        for (int et = 0; et < 8; ++et) { const bf16_t* vr = Vt + (16 * et + lc) * 72 + 32 * s + 4 * g; o[et] = MFMA16(ld44(vr, vr + 16), pb, o[et]); }
    }
#pragma unroll
    for (int et = 0; et < 8; ++et)
#pragma unroll
        for (int s = 0; s < 4; ++s) oc[et] = MFMA16(ld8(rsu + (16 * et + lc) * 128 + 32 * s + 8 * g), qf[s], oc[et]);
    const float xi = exp2f((float)(ii + 1) * log2g);
    float sum = 0.f;
#pragma unroll
    for (int et = 0; et < 8; ++et)
#pragma unroll
        for (int r = 0; r < 4; ++r) { o[et][r] += xi * oc[et][r]; sum += o[et][r]; }
    const float mean = xr16_32_sum(sum) * (1.f / 128.f);
    float sq = 0.f;
#pragma unroll
    for (int et = 0; et < 8; ++et)
#pragma unroll
        for (int r = 0; r < 4; ++r) { const float dd = o[et][r] - mean; sq += dd * dd; }
    const float rstd = rsqrtf(xr16_32_sum(sq) * (1.f / 128.f) + 1e-5f);
    const size_t row = (size_t)rowbase + ii;
    const float* gn = p.in[9] + h * 128;
#pragma unroll
    for (int et = 0; et < 8; ++et) {
        const int e = 16 * et + 4 * g;
        const uint2 gt = *(const uint2*)(proj + row * NRET + 2304 + h * 128 + e);
        const float4 gg = *(const float4*)(gn + e);
        const float y0 = (o[et][0] - mean) * rstd * gg.x * silu(bflo(gt.x)), y1 = (o[et][1] - mean) * rstd * gg.y * silu(bfhi(gt.x));
        const float y2 = (o[et][2] - mean) * rstd * gg.z * silu(bflo(gt.y)), y3 = (o[et][3] - mean) * rstd * gg.w * silu(bfhi(gt.y));
        *(uint2*)(H + row * 1024 + h * 128 + e) = make_uint2(pk2(y0, y1), pk2(y2, y3));
    }
    __syncthreads();
}

__device__ __forceinline__ void glds16_asm(const void* gsrc, unsigned lds_dst) {
    unsigned keep;
    asm volatile("s_mov_b32 %0, m0\n\ts_mov_b32 m0, %2\n\ts_nop 0\n\tglobal_load_lds_dwordx4 %1, off\n\ts_mov_b32 m0, %0" : "=&s"(keep) : "v"(gsrc), "s"(lds_dst) : "memory");
}
__device__ __forceinline__ void mem_attn(const Params& p, int unit, int layer, char* lds) {
    const int tid = TIDX(), lane = tid & 63, w = tid >> 6, g = lane >> 4, lc = lane & 15;
    const bf16_t* Q; int ldq;
    if (layer == 0) { Q = (const bf16_t*)(p.ws + W_RA) + 3072; ldq = NRET; } else { Q = (const bf16_t*)(p.ws + W_QM) + 768; ldq = 1024; }
    int bb, h, r0, npass; bool all8;
    if (unit < 256) { const int b = unit >> 5; h = (unit >> 3) & 3; bb = b; r0 = b * 4096 + (unit & 7) * 512; npass = 4; all8 = true; }
    else { const int us = unit - 256, b = us >> 2; h = us & 3; bb = 8 + b; r0 = TP + b * 64; npass = 1; all8 = false; }
    const bf16_t* mk = (const bf16_t*)(p.ws + W_MK) + (size_t)(layer * 24 + bb) * 65536 + h * 64;
    const bf16_t* mv = (const bf16_t*)(p.ws + W_MVT) + (size_t)((layer * 24 + bb) * 4 + h) * 16384;
    bf16_t* H = (bf16_t*)(p.ws + W_H);
    const float sc = 0.125f * 1.44269504089f;
    asm volatile("s_waitcnt vmcnt(0) lgkmcnt(0)" ::: "memory");
    __syncthreads();
    {
        const unsigned lds_w = (unsigned)__builtin_amdgcn_readfirstlane((int)(unsigned)(size_t)(LAS char*)lds + (tid & ~63) * 16);
#pragma unroll
        for (int i = 0; i < 4; ++i) {
            const int kr = (tid >> 3) + 64 * i, kc = (tid & 7) ^ ((kr >> 1) & 7);
            glds16_asm(mk + (size_t)kr * 256 + kc * 8, lds_w + i * 8192);
            const int vr = (tid >> 5) + 16 * i, vc = (tid & 31) ^ (vr & 15);
            glds16_asm(mv + (size_t)vr * 256 + vc * 8, lds_w + 32768 + i * 8192);
        }
    }
    const bf16_t* Ks = (const bf16_t*)lds; const bf16_t* Vs = (const bf16_t*)(lds + 32768);
    const bool act = all8 || w < 4;
    const size_t rowb = (size_t)r0 + 16 * (all8 ? w : (w & 3)) + lc;
    bf16x8 qf[2];
#pragma unroll
    for (int s = 0; s < 2; ++s) qf[s] = ld8(Q + rowb * ldq + h * 64 + 32 * s + 8 * g);
#pragma unroll
    for (int s = 0; s < 2; ++s) asm volatile("" : "+v"(qf[s]));
    asm volatile("s_waitcnt vmcnt(0)" ::: "memory");
    __syncthreads();
    for (int it = 0; it < npass; ++it) {
        const size_t row = rowb + (size_t)it * 128;
        bf16x8 qn[2];
        if (it + 1 < npass) {
#pragma unroll
            for (int s = 0; s < 2; ++s) qn[s] = ld8(Q + (row + 128) * ldq + h * 64 + 32 * s + 8 * g);
        }
        if (act) {
            f32x4 st[16];
            float mx = -3.0e38f;
#pragma unroll
            for (int t = 0; t < 16; ++t) {
                st[t] = (f32x4){0.f, 0.f, 0.f, 0.f};
#pragma unroll
                for (int s = 0; s < 2; ++s) st[t] = MFMA16(ld8(Ks + (16 * t + lc) * 64 + ((4 * s + g) ^ ((lc >> 1) & 7)) * 8), qf[s], st[t]);
                mx = fmaxf(mx, fmaxf(fmaxf(st[t][0], st[t][1]), fmaxf(st[t][2], st[t][3])));
            }
            mx = xr16_32_max(mx) * sc;
            float sum = 0.f;
#pragma unroll
            for (int t = 0; t < 16; ++t)
#pragma unroll
                for (int r = 0; r < 4; ++r) { st[t][r] = __builtin_amdgcn_exp2f(st[t][r] * sc - mx); sum += st[t][r]; }
            const float inv = 1.f / xr16_32_sum(sum);
            f32x4 o[4];
#pragma unroll
            for (int dt = 0; dt < 4; ++dt) o[dt] = (f32x4){0.f, 0.f, 0.f, 0.f};
#pragma unroll
            for (int s = 0; s < 8; ++s) {
                const bf16x8 pb = pack8(st[2 * s] * inv, st[2 * s + 1] * inv);
#pragma unroll
                for (int dt = 0; dt < 4; ++dt) { const bf16_t* vr = Vs + (16 * dt + lc) * 256 + (g & 1) * 4; o[dt] = MFMA16(ld44(vr + ((4 * s + (g >> 1)) ^ lc) * 8, vr + ((4 * s + (g >> 1) + 2) ^ lc) * 8), pb, o[dt]); }
            }
#pragma unroll
            for (int dt = 0; dt < 4; ++dt) *(uint2*)(H + row * 1024 + 768 + h * 64 + 16 * dt + 4 * g) = make_uint2(pk2(o[dt][0], o[dt][1]), pk2(o[dt][2], o[dt][3]));
        }
        if (it + 1 < npass) { qf[0] = qn[0]; qf[1] = qn[1]; }
    }
    __syncthreads();
}

__device__ __forceinline__ void diff_attn(const Params& p, int rowq0, int h, const bf16_t* Kp, const bf16_t* Vp, int ldv, int nkt, int nkt_lo, bool hi_active, float lam, char* lds) {
    const int tid = TIDX(), lane = tid & 63, w = tid >> 6, g = lane >> 4, lc = lane & 15;
    const bf16_t* QM = (const bf16_t*)(p.ws + W_QM);
    bf16_t* H = (bf16_t*)(p.ws + W_H);
    const size_t row = (size_t)rowq0 + 16 * (hi_active ? w : (w & 3)) + lc;
    const int my_nkt = w < 4 ? nkt_lo : (hi_active ? nkt : 0);
    const float sc = 0.125f * 1.44269504089f;
    bf16x8 qf[2][2];
#pragma unroll
    for (int c = 0; c < 2; ++c)
#pragma unroll
        for (int s = 0; s < 2; ++s) qf[c][s] = ld8(QM + row * 1024 + h * 128 + c * 64 + 32 * s + 8 * g);
    f32x4 o[2][8];
    float m[2] = {0.f, 0.f};
    f32x4 osum[2] = {(f32x4){0.f, 0.f, 0.f, 0.f}, (f32x4){0.f, 0.f, 0.f, 0.f}};
    const bf16x8 onesA = mk8(0x3F803F80u, 0x3F803F80u, 0x3F803F80u, 0x3F803F80u);
#pragma unroll
    for (int c = 0; c < 2; ++c)
#pragma unroll
        for (int dt = 0; dt < 8; ++dt) o[c][dt] = (f32x4){0.f, 0.f, 0.f, 0.f};
    const int kkey = tid >> 4, kdc = tid & 15;
    const int vdim = tid >> 3, vkc = tid & 7;
    const bf16_t* kg0 = Kp + (size_t)kkey * 768 + (kdc ^ (kkey & 15)) * 8;
    const bf16_t* vg0 = Vp + (size_t)vdim * ldv + (vkc ^ (vdim & 7)) * 8;
    const unsigned lds_w = (unsigned)__builtin_amdgcn_readfirstlane((int)(unsigned)(size_t)(LAS char*)lds + (tid & ~63) * 16);
#define DA_ISSUE(vt_) do { const int st_ = (vt_) & 3; const int tt_ = (vt_) < nkt ? (vt_) : nkt - 1; \
        const bf16_t* kg_ = kg0 + (size_t)tt_ * (64 * 768); const bf16_t* vg_ = vg0 + tt_ * 64; const unsigned dst_ = lds_w + st_ * 32768; \
        glds16_asm(kg_, dst_); glds16_asm(kg_ + 32 * 768, dst_ + 8192); glds16_asm(vg_, dst_ + 16384); glds16_asm(vg_ + (size_t)64 * ldv, dst_ + 16384 + 8192); } while (0)
#pragma unroll
    for (int c = 0; c < 2; ++c)
#pragma unroll
        for (int s = 0; s < 2; ++s) asm volatile("" : "+v"(qf[c][s]));
    asm volatile("s_waitcnt vmcnt(0) lgkmcnt(0)" ::: "memory");
    __syncthreads();
    DA_ISSUE(0); DA_ISSUE(1); DA_ISSUE(2);
    asm volatile("s_waitcnt vmcnt(8)" ::: "memory");
    __builtin_amdgcn_s_barrier();
    for (int kt = 0; kt < nkt; ++kt) {
        DA_ISSUE(kt + 3);
        if (kt < my_nkt) {
            const bf16_t* Ks = (const bf16_t*)(lds + (kt & 3) * 32768); const bf16_t* Vt = (const bf16_t*)(lds + (kt & 3) * 32768 + 16384);
            f32x4 st[2][4];
#pragma unroll
            for (int c = 0; c < 2; ++c)
#pragma unroll
                for (int t = 0; t < 4; ++t) {
                    st[c][t] = (f32x4){0.f, 0.f, 0.f, 0.f};
#pragma unroll
                    for (int s = 0; s < 2; ++s) st[c][t] = MFMA16(ld8(Ks + (16 * t + lc) * 128 + ((c * 8 + 4 * s + g) ^ lc) * 8), qf[c][s], st[c][t]);
                }
#pragma unroll
            for (int c = 0; c < 2; ++c) {
                const float mneg = -m[c];
#pragma unroll
                for (int t = 0; t < 4; ++t)
#pragma unroll
                    for (int r = 0; r < 4; ++r) st[c][t][r] = __builtin_fmaf(st[c][t][r], sc, mneg);
                float mx = -3.0e38f;
#pragma unroll
                for (int t = 0; t < 4; ++t) mx = fmaxf(mx, fmaxf(fmaxf(st[c][t][0], st[c][t][1]), fmaxf(st[c][t][2], st[c][t][3])));
                mx = xr16_32_max(mx);
                const bool first = kt == 0;
                if (first || __builtin_amdgcn_ballot_w64(mx > 8.f) != 0ull) {
                    const float d = first ? mx : fmaxf(mx, 0.f);
                    m[c] += d;
                    if (!first) {
                        const float al = __builtin_amdgcn_exp2f(-d);
                        osum[c] = osum[c] * al;
#pragma unroll
                        for (int dt = 0; dt < 8; ++dt) o[c][dt] = o[c][dt] * al;
                    }
#pragma unroll
                    for (int t = 0; t < 4; ++t)
#pragma unroll
                        for (int r = 0; r < 4; ++r) st[c][t][r] -= d;
                }
#pragma unroll
                for (int t = 0; t < 4; ++t)
#pragma unroll
                    for (int r = 0; r < 4; ++r) st[c][t][r] = __builtin_amdgcn_exp2f(st[c][t][r]);
            }
#pragma unroll
            for (int s = 0; s < 2; ++s) {
                const bf16x8 pb0 = pack8(st[0][2 * s], st[0][2 * s + 1]), pb1 = pack8(st[1][2 * s], st[1][2 * s + 1]);
                osum[0] = MFMA16(onesA, pb0, osum[0]); osum[1] = MFMA16(onesA, pb1, osum[1]);
#pragma unroll
                for (int dt = 0; dt < 8; ++dt) {
                    const bf16_t* vr = Vt + (16 * dt + lc) * 64 + (g & 1) * 4;
                    const bf16x8 va = ld44(vr + ((4 * s + (g >> 1)) ^ (lc & 7)) * 8, vr + ((4 * s + (g >> 1) + 2) ^ (lc & 7)) * 8);
                    o[0][dt] = MFMA16(va, pb0, o[0][dt]); o[1][dt] = MFMA16(va, pb1, o[1][dt]);
                }
            }
        }
        asm volatile("s_waitcnt vmcnt(8) lgkmcnt(0)" ::: "memory");
        __builtin_amdgcn_s_barrier();
    }
    asm volatile("s_waitcnt vmcnt(0)" ::: "memory");
    if (my_nkt > 0) {
        const float i0 = 1.f / osum[0][0], i1 = lam / osum[1][0];
        float sq = 0.f;
#pragma unroll
        for (int dt = 0; dt < 8; ++dt)
#pragma unroll
            for (int r = 0; r < 4; ++r) { const float v = o[0][dt][r] * i0 - o[1][dt][r] * i1; o[0][dt][r] = v; sq += v * v; }
        const float rs = rsqrtf(xr16_32_sum(sq) * (1.f / 128.f) + 1e-5f) * (1.f - LAM_INIT);
        const float* sg = p.in[15];
#pragma unroll
        for (int dt = 0; dt < 8; ++dt) {
            const int e = 16 * dt + 4 * g;
            const float4 gg = *(const float4*)(sg + e);
            *(uint2*)(H + row * 1024 + h * 128 + e) = make_uint2(pk2(o[0][dt][0] * rs * gg.x, o[0][dt][1] * rs * gg.y), pk2(o[0][dt][2] * rs * gg.z, o[0][dt][3] * rs * gg.w));
        }
    }
#undef DA_ISSUE
}

__device__ __forceinline__ void phase_ln(const Params& p, const float* gam, const float* bet, const bf16_t* Zb, bf16_t* Xd, bool fin) {
    const int lane = TIDX() & 63, w = TIDX() >> 6;
    float4 gg[4], bb[4];
#pragma unroll
    for (int i = 0; i < 4; ++i) { gg[i] = ((const float4*)gam)[lane + 64 * i]; bb[i] = ((const float4*)bet)[lane + 64 * i]; }
    for (int row = BIDX() * 8 + w; row < TT; row += gridDim.x * 8) {
        const uint2* z = (const uint2*)(Zb + (size_t)row * 1024);
        float4 v[4]; float s = 0.f;
#pragma unroll
        for (int i = 0; i < 4; ++i) { const uint2 u = z[lane + 64 * i]; v[i] = make_float4(bflo(u.x), bfhi(u.x), bflo(u.y), bfhi(u.y)); s += (v[i].x + v[i].y) + (v[i].z + v[i].w); }
        const float mean = wave_sum(s) * (1.f / 1024.f);
        float q = 0.f;
#pragma unroll
        for (int i = 0; i < 4; ++i) { v[i].x -= mean; v[i].y -= mean; v[i].z -= mean; v[i].w -= mean; q += (v[i].x * v[i].x + v[i].y * v[i].y) + (v[i].z * v[i].z + v[i].w * v[i].w); }
        const float rstd = rsqrtf(wave_sum(q) * (1.f / 1024.f) + 1e-5f);
        uint2* xd = (uint2*)(Xd + (size_t)row * 1024);
        float4* yo = (float4*)(p.out + (size_t)row * 1024);
#pragma unroll
        for (int i = 0; i < 4; ++i) {
            float4 y; y.x = v[i].x * rstd * gg[i].x + bb[i].x; y.y = v[i].y * rstd * gg[i].y + bb[i].y; y.z = v[i].z * rstd * gg[i].z + bb[i].z; y.w = v[i].w * rstd * gg[i].w + bb[i].w;
            if (fin) yo[lane + 64 * i] = y; else xd[lane + 64 * i] = make_uint2(pk2(y.x, y.y), pk2(y.z, y.w));
        }
    }
}

__device__ __forceinline__ int next_unit(int* ctr, char* lds) {
    int* slot = (int*)(lds + LDS_MAIN);
    if (TIDX() == 0) *slot = atomicAdd(ctr, 1);
    __syncthreads();
    const int u = *slot;
    __syncthreads();
    return u;
}


#define XB_TMO      128
#define XB_XCNT(j)  (256  + 64 * (j))
#define XB_XSUB(j)  (1280 + 64 * (j))
#define XB_XGEN(j)  (2304 + 64 * (j))
#define XB_TOP      3328
#define XB_TOPGEN   3392
#define XCD_BAR_WORDS 3456
#define XB_SPIN_CAP (1u << 18)
__device__ __forceinline__ unsigned xb_ld(unsigned* p)              { return __hip_atomic_load(p, __ATOMIC_RELAXED, __HIP_MEMORY_SCOPE_AGENT); }
__device__ __forceinline__ unsigned xb_add(unsigned* p, unsigned v) { return __hip_atomic_fetch_add(p, v, __ATOMIC_RELAXED, __HIP_MEMORY_SCOPE_AGENT); }
__device__ __forceinline__ unsigned xb_xcc_id() { return (unsigned)__builtin_amdgcn_s_getreg((3 << 11) | 20) & 0xFu; }
#define XB_SPIN(cond, bar) do { unsigned _sp = 0; while (cond) { __builtin_amdgcn_s_sleep(1); \
    if ((++_sp & 255u) == 0u) { if (xb_ld(&(bar)[XB_TMO])) break; if (_sp > XB_SPIN_CAP) { atomicAdd(&(bar)[XB_TMO], 1u); break; } } } } while (0)
struct XcdBarrier { unsigned* bar; unsigned x; volatile LAS unsigned* st; };
__device__ __forceinline__ XcdBarrier xcd_barrier_post(unsigned* bar, volatile LAS unsigned* st) {
    XcdBarrier b; b.bar = bar; b.x = xb_xcc_id(); b.st = st;
    if (TIDX() == 0) (void)xb_add(&bar[XB_XCNT(b.x)], 1u);
    return b;
}
__device__ __forceinline__ void xcd_barrier_complete(unsigned* bar, unsigned x, unsigned& nloc, unsigned& nx) {
    const unsigned G = gridDim.x * gridDim.y * gridDim.z;
    unsigned sum, cnt, mine, sp = 0u;
    for (;;) {
        sum = 0u; cnt = 0u; mine = 0u;
#pragma unroll
        for (unsigned j = 0; j < 16; ++j) { const unsigned c = xb_ld(&bar[XB_XCNT(j)]); sum += c; cnt += (c > 0u) ? 1u : 0u; mine = (j == x) ? c : mine; }
        if (sum == G) break;
        __builtin_amdgcn_s_sleep(1);
        if ((++sp & 255u) == 0u) { if (xb_ld(&bar[XB_TMO])) break; if (sp > XB_SPIN_CAP) { atomicAdd(&bar[XB_TMO], 1u); break; } }
    }
    nloc = mine > 0u ? mine : 1u; nx = cnt > 0u ? cnt : 1u;
}
__device__ __forceinline__ void xcd_barrier(const XcdBarrier& b) {
    asm volatile("s_waitcnt vmcnt(0)" ::: "memory");
    __syncthreads();
    if (TIDX() == 0) {
        unsigned* bar = b.bar;
        __builtin_amdgcn_s_waitcnt(0);
        unsigned nloc = b.st[0], nx = b.st[1];
        if (nloc == 0u) { xcd_barrier_complete(bar, b.x, nloc, nx); b.st[0] = nloc; b.st[1] = nx; }
        const unsigned old = xb_add(&bar[XB_XSUB(b.x)], 1u);
        const unsigned gen = old / nloc;
        if (old + 1u == (gen + 1u) * nloc) {
            __builtin_amdgcn_fence(__ATOMIC_RELEASE, "agent");
            asm volatile("s_waitcnt vmcnt(0)" ::: "memory");
            const unsigned og = xb_add(&bar[XB_TOP], 1u);
            const unsigned tg = og / nx;
            if (og + 1u == (tg + 1u) * nx) xb_add(&bar[XB_TOPGEN], 1u);
            else XB_SPIN(xb_ld(&bar[XB_TOPGEN]) == tg, bar);
            __builtin_amdgcn_fence(__ATOMIC_ACQUIRE, "agent");
            xb_add(&bar[XB_XGEN(b.x)], 1u);
            asm volatile("s_waitcnt vmcnt(0)" ::: "memory");
        } else {
            XB_SPIN(xb_ld(&bar[XB_XGEN(b.x)]) == gen, bar);
            __builtin_amdgcn_fence(__ATOMIC_ACQUIRE, "agent");
            asm volatile("s_waitcnt vmcnt(0)" ::: "memory");
        }
    }
    __syncthreads();
}

__device__ __forceinline__ void run_phase(const Params& p_, const int ph, const int l, char* lds, const int cslot = 0) {
    Params p = p_;
    asm volatile("" : "+s"(p.ws), "+s"(p.out));
    char* ws = p.ws;
    bf16_t* XB = (bf16_t*)(ws + W_XB); bf16_t* Hb = (bf16_t*)(ws + W_H); bf16_t* RA = (bf16_t*)(ws + W_RA);
    int* ctr = (int*)(ws + W_CTRL);
    switch (ph) {
    case 0: phase_prep(p, lds); break;
    case 1: {
        gemm_phase(XB, (const bf16_t*)(ws + W_WRET), 1024, TT / 256, NRET / 256, lds, EpiBf16{RA, NRET});
        for (int ll = 0; ll < 2; ++ll)
            gemm_phase((const bf16_t*)(ws + W_MB), (const bf16_t*)(ws + W_WMKV) + (size_t)ll * 512 * 1024, 1024, 8, 2, lds,
                       EpiMemKV{p.out + O_MKP + (size_t)ll * 524288, p.out + O_MVP + (size_t)ll * 524288, (bf16_t*)(ws + W_MK) + (size_t)ll * 24 * 65536, (bf16_t*)(ws + W_MVT) + (size_t)ll * 24 * 65536},
                       (1716 % 256 + 16 * ll) % (int)gridDim.x);
    } break;
    case 2: {
        bf16_t* RS = (bf16_t*)(p.out + O_DKP);
        for (;;) {
            const int u = next_unit(ctr + 0 + cslot, lds);
            if (u >= 192 + 384 + 320) break;
            if (u < 576) {
                const bool pr = u < 192; const int us = pr ? u : u - 192, chain = us >> 2, sl = us & 3, b = chain / 6, h = chain % 6;
                ret_chain(p, h, sl, pr ? 64 : 1, pr ? b * 4096 : TP + b * 64, pr ? 0 : 1024, pr ? nullptr : p.in[3] + (size_t)chain * 16384,
                          RS + (pr ? (size_t)chain * 64 : (size_t)(3072 + chain)) * 16384, p.out + (pr ? O_RSP : O_RSS) + (size_t)chain * 16384, lds);
            }
            else mem_attn(p, u - 576, 0, lds);
        }
    } break;
    case 3: for (int u2 = BIDX(); u2 < 1584; u2 += gridDim.x) ret_out(p, u2, lds); break;
    case 4: gemm_phase(Hb, (const bf16_t*)(ws + W_WO) + (size_t)l * 1024 * 1024, 1024, TT / 256, 4, lds, EpiResid{XB, RA}); break;
    case 5: phase_ln(p, p.in[18] + l * 1024, p.in[19] + l * 1024, RA, Hb, false); break;
    case 6: gemm_phase(Hb, (const bf16_t*)(ws + W_WGU) + (size_t)l * 5632 * 1024, 1024, TT / 256, 22, lds, EpiGU{RA}); break;
    case 7: gemm_phase(RA, (const bf16_t*)(ws + W_WD) + (size_t)l * 1024 * DFF, DFF, TT / 256, 4, lds, EpiResid{Hb, XB}); break;
    case 8: phase_ln(p, p.in[23] + l * 1024, p.in[24] + l * 1024, XB, XB, l == 1); break;
    case 9: {
        { uint2* dst = (uint2*)(ws + W_KBS); const float4* s = (const float4*)p.in[4];
          const int skip = (int)gridDim.x > 80 ? 40 : 0, cb = BIDX() - skip, ncb = (int)gridDim.x - skip;
          const size_t per = 1024ull * 192, gt = (size_t)cb * NTHR + TIDX(), gs = (size_t)ncb * NTHR;
          if (cb >= 0) for (size_t i = gt; i < 16 * per; i += gs) { const size_t b = i / per, rem = i - b * per; const float4 v = s[i]; dst[b * (1088ull * 192) + rem] = make_uint2(pk2(v.x, v.y), pk2(v.z, v.w)); } }
        { const int tid = TIDX(), half = tid >> 8;
          const int skip = (int)gridDim.x > 80 ? 40 : 0, cb = BIDX() - skip, ncb = (int)gridDim.x - skip;
          if (cb >= 0 && cb < 1536) {
              float* tile = (float*)lds + half * 4224; const int tl = tid & 255;
              TrDesc dc = tr_desc9(p, 2 * cb + half); float4 r[4]; tr_load(dc, r, tl);
              for (int it2 = cb; it2 < 1536; it2 += ncb) {
                  const bool has = it2 + ncb < 1536;
                  TrDesc dn = dc; float4 rn[4];
                  if (has) { dn = tr_desc9(p, 2 * (it2 + ncb) + half); tr_load(dn, rn, tl); }
                  tr_finish(dc, r, tile, tl);
                  if (has) { dc = dn;
#pragma unroll
                      for (int i = 0; i < 4; ++i) r[i] = rn[i]; }
              }
          } }
        gemm_phase(XB, (const bf16_t*)(ws + W_WDIFF), 1024, TT / 256, NDIFF / 256, lds,
                   EpiProj1{(bf16_t*)(ws + W_QM), (bf16_t*)(ws + W_KBP), (bf16_t*)(ws + W_KBS), (bf16_t*)(ws + W_VTP), (bf16_t*)(ws + W_VTS), p.out, (const float2*)(ws + W_ROPED)});
    } break;
    case 10: {
        float lam;
        { const int lane = TIDX() & 63; const float a = wave_sum(p.in[11][lane] * p.in[12][lane]), b = wave_sum(p.in[13][lane] * p.in[14][lane]); lam = expf(a) - expf(b) + LAM_INIT; }
        for (;;) {
            const int u = next_unit(ctr + 1 + cslot, lds);
            if (u >= 1536 + 96 + 320) break;
            if (u < 1632) {
                const bool pr = u >= 96; const int up = u - 96, qp = 31 - up / 48, bh = pr ? up % 48 : u, b = bh / 6, h = bh % 6;
                diff_attn(p, pr ? b * 4096 + qp * 128 : TP + b * 64, h,
                          pr ? (const bf16_t*)(ws + W_KBP) + (size_t)b * 4096 * 768 + h * 128 : (const bf16_t*)(ws + W_KBS) + (size_t)b * 1088 * 768 + h * 128,
                          pr ? (const bf16_t*)(ws + W_VTP) + (size_t)bh * 128 * 4096 : (const bf16_t*)(ws + W_VTS) + (size_t)bh * 128 * 1088,
                          pr ? 4096 : 1088, pr ? 2 * qp + 2 : 17, pr ? 2 * qp + 1 : 17, pr, lam, lds);
            }
            else mem_attn(p, u - 1632, 1, lds);
        }
    } break;
    default: break;
    }
}

#ifndef PROBE_PH
#define PROBE_PH -1
#endif
extern "C" __global__ void __launch_bounds__(512, 2) mega_fwd(Params p) {
    extern __shared__ __attribute__((aligned(16))) char lds[];
    cg::grid_group grid = cg::this_grid();
    volatile LAS unsigned* xst = (volatile LAS unsigned*)(lds + LDS_MAIN + 16);
    if (TIDX() == 0) { xst[0] = 0u; xst[1] = 0u; }
    __syncthreads();
    (void)xcd_barrier_post((unsigned*)(p.ws + W_CTRL), xst);
#define XBAR() do { XcdBarrier xb_; xb_.bar = (unsigned*)(p.ws + W_CTRL); xb_.x = xb_xcc_id(); xb_.st = (volatile LAS unsigned*)(lds + LDS_MAIN + 16); xcd_barrier(xb_); } while (0)
    run_phase(p, 0, 0, lds);
    if (p.ph_lo != 0) grid.sync();
    XBAR();
#if PROBE_PH == 0
    run_phase(p, 0, 0, lds); XBAR();
#endif
    run_phase(p, 1, 0, lds); XBAR();
    run_phase(p, 2, 0, lds); XBAR();
#if PROBE_PH == 2
    run_phase(p, 2, 0, lds, 2); XBAR();
#endif
    run_phase(p, 3, 0, lds); XBAR();
#if PROBE_PH == 3
    run_phase(p, 3, 0, lds); XBAR();
#endif
    run_phase(p, 4, 0, lds); XBAR();
    run_phase(p, 5, 0, lds); XBAR();
    run_phase(p, 6, 0, lds); XBAR();
    run_phase(p, 7, 0, lds); XBAR();
    run_phase(p, 8, 0, lds); XBAR();
    run_phase(p, 9, 1, lds); XBAR();
    run_phase(p, 10, 1, lds); XBAR();
    run_phase(p, 4, 1, lds); XBAR();
    run_phase(p, 5, 1, lds); XBAR();
    run_phase(p, 6, 1, lds); XBAR();
    run_phase(p, 7, 1, lds); XBAR();
    run_phase(p, 8, 1, lds);
}

#ifndef PROBE_PH
#define PROBE_PH -1
#endif
#ifndef MULTI_LAUNCH
#define MULTI_LAUNCH 0
#endif
#if MULTI_LAUNCH
extern "C" __global__ void __launch_bounds__(512, 2) phase_kernel(Params p) {
    extern __shared__ __attribute__((aligned(16))) char lds[];
    switch (p.ph_lo) {
    case 0: run_phase(p, 0, 0, lds); break;
    case 1: run_phase(p, 1, 0, lds); break;
    case 2: run_phase(p, 2, 0, lds); break;
    case 3: run_phase(p, 3, 0, lds); break;
    case 4: run_phase(p, 4, p.ph_hi, lds); break;
    case 5: run_phase(p, 5, p.ph_hi, lds); break;
    case 6: run_phase(p, 6, p.ph_hi, lds); break;
    case 7: run_phase(p, 7, p.ph_hi, lds); break;
    case 8: run_phase(p, 8, p.ph_hi, lds); break;
    case 9: run_phase(p, 9, 1, lds); break;
    case 10: run_phase(p, 10, 1, lds); break;
    default: break;
    }
}
#endif

extern "C" void kernel_launch(void* const* d_in, const int* in_sizes, int n_in, void* d_out, int out_size, void* d_ws, size_t ws_size, hipStream_t stream) {
    static int grid = 0;
#if MULTI_LAUNCH
    const void* kfn = (const void*)phase_kernel;
#else
    const void* kfn = (const void*)mega_fwd;
#endif
    if (grid == 0) {
        int dev = 0, cus = 0, per_cu = 0;
        (void)hipGetDevice(&dev);
        (void)hipDeviceGetAttribute(&cus, hipDeviceAttributeMultiprocessorCount, dev);
        (void)hipFuncSetAttribute(kfn, hipFuncAttributeMaxDynamicSharedMemorySize, LDS_BYTES);
        (void)hipOccupancyMaxActiveBlocksPerMultiprocessor(&per_cu, kfn, NTHR, LDS_BYTES);
        if (per_cu < 1) { fprintf(stderr, "kernel_launch: occupancy query reports %d blocks per CU\n", per_cu); per_cu = 1; }
        grid = cus;
        if (ws_size < W_END) { fprintf(stderr, "kernel_launch: workspace too small: %zu < %zu\n", ws_size, (size_t)W_END); grid = -1; }
    }
    if (grid < 0) return;
    (void)hipMemsetAsync((char*)d_ws + W_CTRL, 0, 16384, stream);
    Params p{};
    for (int i = 0; i < 25; ++i) p.in[i] = (const float*)d_in[i];
    p.out = (float*)d_out; p.ws = (char*)d_ws; p.ph_lo = 0; p.ph_hi = 16;
#if MULTI_LAUNCH
    static const int seq[16][2] = {{0,0},{1,0},{2,0},{3,0},{4,0},{5,0},{6,0},{7,0},{8,0},{9,1},{10,1},{4,1},{5,1},{6,1},{7,1},{8,1}};
    for (int i = 0; i < 16; ++i) {
        p.ph_lo = seq[i][0]; p.ph_hi = seq[i][1];
        hipLaunchKernelGGL(phase_kernel, dim3(grid), dim3(NTHR), LDS_BYTES, stream, p);
    }
#else
    void* args[] = {&p};
    hipError_t e = hipLaunchCooperativeKernel(kfn, dim3(grid), dim3(NTHR), args, LDS_BYTES, stream);
    if (e != hipSuccess) fprintf(stderr, "cooperative launch failed: %s (grid %d)\n", hipGetErrorString(e), grid);
#endif
}
```

```cpp
#include <hip/hip_runtime.h>
#include <hip/hip_cooperative_groups.h>
#include <stdint.h>
#include <stdio.h>
namespace cg = cooperative_groups;

typedef unsigned short bf16_t;
typedef short bf16x8 __attribute__((ext_vector_type(8)));
typedef float f32x4 __attribute__((ext_vector_type(4)));
typedef float f32x16 __attribute__((ext_vector_type(16)));
#define LAS __attribute__((address_space(3)))

#define MFMA32(a, b, c) __builtin_amdgcn_mfma_f32_32x32x16_bf16(a, b, c, 0, 0, 0)
#define MFMA16(a, b, c) __builtin_amdgcn_mfma_f32_16x16x32_bf16(a, b, c, 0, 0, 0)

constexpr int TP = 32768, TS = 1024, TT = TP + TS;
constexpr int NRET = 3328, NDIFF = 2560, DFF = 2816;
constexpr float ALPHA = 1.41421356237f;
constexpr float LAM_INIT = 0.35550907f;
constexpr int NTHR = 512;
constexpr int LDS_MAIN = 131072, LDS_BYTES = LDS_MAIN + 256;

constexpr size_t O_YP = 0, O_RSP = 34603008, O_RSS = 35389440, O_DKP = 36962304, O_DVP = 62128128,
                 O_DKS = 87293952, O_DVS = 88080384, O_MKP = 88866816, O_MVP = 89915392;
constexpr size_t W_CTRL = 0;
constexpr size_t W_ROPER = 16384;
constexpr size_t W_ROPED = W_ROPER + 4096ull * 64 * 8;
constexpr size_t W_WRET = W_ROPED + 4096ull * 8 * 8;
constexpr size_t W_WDIFF = W_WRET + (size_t)NRET * 1024 * 2;
constexpr size_t W_WMKV = W_WDIFF + (size_t)NDIFF * 1024 * 2;
constexpr size_t W_WO = W_WMKV + 2ull * 512 * 1024 * 2;
constexpr size_t W_WGU = W_WO + 2ull * 1024 * 1024 * 2;
constexpr size_t W_WD = W_WGU + 2ull * 5632 * 1024 * 2;
constexpr size_t W_MB = W_WD + 2ull * 1024 * 2816 * 2;
constexpr size_t W_MK = W_MB + 2048ull * 1024 * 2;
constexpr size_t W_MVT = W_MK + 2ull * 24 * 65536 * 2;
constexpr size_t W_XB = W_MVT + 2ull * 24 * 65536 * 2;
constexpr size_t W_H = W_XB + (size_t)TT * 1024 * 2;
constexpr size_t W_RA = W_H + (size_t)TT * 1024 * 2;
constexpr size_t W_END = W_RA + (size_t)TT * NRET * 2;
constexpr size_t W_QM = W_RA;
constexpr size_t W_KBP = W_QM + (size_t)TT * 1024 * 2;
constexpr size_t W_KBS = W_KBP + 8ull * 4096 * 768 * 2;
constexpr size_t W_VTP = W_KBS + 16ull * 1088 * 768 * 2;
constexpr size_t W_VTS = W_VTP + 8ull * 6 * 128 * 4096 * 2;
static_assert(W_VTS + 16ull * 6 * 128 * 1088 * 2 <= W_END, "layer-1 overlay too big");

struct Params {
    const float* in[25];
    float* out;
    char* ws;
    int ph_lo, ph_hi;
};

__device__ __forceinline__ int TIDX() { int t = threadIdx.x; asm volatile("" : "+v"(t)); return t; }
__device__ __forceinline__ int BIDX() { int t = blockIdx.x; asm volatile("" : "+s"(t)); return t; }
typedef __bf16 bf2_t __attribute__((ext_vector_type(2)));
typedef float f2_t __attribute__((ext_vector_type(2)));
__device__ __forceinline__ uint32_t pk2(float lo, float hi) { f2_t f = {lo, hi}; bf2_t b = __builtin_convertvector(f, bf2_t); return *(uint32_t*)&b; }
__device__ __forceinline__ bf16_t f2bf(float f) { return (bf16_t)(pk2(f, 0.f) & 0xffffu); }
__device__ __forceinline__ float bf2f(bf16_t b) { return __uint_as_float(((uint32_t)b) << 16); }
__device__ __forceinline__ float bflo(uint32_t u) { return __uint_as_float(u << 16); }
__device__ __forceinline__ float bfhi(uint32_t u) { return __uint_as_float(u & 0xffff0000u); }
__device__ __forceinline__ bf16x8 mk8(uint32_t a, uint32_t b, uint32_t c, uint32_t d) { uint4 u = make_uint4(a, b, c, d); return *(bf16x8*)&u; }
__device__ __forceinline__ bf16x8 pack8(f32x4 a, f32x4 b) { return mk8(pk2(a[0], a[1]), pk2(a[2], a[3]), pk2(b[0], b[1]), pk2(b[2], b[3])); }
__device__ __forceinline__ bf16x8 ld8(const bf16_t* p) { return *(const bf16x8*)p; }
__device__ __forceinline__ bf16x8 ld44(const bf16_t* lo, const bf16_t* hi) { uint2 a = *(const uint2*)lo, b = *(const uint2*)hi; return mk8(a.x, a.y, b.x, b.y); }
__device__ __forceinline__ float xr16_32_max(float v) { v = fmaxf(v, __shfl_xor(v, 16)); v = fmaxf(v, __shfl_xor(v, 32)); return v; }
__device__ __forceinline__ float xr16_32_sum(float v) { v += __shfl_xor(v, 16); v += __shfl_xor(v, 32); return v; }
__device__ __forceinline__ float wave_sum(float v) { for (int o = 1; o < 64; o <<= 1) v += __shfl_xor(v, o); return v; }
__device__ __forceinline__ void unpack8(uint4 u, float* f) { f[0] = bflo(u.x); f[1] = bfhi(u.x); f[2] = bflo(u.y); f[3] = bfhi(u.y); f[4] = bflo(u.z); f[5] = bfhi(u.z); f[6] = bflo(u.w); f[7] = bfhi(u.w); }
__device__ __forceinline__ float silu(float x) { return x / (1.f + __expf(-x)); }

constexpr int G_BK = 64, G_HT = 128 * 64;
__device__ __forceinline__ int lds_byte(int r, int c) { const int st = (r >> 4) * 2 + (c >> 5), rr = r & 15, cc = c & 31, ob = rr * 64 + cc * 2; return st * 1024 + (ob ^ (((ob >> 9) & 1) << 5)); }
__device__ __forceinline__ void stage_rc(int b, int& R, int& C) { const int st = b / 1024, sb = b % 1024, swz = sb ^ (((sb >> 9) & 1) << 5); R = (st >> 1) * 16 + swz / 64; C = (st & 1) * 32 + (swz % 64) / 2; }

template <class Epi>
__device__ __forceinline__ void gemm256_tile(const bf16_t* __restrict__ A, const bf16_t* __restrict__ Bt, const int K, const int brow, const int bcol, const bool pre, const int nrow, const int ncol, char* lds, const Epi& epi) {
    bf16_t* shm = (bf16_t*)lds;
#define SA(b, h) (shm + ((b) * 2 + (h)) * G_HT)
#define SB(b, h) (shm + (4 + (b) * 2 + (h)) * G_HT)
#define STAGE(P, BASE, br, kt) do { const long _g = (long)(br) * K + (long)(kt) * G_BK; \
    _Pragma("unroll") for (int _i = 0; _i < 2; ++_i) { const int _b = tid * 16 + _i * 8192; int _r, _c; stage_rc(_b, _r, _c); \
      __builtin_amdgcn_global_load_lds((const unsigned*)(BASE + _g + (long)_r * K + _c), (__attribute__((address_space(3))) unsigned*)((char*)(P) + _b), 16, 0, 0); } } while (0)
#define LDA(dst, b, h) _Pragma("unroll") for (int m = 0; m < 4; ++m) _Pragma("unroll") for (int k = 0; k < 2; ++k) \
    dst[m][k] = *reinterpret_cast<const bf16x8*>((char*)SA(b, h) + lds_byte(wr * 64 + m * 16 + fr, k * 32 + fq * 8))
#define LDB(dst, b, h) _Pragma("unroll") for (int n = 0; n < 2; ++n) _Pragma("unroll") for (int k = 0; k < 2; ++k) \
    dst[n][k] = *reinterpret_cast<const bf16x8*>((char*)SB(b, h) + lds_byte(wc * 32 + n * 16 + fr, k * 32 + fq * 8))
#define MMA(ai, bj, At_, Bt_) do { __builtin_amdgcn_s_setprio(1); \
    _Pragma("unroll") for (int m = 0; m < 4; ++m) _Pragma("unroll") for (int n = 0; n < 2; ++n) _Pragma("unroll") for (int k = 0; k < 2; ++k) \
      acc[ai][bj][m][n] = MFMA16(Bt_[n][k], At_[m][k], acc[ai][bj][m][n]); \
    __builtin_amdgcn_s_setprio(0); } while (0)
#define WAIT_V(n) asm volatile("s_waitcnt vmcnt(" #n ")" ::: "memory")
#define WAIT_L(n) asm volatile("s_waitcnt lgkmcnt(" #n ")" ::: "memory")
#define BAR __builtin_amdgcn_s_barrier()
#define SCHED __builtin_amdgcn_sched_barrier(0)
    const int tid = TIDX();
    const int wid = tid >> 6, lane = tid & 63, wr = wid >> 2, wc = wid & 3, fr = lane & 15, fq = lane >> 4;
    constexpr int HALF = 128;
    f32x4 acc[2][2][4][2];
#pragma unroll
    for (int a = 0; a < 2; ++a)
#pragma unroll
        for (int b = 0; b < 2; ++b)
#pragma unroll
            for (int m = 0; m < 4; ++m)
#pragma unroll
                for (int n = 0; n < 2; ++n) acc[a][b][m][n] = (f32x4){0.f, 0.f, 0.f, 0.f};
    bf16x8 At[4][2], B0[2][2], B1[2][2];
    const int nt = K / G_BK;
    asm volatile("s_waitcnt vmcnt(0) lgkmcnt(0)" ::: "memory");
    __syncthreads();
    if (!pre) {
        STAGE(SB(0, 0), Bt, bcol, 0); STAGE(SA(0, 0), A, brow, 0);
        STAGE(SB(0, 1), Bt, bcol + HALF, 0); STAGE(SA(0, 1), A, brow + HALF, 0);
    }
    if (wr == 1) BAR;
    WAIT_V(4); BAR;
    STAGE(SB(1, 0), Bt, bcol, 1); STAGE(SA(1, 0), A, brow, 1); STAGE(SB(1, 1), Bt, bcol + HALF, 1);
    WAIT_V(6); BAR;
    for (int t = 0; t < nt - 2; t += 2) {
        LDB(B0, 0, 0); SCHED; LDA(At, 0, 0); STAGE(SA(1, 1), A, brow + HALF, t + 1);
        WAIT_L(8); BAR; WAIT_L(0); MMA(0, 0, At, B0); BAR; SCHED;
        LDB(B1, 0, 1); STAGE(SB(0, 0), Bt, bcol, t + 2);
        BAR; WAIT_L(0); MMA(0, 1, At, B1); BAR;
        LDA(At, 0, 1); STAGE(SA(0, 0), A, brow, t + 2);
        BAR; WAIT_L(0); MMA(1, 0, At, B0); BAR; SCHED;
        STAGE(SB(0, 1), Bt, bcol + HALF, t + 2);
        WAIT_V(6); BAR; MMA(1, 1, At, B1); BAR;
        LDB(B0, 1, 0); SCHED; LDA(At, 1, 0); STAGE(SA(0, 1), A, brow + HALF, t + 2);
        WAIT_L(8); BAR; WAIT_L(0); MMA(0, 0, At, B0); BAR; SCHED;
        LDB(B1, 1, 1); STAGE(SB(1, 0), Bt, bcol, t + 3);
        BAR; WAIT_L(0); MMA(0, 1, At, B1); BAR;
        LDA(At, 1, 1); STAGE(SA(1, 0), A, brow, t + 3);
        BAR; WAIT_L(0); MMA(1, 0, At, B0); BAR; SCHED;
        STAGE(SB(1, 1), Bt, bcol + HALF, t + 3);
        WAIT_V(6); BAR; MMA(1, 1, At, B1); BAR;
    }
    { LDB(B0, 0, 0); LDA(At, 0, 0); STAGE(SA(1, 1), A, brow + HALF, nt - 1);
      BAR; WAIT_L(0); MMA(0, 0, At, B0); BAR;
      LDB(B1, 0, 1); BAR; WAIT_L(0); MMA(0, 1, At, B1); BAR;
      LDA(At, 0, 1); WAIT_V(4); BAR; WAIT_L(0); MMA(1, 0, At, B0); MMA(1, 1, At, B1); BAR; }
    { LDB(B0, 1, 0); LDA(At, 1, 0); WAIT_V(2); BAR; WAIT_L(0); MMA(0, 0, At, B0); BAR;
      LDB(B1, 1, 1); WAIT_V(0); BAR; WAIT_L(0); MMA(0, 1, At, B1); BAR;
      LDA(At, 1, 1); BAR; WAIT_L(0); MMA(1, 0, At, B0); MMA(1, 1, At, B1); BAR; }
    if (wr == 0) BAR;
    if (nrow >= 0) {
        STAGE(SB(0, 0), Bt, ncol, 0); STAGE(SA(0, 0), A, nrow, 0);
        STAGE(SB(0, 1), Bt, ncol + HALF, 0); STAGE(SA(0, 1), A, nrow + HALF, 0);
    }
    epi(acc, brow, bcol, wr, wc, fr, fq);
#undef SA
#undef SB
#undef STAGE
#undef LDA
#undef LDB
#undef MMA
}

__device__ __forceinline__ bool gemm_tile_coord(int i, int G, int c, int nM, int nN, int& pm, int& pn) {
    const int nwg = nM * nN; const long L = (long)i * G + c; if (L >= nwg) return false;
    int wgid = (int)L; { const int q = nwg / 8, r = nwg % 8, xcd = wgid % 8, off = wgid / 8; wgid = (xcd < r ? xcd * (q + 1) : r * (q + 1) + (xcd - r) * q) + off; }
    const int nig = 8 * nN, gid = wgid / nig, fm = gid * 8, gsz = (nM - fm) < 8 ? (nM - fm) : 8;
    pm = fm + ((wgid % nig) % gsz); pn = (wgid % nig) / gsz; return true;
}
template <class Epi>
__device__ __forceinline__ void gemm_phase(const bf16_t* A, const bf16_t* Bt, int K, int nM, int nN, char* lds, const Epi& epi, const int coff = 0) {
    const int G = gridDim.x, c = (BIDX() + G - coff) % G;
    int pm, pn; bool have = gemm_tile_coord(0, G, c, nM, nN, pm, pn), pre = false;
    for (int i = 0; have; ++i) {
        int qm = 0, qn = 0; const bool nxt = gemm_tile_coord(i + 1, G, c, nM, nN, qm, qn);
        gemm256_tile(A, Bt, K, pm * 256, pn * 256, pre, (Epi::PRESTAGE && nxt) ? qm * 256 : -1, qn * 256, lds, epi);
        pre = Epi::PRESTAGE && nxt; have = nxt; pm = qm; pn = qn;
    }
}

#define EPI_ARGS f32x4 (&acc)[2][2][4][2], int brow, int bcol, int wr, int wc, int fr, int fq
#define EPI_LOOP _Pragma("unroll") for (int ai = 0; ai < 2; ++ai) _Pragma("unroll") for (int bj = 0; bj < 2; ++bj) _Pragma("unroll") for (int m = 0; m < 4; ++m) _Pragma("unroll") for (int n = 0; n < 2; ++n)
#define EPI_ROW (brow + 128 * ai + 64 * wr + 16 * m + fr)
#define EPI_COL (bcol + 128 * bj + 32 * wc + 16 * n + 4 * fq)

__device__ __forceinline__ int vperm(int s) { return (s & ~31) | (((s >> 2) & 3) << 3) | (((s >> 4) & 1) << 2) | (s & 3); }
struct EpiBf16 {
    static constexpr bool PRESTAGE = true;
    bf16_t* C; int ldc;
    __device__ __forceinline__ void operator()(EPI_ARGS) const {
        EPI_LOOP { const f32x4 v = acc[ai][bj][m][n]; *(uint2*)(C + (size_t)EPI_ROW * ldc + EPI_COL) = make_uint2(pk2(v[0], v[1]), pk2(v[2], v[3])); }
    }
};
struct EpiMemKV {
    static constexpr bool PRESTAGE = false;
    float* outk; float* outv; bf16_t* mk; bf16_t* mvt;
    __device__ __forceinline__ void operator()(EPI_ARGS) const {
        EPI_LOOP {
            const int row = EPI_ROW, col = EPI_COL; const f32x4 v = acc[ai][bj][m][n];
            if (bcol == 0) { *(f32x4*)(outk + (size_t)row * 256 + col) = v; *(uint2*)(mk + (size_t)row * 256 + col) = make_uint2(pk2(v[0], v[1]), pk2(v[2], v[3])); }
            else { const int c = col - 256, b = row >> 8, mm = row & 255; *(f32x4*)(outv + (size_t)row * 256 + c) = v;
#pragma unroll
                for (int q = 0; q < 4; ++q) mvt[(size_t)((b * 4 + (c >> 6)) * 64 + (c & 63) + q) * 256 + mm] = f2bf(v[q]); }
        }
    }
};
struct EpiResid {
    static constexpr bool PRESTAGE = false;
    const bf16_t* X; bf16_t* Zb;
    __device__ __forceinline__ void operator()(EPI_ARGS) const {
#pragma unroll
        for (int ai = 0; ai < 2; ++ai)
#pragma unroll
            for (int bj = 0; bj < 2; ++bj) {
#pragma unroll
                for (int m = 0; m < 4; ++m)
#pragma unroll
                    for (int n = 0; n < 2; ++n) { const unsigned o = (unsigned)EPI_ROW * 1024u + (unsigned)EPI_COL; const uint2 x = *(const uint2*)(X + o); const f32x4 v = acc[ai][bj][m][n];
                        *(uint2*)(Zb + o) = make_uint2(pk2(ALPHA * bflo(x.x) + v[0], ALPHA * bfhi(x.x) + v[1]), pk2(ALPHA * bflo(x.y) + v[2], ALPHA * bfhi(x.y) + v[3])); }
                __builtin_amdgcn_sched_barrier(0);
            }
    }
};
struct EpiGU {
    static constexpr bool PRESTAGE = false;
    bf16_t* ACT;
    __device__ __forceinline__ void operator()(EPI_ARGS) const {
#pragma unroll
        for (int ai = 0; ai < 2; ++ai)
#pragma unroll
            for (int bj = 0; bj < 2; ++bj)
#pragma unroll
                for (int m = 0; m < 4; ++m) {
                    const int row = brow + 128 * ai + 64 * wr + 16 * m + fr, ocol = (bcol >> 1) + 64 * bj + 16 * wc + 4 * fq;
                    const f32x4 gt = acc[ai][bj][m][0], up = acc[ai][bj][m][1];
                    *(uint2*)(ACT + (size_t)row * DFF + ocol) = make_uint2(pk2(silu(gt[0]) * up[0], silu(gt[1]) * up[1]), pk2(silu(gt[2]) * up[2], silu(gt[3]) * up[3]));
                    __builtin_amdgcn_sched_barrier(0);
                }
    }
};
struct EpiProj1 {
    static constexpr bool PRESTAGE = false;
    bf16_t* QM; bf16_t* KBP; bf16_t* KBS; bf16_t* VTP; bf16_t* VTS; float* out; const float2* ropeD;
    __device__ __forceinline__ void operator()(EPI_ARGS) const {
        EPI_LOOP {
            const int row = EPI_ROW, col = EPI_COL;
            f32x4 v = acc[ai][bj][m][n];
            const int region = col < 768 ? 0 : (col < 1536 ? 1 : (col < 2304 ? 2 : 3));
            if (region <= 1) {
                const bool rot = ((wc & 1) == 0) && (n == 0);
                if (rot) {
                    f32x4 pr; pr[0] = __shfl_xor(v[0], 32); pr[1] = __shfl_xor(v[1], 32); pr[2] = __shfl_xor(v[2], 32); pr[3] = __shfl_xor(v[3], 32);
                    const int pos = row < TP ? (row & 4095) : 1024 + ((row - TP) & 63);
                    const float4* cs = (const float4*)(ropeD + pos * 8 + 4 * (fq & 1));
                    const float4 c01 = cs[0], c23 = cs[1];
                    const float cc[4] = {c01.x, c01.z, c23.x, c23.z}, sn[4] = {c01.y, c01.w, c23.y, c23.w};
#pragma unroll
                    for (int q = 0; q < 4; ++q) v[q] = fq < 2 ? v[q] * cc[q] - pr[q] * sn[q] : pr[q] * sn[q] + v[q] * cc[q];
                }
                const uint2 pk = make_uint2(pk2(v[0], v[1]), pk2(v[2], v[3]));
                if (region == 0) *(uint2*)(QM + (size_t)row * 1024 + col) = pk;
                else {
                    const int kc = col - 768;
                    if (row < TP) { *(uint2*)(KBP + (size_t)row * 768 + kc) = pk; *(f32x4*)(out + O_DKP + (size_t)row * 768 + kc) = v; }
                    else { const int rs = row - TP, b = rs >> 6, s = rs & 63; *(uint2*)(KBS + (size_t)(b * 1088 + 1024 + s) * 768 + kc) = pk; *(f32x4*)(out + O_DKS + (size_t)rs * 768 + kc) = v; }
                }
            } else if (region == 2) {
                const int vc = col - 1536, h = vc >> 7, dim = vc & 127;
                if (row < TP) {
                    const int b = row >> 12, s = row & 4095;
                    *(f32x4*)(out + O_DVP + (size_t)row * 768 + vc) = v;
#pragma unroll
                    for (int q = 0; q < 4; ++q) VTP[((size_t)(b * 6 + h) * 128 + dim + q) * 4096 + vperm(s)] = f2bf(v[q]);
                } else {
                    const int rs = row - TP, b = rs >> 6, s = rs & 63;
                    *(f32x4*)(out + O_DVS + (size_t)rs * 768 + vc) = v;
#pragma unroll
                    for (int q = 0; q < 4; ++q) VTS[((size_t)(b * 6 + h) * 128 + dim + q) * 1088 + 1024 + vperm(s)] = f2bf(v[q]);
                }
            } else {
                *(uint2*)(QM + (size_t)row * 1024 + 768 + (col - 2304)) = make_uint2(pk2(v[0], v[1]), pk2(v[2], v[3]));
            }
        }
    }
};

struct TrDesc { const float* src; bf16_t* dst; int lds_, ldd, k0, n0, mode, which; };
__device__ __forceinline__ void tr_load(const TrDesc& d, float4 (&r)[4], int tid) {
#pragma unroll
    for (int i = 0; i < 4; ++i) { const int k = (tid >> 4) + 16 * i, n4 = (tid & 15) * 4; r[i] = *(const float4*)(d.src + (size_t)(d.k0 + k) * d.lds_ + d.n0 + n4); }
}
__device__ __forceinline__ void tr_finish(const TrDesc& d, const float4 (&r)[4], float* tile, int tid) {
#pragma unroll
    for (int i = 0; i < 4; ++i) { const int k = (tid >> 4) + 16 * i, n4 = (tid & 15) * 4; float* t = tile + k * 65 + n4; t[0] = r[i].x; t[1] = r[i].y; t[2] = r[i].z; t[3] = r[i].w; }
    __syncthreads();
    const int n = tid >> 2, kq = (tid & 3) * 16;
    uint32_t w[8];
#pragma unroll
    for (int q = 0; q < 8; ++q) w[q] = pk2(tile[(kq + 2 * q) * 65 + n], tile[(kq + 2 * q + 1) * 65 + n]);
    const int c = d.n0 + n;
    const int row = d.mode != 1 ? c : (256 * (c >> 7) + 128 * ((c >> 6) & 1) + 32 * ((c >> 4) & 3) + 16 * d.which + (c & 15));
    if (d.mode == 2) {
        const int kk = d.k0 + kq, blk = kk & ~31, hi = (kk >> 4) & 1;
        bf16_t* o = d.dst + (size_t)c * d.ldd + blk + 4 * hi;
#pragma unroll
        for (int gg = 0; gg < 4; ++gg) *(uint2*)(o + 8 * gg) = make_uint2(w[2 * gg], w[2 * gg + 1]);
    } else {
        uint4* o = (uint4*)(d.dst + (size_t)row * d.ldd + d.k0 + kq);
        o[0] = make_uint4(w[0], w[1], w[2], w[3]); o[1] = make_uint4(w[4], w[5], w[6], w[7]);
    }
    __syncthreads();
}
__device__ __forceinline__ TrDesc tr_desc0(const Params& p, int it) {
    char* ws = p.ws;
    constexpr int T0 = 832, T1 = T0 + 640, T2 = T1 + 256, T3 = T2 + 512, T4 = T3 + 1408, T5 = T4 + 1408;
    if (it < T0) { const int kt = it / 52, nt = it % 52; return TrDesc{p.in[8], (bf16_t*)(ws + W_WRET), NRET, 1024, kt * 64, nt * 64, 0, 0}; }
    if (it < T1) { const int r = it - T0, kt = r / 40, nt = r % 40; return TrDesc{p.in[10], (bf16_t*)(ws + W_WDIFF), NDIFF, 1024, kt * 64, nt * 64, 0, 0}; }
    if (it < T2) { const int r = it - T1, l = r >> 7, q = r & 127, kt = q >> 3, nt = q & 7; return TrDesc{p.in[16] + (size_t)l * 1024 * 512, (bf16_t*)(ws + W_WMKV) + (size_t)l * 512 * 1024, 512, 1024, kt * 64, nt * 64, 0, 0}; }
    if (it < T3) { const int r = it - T2, l = r >> 8, q = r & 255, kt = q >> 4, nt = q & 15; return TrDesc{p.in[17] + (size_t)l * 1024 * 1024, (bf16_t*)(ws + W_WO) + (size_t)l * 1024 * 1024, 1024, 1024, kt * 64, nt * 64, 0, 0}; }
    if (it < T5) { const int wh = it >= T4; const int r = it - (wh ? T4 : T3), l = r / 704, q = r % 704, kt = q / 44, nt = q % 44;
        return TrDesc{p.in[wh ? 21 : 20] + (size_t)l * 1024 * DFF, (bf16_t*)(ws + W_WGU) + (size_t)l * 5632 * 1024, DFF, 1024, kt * 64, nt * 64, 1, wh}; }
    { const int r = it - T5, l = r / 704, q = r % 704, kt = q >> 4, nt = q & 15; return TrDesc{p.in[22] + (size_t)l * DFF * 1024, (bf16_t*)(ws + W_WD) + (size_t)l * 1024 * DFF, 1024, DFF, kt * 64, nt * 64, 0, 0}; }
}
__device__ __forceinline__ TrDesc tr_desc9(const Params& p, int it) {
    const int bh = it >> 5, q = it & 31, jt = q >> 1, dt = q & 1, b = bh / 6, h = bh % 6;
    return TrDesc{p.in[5] + (size_t)b * 1024 * 768 + h * 128, (bf16_t*)(p.ws + W_VTS) + (size_t)bh * 128 * 1088, 768, 1088, jt * 64, dt * 64, 2, 0};
}

__device__ __forceinline__ void phase_prep(const Params& p, char* lds) {
    char* ws = p.ws;
    const int nb = gridDim.x, bid = BIDX(), tid = TIDX(), half = tid >> 8, tl = tid & 255;
    float* tile = (float*)lds + half * 4224;
    constexpr int T6 = 832 + 640 + 256 + 512 + 3 * 1408;
    if (bid < T6 / 2) {
        TrDesc dc = tr_desc0(p, 2 * bid + half); float4 r[4]; tr_load(dc, r, tl);
        for (int it2 = bid; it2 < T6 / 2; it2 += nb) {
            const bool has = it2 + nb < T6 / 2;
            TrDesc dn = dc; float4 rn[4];
            if (has) { dn = tr_desc0(p, 2 * (it2 + nb) + half); tr_load(dn, rn, tl); }
            tr_finish(dc, r, tile, tl);
            if (has) { dc = dn;
#pragma unroll
                for (int i = 0; i < 4; ++i) r[i] = rn[i]; }
        }
    }
    const size_t gt = (size_t)bid * NTHR + tid, gs = (size_t)nb * NTHR;
    { uint2* dst = (uint2*)(ws + W_XB); const float4* xp = (const float4*)p.in[0]; const float4* xs = (const float4*)p.in[1];
      const size_t n4 = (size_t)TT * 256, np4 = (size_t)TP * 256;
      for (size_t i = gt; i < n4; i += gs) { const float4 v = i < np4 ? xp[i] : xs[i - np4]; dst[i] = make_uint2(pk2(v.x, v.y), pk2(v.z, v.w)); } }
    { uint2* dst = (uint2*)(ws + W_MB); const float4* s = (const float4*)p.in[2];
      for (size_t i = gt; i < 2048ull * 256; i += gs) { const float4 v = s[i]; dst[i] = make_uint2(pk2(v.x, v.y), pk2(v.z, v.w)); } }
    { uint2* dst = (uint2*)(ws + W_MK); const float4* s = (const float4*)p.in[6];
      for (size_t i = gt; i < 2ull * 16 * 16384; i += gs) { const size_t l = i / (16 * 16384), rem = i - l * 16 * 16384; const float4 v = s[i]; dst[(l * 24 + 8) * 16384 + rem] = make_uint2(pk2(v.x, v.y), pk2(v.z, v.w)); } }
    { bf16_t* dst = (bf16_t*)(ws + W_MVT); const float* s = p.in[7];
      for (size_t i = gt; i < 2ull * 16 * 65536; i += gs) {
          const int m = i & 255, dim = (i >> 8) & 63, h = (i >> 14) & 3, b = (i >> 16) & 15, l = (int)(i >> 20);
          dst[((size_t)((l * 24 + 8 + b) * 4 + h) * 64 + dim) * 256 + m] = f2bf(s[((size_t)(l * 16 + b) * 256 + m) * 256 + h * 64 + dim]); } }
    { float2* rr = (float2*)(ws + W_ROPER); float2* rd = (float2*)(ws + W_ROPED);
      for (size_t i = gt; i < 4096ull * 64; i += gs) { const int pos = (int)(i >> 6), f = (int)(i & 63); const float inv = expf(-logf(10000.f) * (float)f * 2.0f / 128.f); float sn, cs; sincosf((float)pos * inv, &sn, &cs); rr[i] = make_float2(cs, sn); }
      for (size_t i = gt; i < 4096ull * 8; i += gs) { const int pos = (int)(i >> 3), f = (int)(i & 7); const float inv = expf(-logf(500000.f) * (float)f * 2.0f / 16.f); float sn, cs; sincosf((float)pos * inv, &sn, &cs); rd[i] = make_float2(cs, sn); } }
    if (bid == 0 && tid < 64) ((int*)(ws + W_CTRL))[tid] = 0;
}

__device__ __forceinline__ void ret_chain(const Params& p, int h, int sl, int nsteps, int rowbase, int posbase, const float* init, bf16_t* rs, float* fin, char* lds) {
    const int tid = TIDX(), lane = tid & 63, w = tid >> 6, g = lane >> 4, lc = lane & 15;
    const float log_g = logf(1.f - exp2f(-5.f - (float)h));
    const float gch = expf(64.f * log_g);
    const float kscale = 0.08838834764831845f;
    const bf16_t* proj = (const bf16_t*)(p.ws + W_RA);
    const float2* ropeR = (const float2*)(p.ws + W_ROPER);
    f32x4 acc[2];
#pragma unroll
    for (int jj = 0; jj < 2; ++jj)
#pragma unroll
        for (int r = 0; r < 4; ++r) { const int d = 16 * w + 4 * g + r, e = sl * 32 + 16 * jj + lc; acc[jj][r] = init ? init[d * 128 + e] : 0.f; }
    const float zeta = expf((float)(63 - (tid >> 3)) * log_g) * kscale;
    uint4 ka0, kb0, vv0, ka1, kb1, vv1, ka2, kb2, vv2, ka3, kb3, vv3;
    float4 ca0[4], ca1[4], ca2[4], ca3[4];
    const int kj = tid >> 3, kdg = tid & 7, vj = (tid >> 2) & 63, veg = tid & 3;
#define RC_LOAD(c_, K1, K2, VV, CS) do { const bf16_t* s_ = proj + (size_t)(rowbase + (c_) * 64 + kj) * NRET + 768 + h * 128 + kdg * 8; K1 = *(const uint4*)s_; K2 = *(const uint4*)(s_ + 64); \
        { const float4* cs_ = (const float4*)(ropeR + (size_t)(posbase + (c_) * 64 + kj) * 64 + kdg * 8); CS[0] = cs_[0]; CS[1] = cs_[1]; CS[2] = cs_[2]; CS[3] = cs_[3]; } \
        VV = *(const uint4*)(proj + (size_t)(rowbase + (c_) * 64 + vj) * NRET + 1536 + h * 128 + sl * 32 + veg * 8); } while (0)
#define RC_STEP(c_, K1, K2, VV, CS) if ((c_) < nsteps) { const int c = (c_); \
        bf16_t* Kt = (bf16_t*)(lds + (c & 1) * 18432); \
        bf16_t* Vt = (bf16_t*)(lds + 36864 + (c & 1) * 4608); \
        { \
            float x1[8], x2[8]; unpack8(K1, x1); unpack8(K2, x2); \
            _Pragma("unroll") for (int e2 = 0; e2 < 4; ++e2) { \
                const float4 t = CS[e2]; \
                { const float a = x1[2 * e2], b = x2[2 * e2]; Kt[(kdg * 8 + 2 * e2) * 72 + kj] = f2bf((a * t.x - b * t.y) * zeta); Kt[(64 + kdg * 8 + 2 * e2) * 72 + kj] = f2bf((a * t.y + b * t.x) * zeta); } \
                { const float a = x1[2 * e2 + 1], b = x2[2 * e2 + 1]; Kt[(kdg * 8 + 2 * e2 + 1) * 72 + kj] = f2bf((a * t.z - b * t.w) * zeta); Kt[(64 + kdg * 8 + 2 * e2 + 1) * 72 + kj] = f2bf((a * t.w + b * t.z) * zeta); } \
            } \
        } \
        if (tid < 256) { const uint32_t u[4] = {VV.x, VV.y, VV.z, VV.w}; \
          _Pragma("unroll") for (int e2 = 0; e2 < 4; ++e2) { Vt[(veg * 8 + 2 * e2) * 72 + vj] = (bf16_t)(u[e2] & 0xffff); Vt[(veg * 8 + 2 * e2 + 1) * 72 + vj] = (bf16_t)(u[e2] >> 16); } } \
        if (c + 4 < nsteps) RC_LOAD(c + 4, K1, K2, VV, CS); \
        __syncthreads(); \
        bf16_t* rsc = rs + (size_t)c * 16384; \
        _Pragma("unroll") for (int jj = 0; jj < 2; ++jj) { \
            const int d = 16 * w + 4 * g, e = sl * 32 + 16 * jj + lc; \
            *(uint2*)(rsc + e * 128 + d) = make_uint2(pk2(acc[jj][0], acc[jj][1]), pk2(acc[jj][2], acc[jj][3])); \
            acc[jj] = acc[jj] * gch; \
        } \
        _Pragma("unroll") for (int s = 0; s < 2; ++s) { \
            const bf16x8 a = ld8(Kt + (16 * w + lc) * 72 + 32 * s + 8 * g); \
            _Pragma("unroll") for (int jj = 0; jj < 2; ++jj) acc[jj] = MFMA16(a, ld8(Vt + (16 * jj + lc) * 72 + 32 * s + 8 * g), acc[jj]); \
        } \
    }
    RC_LOAD(0, ka0, kb0, vv0, ca0);
    if (1 < nsteps) RC_LOAD(1, ka1, kb1, vv1, ca1);
    if (2 < nsteps) RC_LOAD(2, ka2, kb2, vv2, ca2);
    if (3 < nsteps) RC_LOAD(3, ka3, kb3, vv3, ca3);
    for (int c4 = 0; c4 < nsteps; c4 += 4) {
        RC_STEP(c4, ka0, kb0, vv0, ca0)
        RC_STEP(c4 + 1, ka1, kb1, vv1, ca1)
        RC_STEP(c4 + 2, ka2, kb2, vv2, ca2)
        RC_STEP(c4 + 3, ka3, kb3, vv3, ca3)
    }
#pragma unroll
    for (int jj = 0; jj < 2; ++jj)
#pragma unroll
        for (int r = 0; r < 4; ++r) { const int d = 16 * w + 4 * g + r, e = sl * 32 + 16 * jj + lc; fin[d * 128 + e] = acc[jj][r]; }
    __syncthreads();
#undef RC_LOAD
#undef RC_STEP
}
__device__ __forceinline__ void ret_out(const Params& p, int u2, char* lds_) {
    const int tid_ = TIDX(), half = tid_ >> 8, tid = tid_ & 255, lane = tid & 63, w = tid >> 6, g = lane >> 4, lc = lane & 15;
    const int u = 2 * u2 + half; char* lds = lds_ + half * 53248;
    int b, h, rowbase, pos0;
    if (u < 3072) { const int chain = u >> 6, c = u & 63; b = chain / 6; h = chain % 6; rowbase = b * 4096 + c * 64; pos0 = c * 64; }
    else { const int cs = u - 3072; b = cs / 6; h = cs % 6; rowbase = TP + b * 64; pos0 = 1024; }
    const float log_g = logf(1.f - exp2f(-5.f - (float)h));
    const float log2g = log_g * 1.44269504089f;
    const float kscale = 0.08838834764831845f;
    const bf16_t* proj = (const bf16_t*)(p.ws + W_RA);
    const float2* ropeR = (const float2*)(p.ws + W_ROPER);
    const bf16_t* rsu = (const bf16_t*)(p.out + O_DKP) + (size_t)u * 16384;
    bf16_t* H = (bf16_t*)(p.ws + W_H);
    bf16_t* Qs = (bf16_t*)lds; bf16_t* Ks = (bf16_t*)(lds + 17408); bf16_t* Vt = (bf16_t*)(lds + 34816);
#pragma unroll
    for (int q = 0; q < 2; ++q) {
        const int it = tid + 256 * q, j = it >> 3, dg = it & 7;
        const bf16_t* s = proj + (size_t)(rowbase + j) * NRET + h * 128 + dg * 8;
        const uint4 q1 = *(const uint4*)s, q2 = *(const uint4*)(s + 64), kk1 = *(const uint4*)(s + 768), kk2 = *(const uint4*)(s + 768 + 64);
        const float4* cs = (const float4*)(ropeR + (size_t)(pos0 + j) * 64 + dg * 8);
        float a1[8], a2[8], b1[8], b2[8]; unpack8(q1, a1); unpack8(q2, a2); unpack8(kk1, b1); unpack8(kk2, b2);
        float qo1[8], qo2[8], ko1[8], ko2[8];
#pragma unroll
        for (int e2 = 0; e2 < 4; ++e2) {
            const float4 t = cs[e2];
            qo1[2 * e2] = a1[2 * e2] * t.x - a2[2 * e2] * t.y; qo2[2 * e2] = a1[2 * e2] * t.y + a2[2 * e2] * t.x;
            qo1[2 * e2 + 1] = a1[2 * e2 + 1] * t.z - a2[2 * e2 + 1] * t.w; qo2[2 * e2 + 1] = a1[2 * e2 + 1] * t.w + a2[2 * e2 + 1] * t.z;
            ko1[2 * e2] = (b1[2 * e2] * t.x - b2[2 * e2] * t.y) * kscale; ko2[2 * e2] = (b1[2 * e2] * t.y + b2[2 * e2] * t.x) * kscale;
            ko1[2 * e2 + 1] = (b1[2 * e2 + 1] * t.z - b2[2 * e2 + 1] * t.w) * kscale; ko2[2 * e2 + 1] = (b1[2 * e2 + 1] * t.w + b2[2 * e2 + 1] * t.z) * kscale;
        }
        *(uint4*)(Qs + j * 136 + dg * 8) = make_uint4(pk2(qo1[0], qo1[1]), pk2(qo1[2], qo1[3]), pk2(qo1[4], qo1[5]), pk2(qo1[6], qo1[7]));
        *(uint4*)(Qs + j * 136 + 64 + dg * 8) = make_uint4(pk2(qo2[0], qo2[1]), pk2(qo2[2], qo2[3]), pk2(qo2[4], qo2[5]), pk2(qo2[6], qo2[7]));
        *(uint4*)(Ks + j * 136 + dg * 8) = make_uint4(pk2(ko1[0], ko1[1]), pk2(ko1[2], ko1[3]), pk2(ko1[4], ko1[5]), pk2(ko1[6], ko1[7]));
        *(uint4*)(Ks + j * 136 + 64 + dg * 8) = make_uint4(pk2(ko2[0], ko2[1]), pk2(ko2[2], ko2[3]), pk2(ko2[4], ko2[5]), pk2(ko2[6], ko2[7]));
    }
#pragma unroll
    for (int q = 0; q < 4; ++q) {
        const int it = tid + 256 * q, j = it >> 4, eg = it & 15;
        const uint4 v = *(const uint4*)(proj + (size_t)(rowbase + j) * NRET + 1536 + h * 128 + eg * 8);
        const uint32_t uu[4] = {v.x, v.y, v.z, v.w};
#pragma unroll
        for (int e2 = 0; e2 < 4; ++e2) { Vt[(eg * 8 + 2 * e2) * 72 + j] = (bf16_t)(uu[e2] & 0xffff); Vt[(eg * 8 + 2 * e2 + 1) * 72 + j] = (bf16_t)(uu[e2] >> 16); }
    }
    __syncthreads();
    bf16x8 qf[4];
#pragma unroll
    for (int s = 0; s < 4; ++s) qf[s] = ld8(Qs + (16 * w + lc) * 136 + 32 * s + 8 * g);
    f32x4 st[4];
#pragma unroll
    for (int t = 0; t < 4; ++t) {
        st[t] = (f32x4){0.f, 0.f, 0.f, 0.f};
#pragma unroll
        for (int s = 0; s < 4; ++s) st[t] = MFMA16(ld8(Ks + (16 * t + lc) * 136 + 32 * s + 8 * g), qf[s], st[t]);
    }
    const int ii = 16 * w + lc;
#pragma unroll
    for (int t = 0; t < 4; ++t)
#pragma unroll
        for (int r = 0; r < 4; ++r) { const int j = 16 * t + 4 * g + r; st[t][r] *= exp2f(fabsf((float)(ii - j)) * log2g); }
    f32x4 o[8], oc[8];
#pragma unroll
    for (int et = 0; et < 8; ++et) { o[et] = (f32x4){0.f, 0.f, 0.f, 0.f}; oc[et] = (f32x4){0.f, 0.f, 0.f, 0.f}; }
#pragma unroll
    for (int s = 0; s < 2; ++s) {
        const bf16x8 pb = pack8(st[2 * s], st[2 * s + 1]);
#pragma unroll
        for (int et = 0; et < 8; ++et) { const bf16_t* vr = Vt + (16 * et + lc) * 72 + 32 * s + 4 * g; o[et] = MFMA16(ld44(vr, vr + 16), pb, o[et]); }
    }
#pragma unroll
    for (int et = 0; et < 8; ++et)
#pragma unroll
        for (int s = 0; s < 4; ++s) oc[et] = MFMA16(ld8(rsu + (16 * et + lc) * 128 + 32 * s + 8 * g), qf[s], oc[et]);
    const float xi = exp2f((float)(ii + 1) * log2g);
    float sum = 0.f;
#pragma unroll
    for (int et = 0; et < 8; ++et)
#pragma unroll
        for (int r = 0; r < 4; ++r) { o[et][r] += xi * oc[et][r]; sum += o[et][r]; }
    const float mean = xr16_32_sum(sum) * (1.f / 128.f);
    float sq = 0.f;
#pragma unroll
    for (int et = 0; et < 8; ++et)
#pragma unroll
        for (int r = 0; r < 4; ++r) { const float dd = o[et][r] - mean; sq += dd * dd; }
    const float rstd = rsqrtf(xr16_32_sum(sq) * (1.f / 128.f) + 1e-5f);
    const size_t row = (size_t)rowbase + ii;
    const float* gn = p.in[9] + h * 128;
#pragma unroll
    for (int et = 0; et < 8; ++et) {
        const int e = 16 * et + 4 * g;
        const uint2 gt = *(const uint2*)(proj + row * NRET + 2304 + h * 128 + e);
        const float4 gg = *(const float4*)(gn + e);
        const float y0 = (o[et][0] - mean) * rstd * gg.x * silu(bflo(gt.x)), y1 = (o[et][1] - mean) * rstd * gg.y * silu(bfhi(gt.x));
        const float y2 = (o[et][2] - mean) * rstd * gg.z * silu(bflo(gt.y)), y3 = (o[et][3] - mean) * rstd * gg.w * silu(bfhi(gt.y));
        *(uint2*)(H + row * 1024 + h * 128 + e) = make_uint2(pk2(y0, y1), pk2(y2, y3));
    }
    __syncthreads();
}

__device__ __forceinline__ void glds16_asm(const void* gsrc, unsigned lds_dst) {
    unsigned keep;
    asm volatile("s_mov_b32 %0, m0\n\ts_mov_b32 m0, %2\n\ts_nop 0\n\tglobal_load_lds_dwordx4 %1, off\n\ts_mov_b32 m0, %0" : "=&s"(keep) : "v"(gsrc), "s"(lds_dst) : "memory");
}
__device__ __forceinline__ void mem_attn(const Params& p, int unit, int layer, char* lds) {
    const int tid = TIDX(), lane = tid & 63, w = tid >> 6, g = lane >> 4, lc = lane & 15;
    const bf16_t* Q; int ldq;
    if (layer == 0) { Q = (const bf16_t*)(p.ws + W_RA) + 3072; ldq = NRET; } else { Q = (const bf16_t*)(p.ws + W_QM) + 768; ldq = 1024; }
    int bb, h, r0, npass; bool all8;
    if (unit < 256) { const int b = unit >> 5; h = (unit >> 3) & 3; bb = b; r0 = b * 4096 + (unit & 7) * 512; npass = 4; all8 = true; }
    else { const int us = unit - 256, b = us >> 2; h = us & 3; bb = 8 + b; r0 = TP + b * 64; npass = 1; all8 = false; }
    const bf16_t* mk = (const bf16_t*)(p.ws + W_MK) + (size_t)(layer * 24 + bb) * 65536 + h * 64;
    const bf16_t* mv = (const bf16_t*)(p.ws + W_MVT) + (size_t)((layer * 24 + bb) * 4 + h) * 16384;
    bf16_t* H = (bf16_t*)(p.ws + W_H);
    const float sc = 0.125f * 1.44269504089f;
    asm volatile("s_waitcnt vmcnt(0) lgkmcnt(0)" ::: "memory");
    __syncthreads();
    {
        const unsigned lds_w = (unsigned)__builtin_amdgcn_readfirstlane((int)(unsigned)(size_t)(LAS char*)lds + (tid & ~63) * 16);
#pragma unroll
        for (int i = 0; i < 4; ++i) {
            const int kr = (tid >> 3) + 64 * i, kc = (tid & 7) ^ ((kr >> 1) & 7);
            glds16_asm(mk + (size_t)kr * 256 + kc * 8, lds_w + i * 8192);
            const int vr = (tid >> 5) + 16 * i, vc = (tid & 31) ^ (vr & 15);
            glds16_asm(mv + (size_t)vr * 256 + vc * 8, lds_w + 32768 + i * 8192);
        }
    }
    const bf16_t* Ks = (const bf16_t*)lds; const bf16_t* Vs = (const bf16_t*)(lds + 32768);
    const bool act = all8 || w < 4;
    const size_t rowb = (size_t)r0 + 16 * (all8 ? w : (w & 3)) + lc;
    bf16x8 qf[2];
#pragma unroll
    for (int s = 0; s < 2; ++s) qf[s] = ld8(Q + rowb * ldq + h * 64 + 32 * s + 8 * g);
#pragma unroll
    for (int s = 0; s < 2; ++s) asm volatile("" : "+v"(qf[s]));
    asm volatile("s_waitcnt vmcnt(0)" ::: "memory");
    __syncthreads();
    for (int it = 0; it < npass; ++it) {
        const size_t row = rowb + (size_t)it * 128;
        bf16x8 qn[2];
        if (it + 1 < npass) {
#pragma unroll
            for (int s = 0; s < 2; ++s) qn[s] = ld8(Q + (row + 128) * ldq + h * 64 + 32 * s + 8 * g);
        }
        if (act) {
            f32x4 st[16];
            float mx = -3.0e38f;
#pragma unroll
            for (int t = 0; t < 16; ++t) {
                st[t] = (f32x4){0.f, 0.f, 0.f, 0.f};
#pragma unroll
                for (int s = 0; s < 2; ++s) st[t] = MFMA16(ld8(Ks + (16 * t + lc) * 64 + ((4 * s + g) ^ ((lc >> 1) & 7)) * 8), qf[s], st[t]);
                mx = fmaxf(mx, fmaxf(fmaxf(st[t][0], st[t][1]), fmaxf(st[t][2], st[t][3])));
            }
            mx = xr16_32_max(mx) * sc;
            float sum = 0.f;
#pragma unroll
            for (int t = 0; t < 16; ++t)
#pragma unroll
                for (int r = 0; r < 4; ++r) { st[t][r] = __builtin_amdgcn_exp2f(st[t][r] * sc - mx); sum += st[t][r]; }
            const float inv = 1.f / xr16_32_sum(sum);
            f32x4 o[4];
#pragma unroll
            for (int dt = 0; dt < 4; ++dt) o[dt] = (f32x4){0.f, 0.f, 0.f, 0.f};
#pragma unroll
            for (int s = 0; s < 8; ++s) {
                const bf16x8 pb = pack8(st[2 * s] * inv, st[2 * s + 1] * inv);
#pragma unroll
                for (int dt = 0; dt < 4; ++dt) { const bf16_t* vr = Vs + (16 * dt + lc) * 256 + (g & 1) * 4; o[dt] = MFMA16(ld44(vr + ((4 * s + (g >> 1)) ^ lc) * 8, vr + ((4 * s + (g >> 1) + 2) ^ lc) * 8), pb, o[dt]); }
            }
#pragma unroll
            for (int dt = 0; dt < 4; ++dt) *(uint2*)(H + row * 1024 + 768 + h * 64 + 16 * dt + 4 * g) = make_uint2(pk2(o[dt][0], o[dt][1]), pk2(o[dt][2], o[dt][3]));
        }
        if (it + 1 < npass) { qf[0] = qn[0]; qf[1] = qn[1]; }
    }
    __syncthreads();
}

__device__ __forceinline__ void diff_attn(const Params& p, int rowq0, int h, const bf16_t* Kp, const bf16_t* Vp, int ldv, int nkt, int nkt_lo, bool hi_active, float lam, char* lds) {
    const int tid = TIDX(), lane = tid & 63, w = tid >> 6, g = lane >> 4, lc = lane & 15;
    const bf16_t* QM = (const bf16_t*)(p.ws + W_QM);
    bf16_t* H = (bf16_t*)(p.ws + W_H);
    const size_t row = (size_t)rowq0 + 16 * (hi_active ? w : (w & 3)) + lc;
    const int my_nkt = w < 4 ? nkt_lo : (hi_active ? nkt : 0);
    const float sc = 0.125f * 1.44269504089f;
    bf16x8 qf[2][2];
#pragma unroll
    for (int c = 0; c < 2; ++c)
#pragma unroll
        for (int s = 0; s < 2; ++s) qf[c][s] = ld8(QM + row * 1024 + h * 128 + c * 64 + 32 * s + 8 * g);
    f32x4 o[2][8];
    float m[2] = {0.f, 0.f};
    f32x4 osum[2] = {(f32x4){0.f, 0.f, 0.f, 0.f}, (f32x4){0.f, 0.f, 0.f, 0.f}};
    const bf16x8 onesA = mk8(0x3F803F80u, 0x3F803F80u, 0x3F803F80u, 0x3F803F80u);
#pragma unroll
    for (int c = 0; c < 2; ++c)
#pragma unroll
        for (int dt = 0; dt < 8; ++dt) o[c][dt] = (f32x4){0.f, 0.f, 0.f, 0.f};
    const int kkey = tid >> 4, kdc = tid & 15;
    const int vdim = tid >> 3, vkc = tid & 7;
    const bf16_t* kg0 = Kp + (size_t)kkey * 768 + (kdc ^ (kkey & 15)) * 8;
    const bf16_t* vg0 = Vp + (size_t)vdim * ldv + (vkc ^ (vdim & 7)) * 8;
    const unsigned lds_w = (unsigned)__builtin_amdgcn_readfirstlane((int)(unsigned)(size_t)(LAS char*)lds + (tid & ~63) * 16);
#define DA_ISSUE(vt_) do { const int st_ = (vt_) & 3; const int tt_ = (vt_) < nkt ? (vt_) : nkt - 1; \
        const bf16_t* kg_ = kg0 + (size_t)tt_ * (64 * 768); const bf16_t* vg_ = vg0 + tt_ * 64; const unsigned dst_ = lds_w + st_ * 32768; \
        glds16_asm(kg_, dst_); glds16_asm(kg_ + 32 * 768, dst_ + 8192); glds16_asm(vg_, dst_ + 16384); glds16_asm(vg_ + (size_t)64 * ldv, dst_ + 16384 + 8192); } while (0)
#pragma unroll
    for (int c = 0; c < 2; ++c)
#pragma unroll
        for (int s = 0; s < 2; ++s) asm volatile("" : "+v"(qf[c][s]));
    asm volatile("s_waitcnt vmcnt(0) lgkmcnt(0)" ::: "memory");
    __syncthreads();
    DA_ISSUE(0); DA_ISSUE(1); DA_ISSUE(2);
    asm volatile("s_waitcnt vmcnt(8)" ::: "memory");
    __builtin_amdgcn_s_barrier();
    for (int kt = 0; kt < nkt; ++kt) {
        DA_ISSUE(kt + 3);
        if (kt < my_nkt) {
            const bf16_t* Ks = (const bf16_t*)(lds + (kt & 3) * 32768); const bf16_t* Vt = (const bf16_t*)(lds + (kt & 3) * 32768 + 16384);
            f32x4 st[2][4];
#pragma unroll
            for (int c = 0; c < 2; ++c)
#pragma unroll
                for (int t = 0; t < 4; ++t) {
                    st[c][t] = (f32x4){0.f, 0.f, 0.f, 0.f};
#pragma unroll
                    for (int s = 0; s < 2; ++s) st[c][t] = MFMA16(ld8(Ks + (16 * t + lc) * 128 + ((c * 8 + 4 * s + g) ^ lc) * 8), qf[c][s], st[c][t]);
                }
#pragma unroll
            for (int c = 0; c < 2; ++c) {
                const float mneg = -m[c];
#pragma unroll
                for (int t = 0; t < 4; ++t)
#pragma unroll
                    for (int r = 0; r < 4; ++r) st[c][t][r] = __builtin_fmaf(st[c][t][r], sc, mneg);
                float mx = -3.0e38f;
#pragma unroll
                for (int t = 0; t < 4; ++t) mx = fmaxf(mx, fmaxf(fmaxf(st[c][t][0], st[c][t][1]), fmaxf(st[c][t][2], st[c][t][3])));
                mx = xr16_32_max(mx);
                const bool first = kt == 0;
                if (first || __builtin_amdgcn_ballot_w64(mx > 8.f) != 0ull) {
                    const float d = first ? mx : fmaxf(mx, 0.f);
                    m[c] += d;
                    if (!first) {
                        const float al = __builtin_amdgcn_exp2f(-d);
                        osum[c] = osum[c] * al;
#pragma unroll
                        for (int dt = 0; dt < 8; ++dt) o[c][dt] = o[c][dt] * al;
                    }
#pragma unroll
                    for (int t = 0; t < 4; ++t)
#pragma unroll
                        for (int r = 0; r < 4; ++r) st[c][t][r] -= d;
                }
#pragma unroll
                for (int t = 0; t < 4; ++t)
#pragma unroll
                    for (int r = 0; r < 4; ++r) st[c][t][r] = __builtin_amdgcn_exp2f(st[c][t][r]);
            }
#pragma unroll
            for (int s = 0; s < 2; ++s) {
                const bf16x8 pb0 = pack8(st[0][2 * s], st[0][2 * s + 1]), pb1 = pack8(st[1][2 * s], st[1][2 * s + 1]);
                osum[0] = MFMA16(onesA, pb0, osum[0]); osum[1] = MFMA16(onesA, pb1, osum[1]);
#pragma unroll
                for (int dt = 0; dt < 8; ++dt) {
                    const bf16x8 va = ld8(Vt + (16 * dt + lc) * 64 + ((4 * s + g) ^ (lc & 7)) * 8);
                    o[0][dt] = MFMA16(va, pb0, o[0][dt]); o[1][dt] = MFMA16(va, pb1, o[1][dt]);
                }
            }
        }
        asm volatile("s_waitcnt vmcnt(8) lgkmcnt(0)" ::: "memory");
        __builtin_amdgcn_s_barrier();
    }
    asm volatile("s_waitcnt vmcnt(0)" ::: "memory");
    if (my_nkt > 0) {
        const float i0 = 1.f / osum[0][0], i1 = lam / osum[1][0];
        float sq = 0.f;
#pragma unroll
        for (int dt = 0; dt < 8; ++dt)
#pragma unroll
            for (int r = 0; r < 4; ++r) { const float v = o[0][dt][r] * i0 - o[1][dt][r] * i1; o[0][dt][r] = v; sq += v * v; }
        const float rs = rsqrtf(xr16_32_sum(sq) * (1.f / 128.f) + 1e-5f) * (1.f - LAM_INIT);
        const float* sg = p.in[15];
#pragma unroll
        for (int dt = 0; dt < 8; ++dt) {
            const int e = 16 * dt + 4 * g;
            const float4 gg = *(const float4*)(sg + e);
            *(uint2*)(H + row * 1024 + h * 128 + e) = make_uint2(pk2(o[0][dt][0] * rs * gg.x, o[0][dt][1] * rs * gg.y), pk2(o[0][dt][2] * rs * gg.z, o[0][dt][3] * rs * gg.w));
        }
    }
#undef DA_ISSUE
}

__device__ __forceinline__ void phase_ln(const Params& p, const float* gam, const float* bet, const bf16_t* Zb, bf16_t* Xd, bool fin) {
    const int lane = TIDX() & 63, w = TIDX() >> 6;
    float4 gg[4], bb[4];
#pragma unroll
    for (int i = 0; i < 4; ++i) { gg[i] = ((const float4*)gam)[lane + 64 * i]; bb[i] = ((const float4*)bet)[lane + 64 * i]; }
    for (int row = BIDX() * 8 + w; row < TT; row += gridDim.x * 8) {
        const uint2* z = (const uint2*)(Zb + (size_t)row * 1024);
        float4 v[4]; float s = 0.f;
#pragma unroll
        for (int i = 0; i < 4; ++i) { const uint2 u = z[lane + 64 * i]; v[i] = make_float4(bflo(u.x), bfhi(u.x), bflo(u.y), bfhi(u.y)); s += (v[i].x + v[i].y) + (v[i].z + v[i].w); }
        const float mean = wave_sum(s) * (1.f / 1024.f);
        float q = 0.f;
#pragma unroll
        for (int i = 0; i < 4; ++i) { v[i].x -= mean; v[i].y -= mean; v[i].z -= mean; v[i].w -= mean; q += (v[i].x * v[i].x + v[i].y * v[i].y) + (v[i].z * v[i].z + v[i].w * v[i].w); }
        const float rstd = rsqrtf(wave_sum(q) * (1.f / 1024.f) + 1e-5f);
        uint2* xd = (uint2*)(Xd + (size_t)row * 1024);
        float4* yo = (float4*)(p.out + (size_t)row * 1024);
#pragma unroll
        for (int i = 0; i < 4; ++i) {
            float4 y; y.x = v[i].x * rstd * gg[i].x + bb[i].x; y.y = v[i].y * rstd * gg[i].y + bb[i].y; y.z = v[i].z * rstd * gg[i].z + bb[i].z; y.w = v[i].w * rstd * gg[i].w + bb[i].w;
            if (fin) yo[lane + 64 * i] = y; else xd[lane + 64 * i] = make_uint2(pk2(y.x, y.y), pk2(y.z, y.w));
        }
    }
}

__device__ __forceinline__ int next_unit(int* ctr, char* lds) {
    int* slot = (int*)(lds + LDS_MAIN);
    if (TIDX() == 0) *slot = atomicAdd(ctr, 1);
    __syncthreads();
    const int u = *slot;
    __syncthreads();
    return u;
}


#define XB_TMO      128
#define XB_XCNT(j)  (256  + 64 * (j))
#define XB_XSUB(j)  (1280 + 64 * (j))
#define XB_XGEN(j)  (2304 + 64 * (j))
#define XB_TOP      3328
#define XB_TOPGEN   3392
#define XCD_BAR_WORDS 3456
#define XB_SPIN_CAP (1u << 18)
__device__ __forceinline__ unsigned xb_ld(unsigned* p)              { return __hip_atomic_load(p, __ATOMIC_RELAXED, __HIP_MEMORY_SCOPE_AGENT); }
__device__ __forceinline__ unsigned xb_add(unsigned* p, unsigned v) { return __hip_atomic_fetch_add(p, v, __ATOMIC_RELAXED, __HIP_MEMORY_SCOPE_AGENT); }
__device__ __forceinline__ unsigned xb_xcc_id() { return (unsigned)__builtin_amdgcn_s_getreg((3 << 11) | 20) & 0xFu; }
#define XB_SPIN(cond, bar) do { unsigned _sp = 0; while (cond) { __builtin_amdgcn_s_sleep(1); \
    if ((++_sp & 255u) == 0u) { if (xb_ld(&(bar)[XB_TMO])) break; if (_sp > XB_SPIN_CAP) { atomicAdd(&(bar)[XB_TMO], 1u); break; } } } } while (0)
struct XcdBarrier { unsigned* bar; unsigned x; volatile LAS unsigned* st; };
__device__ __forceinline__ XcdBarrier xcd_barrier_post(unsigned* bar, volatile LAS unsigned* st) {
    XcdBarrier b; b.bar = bar; b.x = xb_xcc_id(); b.st = st;
    if (TIDX() == 0) (void)xb_add(&bar[XB_XCNT(b.x)], 1u);
    return b;
}
__device__ __forceinline__ void xcd_barrier_complete(unsigned* bar, unsigned x, unsigned& nloc, unsigned& nx) {
    const unsigned G = gridDim.x * gridDim.y * gridDim.z;
    unsigned sum, cnt, mine, sp = 0u;
    for (;;) {
        sum = 0u; cnt = 0u; mine = 0u;
#pragma unroll
        for (unsigned j = 0; j < 16; ++j) { const unsigned c = xb_ld(&bar[XB_XCNT(j)]); sum += c; cnt += (c > 0u) ? 1u : 0u; mine = (j == x) ? c : mine; }
        if (sum == G) break;
        __builtin_amdgcn_s_sleep(1);
        if ((++sp & 255u) == 0u) { if (xb_ld(&bar[XB_TMO])) break; if (sp > XB_SPIN_CAP) { atomicAdd(&bar[XB_TMO], 1u); break; } }
    }
    nloc = mine > 0u ? mine : 1u; nx = cnt > 0u ? cnt : 1u;
}
__device__ __forceinline__ void xcd_barrier(const XcdBarrier& b) {
    asm volatile("s_waitcnt vmcnt(0)" ::: "memory");
    __syncthreads();
    if (TIDX() == 0) {
        unsigned* bar = b.bar;
        __builtin_amdgcn_s_waitcnt(0);
        unsigned nloc = b.st[0], nx = b.st[1];
        if (nloc == 0u) { xcd_barrier_complete(bar, b.x, nloc, nx); b.st[0] = nloc; b.st[1] = nx; }
        const unsigned old = xb_add(&bar[XB_XSUB(b.x)], 1u);
        const unsigned gen = old / nloc;
        if (old + 1u == (gen + 1u) * nloc) {
            __builtin_amdgcn_fence(__ATOMIC_RELEASE, "agent");
            asm volatile("s_waitcnt vmcnt(0)" ::: "memory");
            const unsigned og = xb_add(&bar[XB_TOP], 1u);
            const unsigned tg = og / nx;
            if (og + 1u == (tg + 1u) * nx) xb_add(&bar[XB_TOPGEN], 1u);
            else XB_SPIN(xb_ld(&bar[XB_TOPGEN]) == tg, bar);
            __builtin_amdgcn_fence(__ATOMIC_ACQUIRE, "agent");
            xb_add(&bar[XB_XGEN(b.x)], 1u);
            asm volatile("s_waitcnt vmcnt(0)" ::: "memory");
        } else {
            XB_SPIN(xb_ld(&bar[XB_XGEN(b.x)]) == gen, bar);
            __builtin_amdgcn_fence(__ATOMIC_ACQUIRE, "agent");
            asm volatile("s_waitcnt vmcnt(0)" ::: "memory");
        }
    }
    __syncthreads();
}

__device__ __forceinline__ void run_phase(const Params& p_, const int ph, const int l, char* lds, const int cslot = 0) {
    Params p = p_;
    asm volatile("" : "+s"(p.ws), "+s"(p.out));
    char* ws = p.ws;
    bf16_t* XB = (bf16_t*)(ws + W_XB); bf16_t* Hb = (bf16_t*)(ws + W_H); bf16_t* RA = (bf16_t*)(ws + W_RA);
    int* ctr = (int*)(ws + W_CTRL);
    switch (ph) {
    case 0: phase_prep(p, lds); break;
    case 1: {
        gemm_phase(XB, (const bf16_t*)(ws + W_WRET), 1024, TT / 256, NRET / 256, lds, EpiBf16{RA, NRET});
        for (int ll = 0; ll < 2; ++ll)
            gemm_phase((const bf16_t*)(ws + W_MB), (const bf16_t*)(ws + W_WMKV) + (size_t)ll * 512 * 1024, 1024, 8, 2, lds,
                       EpiMemKV{p.out + O_MKP + (size_t)ll * 524288, p.out + O_MVP + (size_t)ll * 524288, (bf16_t*)(ws + W_MK) + (size_t)ll * 24 * 65536, (bf16_t*)(ws + W_MVT) + (size_t)ll * 24 * 65536},
                       (1716 % 256 + 16 * ll) % (int)gridDim.x);
    } break;
    case 2: {
        bf16_t* RS = (bf16_t*)(p.out + O_DKP);
        for (;;) {
            const int u = next_unit(ctr + 0 + cslot, lds);
            if (u >= 192 + 384 + 320) break;
            if (u < 576) {
                const bool pr = u < 192; const int us = pr ? u : u - 192, chain = us >> 2, sl = us & 3, b = chain / 6, h = chain % 6;
                ret_chain(p, h, sl, pr ? 64 : 1, pr ? b * 4096 : TP + b * 64, pr ? 0 : 1024, pr ? nullptr : p.in[3] + (size_t)chain * 16384,
                          RS + (pr ? (size_t)chain * 64 : (size_t)(3072 + chain)) * 16384, p.out + (pr ? O_RSP : O_RSS) + (size_t)chain * 16384, lds);
            }
            else mem_attn(p, u - 576, 0, lds);
        }
    } break;
    case 3: for (int u2 = BIDX(); u2 < 1584; u2 += gridDim.x) ret_out(p, u2, lds); break;
    case 4: gemm_phase(Hb, (const bf16_t*)(ws + W_WO) + (size_t)l * 1024 * 1024, 1024, TT / 256, 4, lds, EpiResid{XB, RA}); break;
    case 5: phase_ln(p, p.in[18] + l * 1024, p.in[19] + l * 1024, RA, Hb, false); break;
    case 6: gemm_phase(Hb, (const bf16_t*)(ws + W_WGU) + (size_t)l * 5632 * 1024, 1024, TT / 256, 22, lds, EpiGU{RA}); break;
    case 7: gemm_phase(RA, (const bf16_t*)(ws + W_WD) + (size_t)l * 1024 * DFF, DFF, TT / 256, 4, lds, EpiResid{Hb, XB}); break;
    case 8: phase_ln(p, p.in[23] + l * 1024, p.in[24] + l * 1024, XB, XB, l == 1); break;
    case 9: {
        { uint2* dst = (uint2*)(ws + W_KBS); const float4* s = (const float4*)p.in[4];
          const int skip = (int)gridDim.x > 80 ? 40 : 0, cb = BIDX() - skip, ncb = (int)gridDim.x - skip;
          const size_t per = 1024ull * 192, gt = (size_t)cb * NTHR + TIDX(), gs = (size_t)ncb * NTHR;
          if (cb >= 0) for (size_t i = gt; i < 16 * per; i += gs) { const size_t b = i / per, rem = i - b * per; const float4 v = s[i]; dst[b * (1088ull * 192) + rem] = make_uint2(pk2(v.x, v.y), pk2(v.z, v.w)); } }
        { const int tid = TIDX(), half = tid >> 8;
          const int skip = (int)gridDim.x > 80 ? 40 : 0, cb = BIDX() - skip, ncb = (int)gridDim.x - skip;
          if (cb >= 0 && cb < 1536) {
              float* tile = (float*)lds + half * 4224; const int tl = tid & 255;
              TrDesc dc = tr_desc9(p, 2 * cb + half); float4 r[4]; tr_load(dc, r, tl);
              for (int it2 = cb; it2 < 1536; it2 += ncb) {
                  const bool has = it2 + ncb < 1536;
                  TrDesc dn = dc; float4 rn[4];
                  if (has) { dn = tr_desc9(p, 2 * (it2 + ncb) + half); tr_load(dn, rn, tl); }
                  tr_finish(dc, r, tile, tl);
                  if (has) { dc = dn;
#pragma unroll
                      for (int i = 0; i < 4; ++i) r[i] = rn[i]; }
              }
          } }
        gemm_phase(XB, (const bf16_t*)(ws + W_WDIFF), 1024, TT / 256, NDIFF / 256, lds,
                   EpiProj1{(bf16_t*)(ws + W_QM), (bf16_t*)(ws + W_KBP), (bf16_t*)(ws + W_KBS), (bf16_t*)(ws + W_VTP), (bf16_t*)(ws + W_VTS), p.out, (const float2*)(ws + W_ROPED)});
    } break;
    case 10: {
        float lam;
        { const int lane = TIDX() & 63; const float a = wave_sum(p.in[11][lane] * p.in[12][lane]), b = wave_sum(p.in[13][lane] * p.in[14][lane]); lam = expf(a) - expf(b) + LAM_INIT; }
        for (;;) {
            const int u = next_unit(ctr + 1 + cslot, lds);
            if (u >= 1536 + 96 + 320) break;
            if (u < 1632) {
                const bool pr = u >= 96; const int up = u - 96, qp = 31 - up / 48, bh = pr ? up % 48 : u, b = bh / 6, h = bh % 6;
                diff_attn(p, pr ? b * 4096 + qp * 128 : TP + b * 64, h,
                          pr ? (const bf16_t*)(ws + W_KBP) + (size_t)b * 4096 * 768 + h * 128 : (const bf16_t*)(ws + W_KBS) + (size_t)b * 1088 * 768 + h * 128,
                          pr ? (const bf16_t*)(ws + W_VTP) + (size_t)bh * 128 * 4096 : (const bf16_t*)(ws + W_VTS) + (size_t)bh * 128 * 1088,
                          pr ? 4096 : 1088, pr ? 2 * qp + 2 : 17, pr ? 2 * qp + 1 : 17, pr, lam, lds);
            }
            else mem_attn(p, u - 1632, 1, lds);
        }
    } break;
    default: break;
    }
}

#ifndef PROBE_PH
#define PROBE_PH -1
#endif
extern "C" __global__ void __launch_bounds__(512, 2) mega_fwd(Params p) {
    extern __shared__ __attribute__((aligned(16))) char lds[];
    cg::grid_group grid = cg::this_grid();
    volatile LAS unsigned* xst = (volatile LAS unsigned*)(lds + LDS_MAIN + 16);
    if (TIDX() == 0) { xst[0] = 0u; xst[1] = 0u; }
    __syncthreads();
    (void)xcd_barrier_post((unsigned*)(p.ws + W_CTRL), xst);
#define XBAR() do { XcdBarrier xb_; xb_.bar = (unsigned*)(p.ws + W_CTRL); xb_.x = xb_xcc_id(); xb_.st = (volatile LAS unsigned*)(lds + LDS_MAIN + 16); xcd_barrier(xb_); } while (0)
    run_phase(p, 0, 0, lds);
    if (p.ph_lo != 0) grid.sync();
    XBAR();
#if PROBE_PH == 0
    run_phase(p, 0, 0, lds); XBAR();
#endif
    run_phase(p, 1, 0, lds); XBAR();
    run_phase(p, 2, 0, lds); XBAR();
#if PROBE_PH == 2
    run_phase(p, 2, 0, lds, 2); XBAR();
#endif
    run_phase(p, 3, 0, lds); XBAR();
#if PROBE_PH == 3
    run_phase(p, 3, 0, lds); XBAR();
#endif
    run_phase(p, 4, 0, lds); XBAR();
    run_phase(p, 5, 0, lds); XBAR();
    run_phase(p, 6, 0, lds); XBAR();
    run_phase(p, 7, 0, lds); XBAR();
    run_phase(p, 8, 0, lds); XBAR();
    run_phase(p, 9, 1, lds); XBAR();
    run_phase(p, 10, 1, lds); XBAR();
    run_phase(p, 4, 1, lds); XBAR();
    run_phase(p, 5, 1, lds); XBAR();
    run_phase(p, 6, 1, lds); XBAR();
    run_phase(p, 7, 1, lds); XBAR();
    run_phase(p, 8, 1, lds);
}

#ifndef PROBE_PH
#define PROBE_PH -1
#endif
#ifndef MULTI_LAUNCH
#define MULTI_LAUNCH 0
#endif
#if MULTI_LAUNCH
extern "C" __global__ void __launch_bounds__(512, 2) phase_kernel(Params p) {
    extern __shared__ __attribute__((aligned(16))) char lds[];
    switch (p.ph_lo) {
    case 0: run_phase(p, 0, 0, lds); break;
    case 1: run_phase(p, 1, 0, lds); break;
    case 2: run_phase(p, 2, 0, lds); break;
    case 3: run_phase(p, 3, 0, lds); break;
    case 4: run_phase(p, 4, p.ph_hi, lds); break;
    case 5: run_phase(p, 5, p.ph_hi, lds); break;
    case 6: run_phase(p, 6, p.ph_hi, lds); break;
    case 7: run_phase(p, 7, p.ph_hi, lds); break;
    case 8: run_phase(p, 8, p.ph_hi, lds); break;
    case 9: run_phase(p, 9, 1, lds); break;
    case 10: run_phase(p, 10, 1, lds); break;
    default: break;
    }
}
#endif

extern "C" void kernel_launch(void* const* d_in, const int* in_sizes, int n_in, void* d_out, int out_size, void* d_ws, size_t ws_size, hipStream_t stream) {
    static int grid = 0;
#if MULTI_LAUNCH
    const void* kfn = (const void*)phase_kernel;
#else
    const void* kfn = (const void*)mega_fwd;
#endif
    if (grid == 0) {
        int dev = 0, cus = 0, per_cu = 0;
        (void)hipGetDevice(&dev);
        (void)hipDeviceGetAttribute(&cus, hipDeviceAttributeMultiprocessorCount, dev);
        (void)hipFuncSetAttribute(kfn, hipFuncAttributeMaxDynamicSharedMemorySize, LDS_BYTES);
        (void)hipOccupancyMaxActiveBlocksPerMultiprocessor(&per_cu, kfn, NTHR, LDS_BYTES);
        if (per_cu < 1) { fprintf(stderr, "kernel_launch: occupancy query reports %d blocks per CU\n", per_cu); per_cu = 1; }
        grid = cus;
        if (ws_size < W_END) { fprintf(stderr, "kernel_launch: workspace too small: %zu < %zu\n", ws_size, (size_t)W_END); grid = -1; }
    }
    if (grid < 0) return;
    (void)hipMemsetAsync((char*)d_ws + W_CTRL, 0, 16384, stream);
    Params p{};
    for (int i = 0; i < 25; ++i) p.in[i] = (const float*)d_in[i];
    p.out = (float*)d_out; p.ws = (char*)d_ws; p.ph_lo = 0; p.ph_hi = 16;
#if MULTI_LAUNCH
    static const int seq[16][2] = {{0,0},{1,0},{2,0},{3,0},{4,0},{5,0},{6,0},{7,0},{8,0},{9,1},{10,1},{4,1},{5,1},{6,1},{7,1},{8,1}};
    for (int i = 0; i < 16; ++i) {
        p.ph_lo = seq[i][0]; p.ph_hi = seq[i][1];
        hipLaunchKernelGGL(phase_kernel, dim3(grid), dim3(NTHR), LDS_BYTES, stream, p);
    }
#else
    void* args[] = {&p};
    hipError_t e = hipLaunchCooperativeKernel(kfn, dim3(grid), dim3(NTHR), args, LDS_BYTES, stream);
    if (e != hipSuccess) fprintf(stderr, "cooperative launch failed: %s (grid %d)\n", hipGetErrorString(e), grid);
#endif
}
```

```cpp
#include <hip/hip_runtime.h>
#include <hip/hip_cooperative_groups.h>
#include <stdint.h>
#include <stdio.h>
namespace cg = cooperative_groups;

typedef unsigned short bf16_t;
typedef short bf16x8 __attribute__((ext_vector_type(8)));
typedef float f32x4 __attribute__((ext_vector_type(4)));
typedef float f32x16 __attribute__((ext_vector_type(16)));
#define LAS __attribute__((address_space(3)))

#define MFMA32(a, b, c) __builtin_amdgcn_mfma_f32_32x32x16_bf16(a, b, c, 0, 0, 0)
#define MFMA16(a, b, c) __builtin_amdgcn_mfma_f32_16x16x32_bf16(a, b, c, 0, 0, 0)

constexpr int TP = 32768, TS = 1024, TT = TP + TS;
constexpr int NRET = 3328, NDIFF = 2560, DFF = 2816;
constexpr float ALPHA = 1.41421356237f;
constexpr float LAM_INIT = 0.35550907f;
constexpr int NTHR = 512;
constexpr int LDS_MAIN = 131072, LDS_BYTES = LDS_MAIN + 256;

constexpr size_t O_YP = 0, O_RSP = 34603008, O_RSS = 35389440, O_DKP = 36962304, O_DVP = 62128128,
                 O_DKS = 87293952, O_DVS = 88080384, O_MKP = 88866816, O_MVP = 89915392;
constexpr size_t W_CTRL = 0;
constexpr size_t W_ROPER = 16384;
constexpr size_t W_ROPED = W_ROPER + 4096ull * 64 * 8;
constexpr size_t W_WRET = W_ROPED + 4096ull * 8 * 8;
constexpr size_t W_WDIFF = W_WRET + (size_t)NRET * 1024 * 2;
constexpr size_t W_WMKV = W_WDIFF + (size_t)NDIFF * 1024 * 2;
constexpr size_t W_WO = W_WMKV + 2ull * 512 * 1024 * 2;
constexpr size_t W_WGU = W_WO + 2ull * 1024 * 1024 * 2;
constexpr size_t W_WD = W_WGU + 2ull * 5632 * 1024 * 2;
constexpr size_t W_MB = W_WD + 2ull * 1024 * 2816 * 2;
constexpr size_t W_MK = W_MB + 2048ull * 1024 * 2;
constexpr size_t W_MVT = W_MK + 2ull * 24 * 65536 * 2;
constexpr size_t W_XB = W_MVT + 2ull * 24 * 65536 * 2;
constexpr size_t W_H = W_XB + (size_t)TT * 1024 * 2;
constexpr size_t W_RA = W_H + (size_t)TT * 1024 * 2;
constexpr size_t W_END = W_RA + (size_t)TT * NRET * 2;
constexpr size_t W_QM = W_RA;
constexpr size_t W_KBP = W_QM + (size_t)TT * 1024 * 2;
constexpr size_t W_KBS = W_KBP + 8ull * 4096 * 768 * 2;
constexpr size_t W_VTP = W_KBS + 16ull * 1088 * 768 * 2;
constexpr size_t W_VTS = W_VTP + 8ull * 6 * 128 * 4096 * 2;
static_assert(W_VTS + 16ull * 6 * 128 * 1088 * 2 <= W_END, "layer-1 overlay too big");

struct Params {
    const float* in[25];
    float* out;
    char* ws;
    int ph_lo, ph_hi;
};

__device__ __forceinline__ int TIDX() { int t = threadIdx.x; asm volatile("" : "+v"(t)); return t; }
__device__ __forceinline__ int BIDX() { int t = blockIdx.x; asm volatile("" : "+s"(t)); return t; }
typedef __bf16 bf2_t __attribute__((ext_vector_type(2)));
typedef float f2_t __attribute__((ext_vector_type(2)));
__device__ __forceinline__ uint32_t pk2(float lo, float hi) { f2_t f = {lo, hi}; bf2_t b = __builtin_convertvector(f, bf2_t); return *(uint32_t*)&b; }
__device__ __forceinline__ bf16_t f2bf(float f) { return (bf16_t)(pk2(f, 0.f) & 0xffffu); }
__device__ __forceinline__ float bf2f(bf16_t b) { return __uint_as_float(((uint32_t)b) << 16); }
__device__ __forceinline__ float bflo(uint32_t u) { return __uint_as_float(u << 16); }
__device__ __forceinline__ float bfhi(uint32_t u) { return __uint_as_float(u & 0xffff0000u); }
__device__ __forceinline__ bf16x8 mk8(uint32_t a, uint32_t b, uint32_t c, uint32_t d) { uint4 u = make_uint4(a, b, c, d); return *(bf16x8*)&u; }
__device__ __forceinline__ bf16x8 pack8(f32x4 a, f32x4 b) { return mk8(pk2(a[0], a[1]), pk2(a[2], a[3]), pk2(b[0], b[1]), pk2(b[2], b[3])); }
__device__ __forceinline__ bf16x8 ld8(const bf16_t* p) { return *(const bf16x8*)p; }
__device__ __forceinline__ bf16x8 ld44(const bf16_t* lo, const bf16_t* hi) { uint2 a = *(const uint2*)lo, b = *(const uint2*)hi; return mk8(a.x, a.y, b.x, b.y); }
__device__ __forceinline__ float xr16_32_max(float v) { v = fmaxf(v, __shfl_xor(v, 16)); v = fmaxf(v, __shfl_xor(v, 32)); return v; }
__device__ __forceinline__ float xr16_32_sum(float v) { v += __shfl_xor(v, 16); v += __shfl_xor(v, 32); return v; }
__device__ __forceinline__ float wave_sum(float v) { for (int o = 1; o < 64; o <<= 1) v += __shfl_xor(v, o); return v; }
__device__ __forceinline__ void unpack8(uint4 u, float* f) { f[0] = bflo(u.x); f[1] = bfhi(u.x); f[2] = bflo(u.y); f[3] = bfhi(u.y); f[4] = bflo(u.z); f[5] = bfhi(u.z); f[6] = bflo(u.w); f[7] = bfhi(u.w); }
__device__ __forceinline__ float silu(float x) { return x / (1.f + __expf(-x)); }

constexpr int G_BK = 64, G_HT = 128 * 64;
__device__ __forceinline__ int lds_byte(int r, int c) { const int st = (r >> 4) * 2 + (c >> 5), rr = r & 15, cc = c & 31, ob = rr * 64 + cc * 2; return st * 1024 + (ob ^ (((ob >> 9) & 1) << 5)); }
__device__ __forceinline__ void stage_rc(int b, int& R, int& C) { const int st = b / 1024, sb = b % 1024, swz = sb ^ (((sb >> 9) & 1) << 5); R = (st >> 1) * 16 + swz / 64; C = (st & 1) * 32 + (swz % 64) / 2; }

template <class Epi>
__device__ __forceinline__ void gemm256_tile(const bf16_t* __restrict__ A, const bf16_t* __restrict__ Bt, const int K, const int brow, const int bcol, const bool pre, const int nrow, const int ncol, char* lds, const Epi& epi) {
    bf16_t* shm = (bf16_t*)lds;
#define SA(b, h) (shm + ((b) * 2 + (h)) * G_HT)
#define SB(b, h) (shm + (4 + (b) * 2 + (h)) * G_HT)
#define STAGE(P, BASE, br, kt) do { const long _g = (long)(br) * K + (long)(kt) * G_BK; \
    _Pragma("unroll") for (int _i = 0; _i < 2; ++_i) { const int _b = tid * 16 + _i * 8192; int _r, _c; stage_rc(_b, _r, _c); \
      __builtin_amdgcn_global_load_lds((const unsigned*)(BASE + _g + (long)_r * K + _c), (__attribute__((address_space(3))) unsigned*)((char*)(P) + _b), 16, 0, 0); } } while (0)
#define LDA(dst, b, h) _Pragma("unroll") for (int m = 0; m < 4; ++m) _Pragma("unroll") for (int k = 0; k < 2; ++k) \
    dst[m][k] = *reinterpret_cast<const bf16x8*>((char*)SA(b, h) + lds_byte(wr * 64 + m * 16 + fr, k * 32 + fq * 8))
#define LDB(dst, b, h) _Pragma("unroll") for (int n = 0; n < 2; ++n) _Pragma("unroll") for (int k = 0; k < 2; ++k) \
    dst[n][k] = *reinterpret_cast<const bf16x8*>((char*)SB(b, h) + lds_byte(wc * 32 + n * 16 + fr, k * 32 + fq * 8))
#define MMA(ai, bj, At_, Bt_) do { __builtin_amdgcn_s_setprio(1); \
    _Pragma("unroll") for (int m = 0; m < 4; ++m) _Pragma("unroll") for (int n = 0; n < 2; ++n) _Pragma("unroll") for (int k = 0; k < 2; ++k) \
      acc[ai][bj][m][n] = MFMA16(Bt_[n][k], At_[m][k], acc[ai][bj][m][n]); \
    __builtin_amdgcn_s_setprio(0); } while (0)
#define WAIT_V(n) asm volatile("s_waitcnt vmcnt(" #n ")" ::: "memory")
#define WAIT_L(n) asm volatile("s_waitcnt lgkmcnt(" #n ")" ::: "memory")
#define BAR __builtin_amdgcn_s_barrier()
#define SCHED __builtin_amdgcn_sched_barrier(0)
    const int tid = TIDX();
    const int wid = tid >> 6, lane = tid & 63, wr = wid >> 2, wc = wid & 3, fr = lane & 15, fq = lane >> 4;
    constexpr int HALF = 128;
    f32x4 acc[2][2][4][2];
#pragma unroll
    for (int a = 0; a < 2; ++a)
#pragma unroll
        for (int b = 0; b < 2; ++b)
#pragma unroll
            for (int m = 0; m < 4; ++m)
#pragma unroll
                for (int n = 0; n < 2; ++n) acc[a][b][m][n] = (f32x4){0.f, 0.f, 0.f, 0.f};
    bf16x8 At[4][2], B0[2][2], B1[2][2];
    const int nt = K / G_BK;
    asm volatile("s_waitcnt vmcnt(0) lgkmcnt(0)" ::: "memory");
    __syncthreads();
    if (!pre) {
        STAGE(SB(0, 0), Bt, bcol, 0); STAGE(SA(0, 0), A, brow, 0);
        STAGE(SB(0, 1), Bt, bcol + HALF, 0); STAGE(SA(0, 1), A, brow + HALF, 0);
    }
    if (wr == 1) BAR;
    WAIT_V(4); BAR;
    STAGE(SB(1, 0), Bt, bcol, 1); STAGE(SA(1, 0), A, brow, 1); STAGE(SB(1, 1), Bt, bcol + HALF, 1);
    WAIT_V(6); BAR;
    for (int t = 0; t < nt - 2; t += 2) {
        LDB(B0, 0, 0); SCHED; LDA(At, 0, 0); STAGE(SA(1, 1), A, brow + HALF, t + 1);
        WAIT_L(8); BAR; WAIT_L(0); MMA(0, 0, At, B0); BAR; SCHED;
        LDB(B1, 0, 1); STAGE(SB(0, 0), Bt, bcol, t + 2);
        BAR; WAIT_L(0); MMA(0, 1, At, B1); BAR;
        LDA(At, 0, 1); STAGE(SA(0, 0), A, brow, t + 2);
        BAR; WAIT_L(0); MMA(1, 0, At, B0); BAR; SCHED;
        STAGE(SB(0, 1), Bt, bcol + HALF, t + 2);
        WAIT_V(6); BAR; MMA(1, 1, At, B1); BAR;
        LDB(B0, 1, 0); SCHED; LDA(At, 1, 0); STAGE(SA(0, 1), A, brow + HALF, t + 2);
        WAIT_L(8); BAR; WAIT_L(0); MMA(0, 0, At, B0); BAR; SCHED;
        LDB(B1, 1, 1); STAGE(SB(1, 0), Bt, bcol, t + 3);
        BAR; WAIT_L(0); MMA(0, 1, At, B1); BAR;
        LDA(At, 1, 1); STAGE(SA(1, 0), A, brow, t + 3);
        BAR; WAIT_L(0); MMA(1, 0, At, B0); BAR; SCHED;
        STAGE(SB(1, 1), Bt, bcol + HALF, t + 3);
        WAIT_V(6); BAR; MMA(1, 1, At, B1); BAR;
    }
    { LDB(B0, 0, 0); LDA(At, 0, 0); STAGE(SA(1, 1), A, brow + HALF, nt - 1);
      BAR; WAIT_L(0); MMA(0, 0, At, B0); BAR;
      LDB(B1, 0, 1); BAR; WAIT_L(0); MMA(0, 1, At, B1); BAR;
      LDA(At, 0, 1); WAIT_V(4); BAR; WAIT_L(0); MMA(1, 0, At, B0); MMA(1, 1, At, B1); BAR; }
    { LDB(B0, 1, 0); LDA(At, 1, 0); WAIT_V(2); BAR; WAIT_L(0); MMA(0, 0, At, B0); BAR;
      LDB(B1, 1, 1); WAIT_V(0); BAR; WAIT_L(0); MMA(0, 1, At, B1); BAR;
      LDA(At, 1, 1); BAR; WAIT_L(0); MMA(1, 0, At, B0); MMA(1, 1, At, B1); BAR; }
    if (wr == 0) BAR;
    if (nrow >= 0) {
        STAGE(SB(0, 0), Bt, ncol, 0); STAGE(SA(0, 0), A, nrow, 0);
        STAGE(SB(0, 1), Bt, ncol + HALF, 0); STAGE(SA(0, 1), A, nrow + HALF, 0);
    }
    epi(acc, brow, bcol, wr, wc, fr, fq);
#undef SA
#undef SB
#undef STAGE
#undef LDA
#undef LDB
#undef MMA
}

__device__ __forceinline__ bool gemm_tile_coord(int i, int G, int c, int nM, int nN, int& pm, int& pn) {
    const int nwg = nM * nN; const long L = (long)i * G + c; if (L >= nwg) return false;
    int wgid = (int)L; { const int q = nwg / 8, r = nwg % 8, xcd = wgid % 8, off = wgid / 8; wgid = (xcd < r ? xcd * (q + 1) : r * (q + 1) + (xcd - r) * q) + off; }
    const int nig = 8 * nN, gid = wgid / nig, fm = gid * 8, gsz = (nM - fm) < 8 ? (nM - fm) : 8;
    pm = fm + ((wgid % nig) % gsz); pn = (wgid % nig) / gsz; return true;
}
template <class Epi>
__device__ __forceinline__ void gemm_phase(const bf16_t* A, const bf16_t* Bt, int K, int nM, int nN, char* lds, const Epi& epi, const int coff = 0) {
    const int G = gridDim.x, c = (BIDX() + G - coff) % G;
    int pm, pn; bool have = gemm_tile_coord(0, G, c, nM, nN, pm, pn), pre = false;
    for (int i = 0; have; ++i) {
        int qm = 0, qn = 0; const bool nxt = gemm_tile_coord(i + 1, G, c, nM, nN, qm, qn);
        gemm256_tile(A, Bt, K, pm * 256, pn * 256, pre, (Epi::PRESTAGE && nxt) ? qm * 256 : -1, qn * 256, lds, epi);
        pre = Epi::PRESTAGE && nxt; have = nxt; pm = qm; pn = qn;
    }
}

#define EPI_ARGS f32x4 (&acc)[2][2][4][2], int brow, int bcol, int wr, int wc, int fr, int fq
#define EPI_LOOP _Pragma("unroll") for (int ai = 0; ai < 2; ++ai) _Pragma("unroll") for (int bj = 0; bj < 2; ++bj) _Pragma("unroll") for (int m = 0; m < 4; ++m) _Pragma("unroll") for (int n = 0; n < 2; ++n)
#define EPI_ROW (brow + 128 * ai + 64 * wr + 16 * m + fr)
#define EPI_COL (bcol + 128 * bj + 32 * wc + 16 * n + 4 * fq)

__device__ __forceinline__ int vperm(int s) { return (s & ~31) | (((s >> 2) & 3) << 3) | (((s >> 4) & 1) << 2) | (s & 3); }
struct EpiBf16 {
    static constexpr bool PRESTAGE = true;
    bf16_t* C; int ldc;
    __device__ __forceinline__ void operator()(EPI_ARGS) const {
        EPI_LOOP { const f32x4 v = acc[ai][bj][m][n]; *(uint2*)(C + (size_t)EPI_ROW * ldc + EPI_COL) = make_uint2(pk2(v[0], v[1]), pk2(v[2], v[3])); }
    }
};
struct EpiMemKV {
    static constexpr bool PRESTAGE = false;
    float* outk; float* outv; bf16_t* mk; bf16_t* mvt;
    __device__ __forceinline__ void operator()(EPI_ARGS) const {
        EPI_LOOP {
            const int row = EPI_ROW, col = EPI_COL; const f32x4 v = acc[ai][bj][m][n];
            if (bcol == 0) { *(f32x4*)(outk + (size_t)row * 256 + col) = v; *(uint2*)(mk + (size_t)row * 256 + col) = make_uint2(pk2(v[0], v[1]), pk2(v[2], v[3])); }
            else { const int c = col - 256, b = row >> 8, mm = row & 255; *(f32x4*)(outv + (size_t)row * 256 + c) = v;
#pragma unroll
                for (int q = 0; q < 4; ++q) mvt[(size_t)((b * 4 + (c >> 6)) * 64 + (c & 63) + q) * 256 + mm] = f2bf(v[q]); }
        }
    }
};
struct EpiResid {
    static constexpr bool PRESTAGE = false;
    const bf16_t* X; bf16_t* Zb;
    __device__ __forceinline__ void operator()(EPI_ARGS) const {
#pragma unroll
        for (int ai = 0; ai < 2; ++ai)
#pragma unroll
            for (int bj = 0; bj < 2; ++bj) {
#pragma unroll
                for (int m = 0; m < 4; ++m)
#pragma unroll
                    for (int n = 0; n < 2; ++n) { const unsigned o = (unsigned)EPI_ROW * 1024u + (unsigned)EPI_COL; const uint2 x = *(const uint2*)(X + o); const f32x4 v = acc[ai][bj][m][n];
                        *(uint2*)(Zb + o) = make_uint2(pk2(ALPHA * bflo(x.x) + v[0], ALPHA * bfhi(x.x) + v[1]), pk2(ALPHA * bflo(x.y) + v[2], ALPHA * bfhi(x.y) + v[3])); }
                __builtin_amdgcn_sched_barrier(0);
            }
    }
};
struct EpiGU {
    static constexpr bool PRESTAGE = false;
    bf16_t* ACT;
    __device__ __forceinline__ void operator()(EPI_ARGS) const {
#pragma unroll
        for (int ai = 0; ai < 2; ++ai)
#pragma unroll
            for (int bj = 0; bj < 2; ++bj)
#pragma unroll
                for (int m = 0; m < 4; ++m) {
                    const int row = brow + 128 * ai + 64 * wr + 16 * m + fr, ocol = (bcol >> 1) + 64 * bj + 16 * wc + 4 * fq;
                    const f32x4 gt = acc[ai][bj][m][0], up = acc[ai][bj][m][1];
                    *(uint2*)(ACT + (size_t)row * DFF + ocol) = make_uint2(pk2(silu(gt[0]) * up[0], silu(gt[1]) * up[1]), pk2(silu(gt[2]) * up[2], silu(gt[3]) * up[3]));
                    __builtin_amdgcn_sched_barrier(0);
                }
    }
};
struct EpiProj1 {
    static constexpr bool PRESTAGE = false;
    bf16_t* QM; bf16_t* KBP; bf16_t* KBS; bf16_t* VTP; bf16_t* VTS; float* out; const float2* ropeD;
    __device__ __forceinline__ void operator()(EPI_ARGS) const {
        EPI_LOOP {
            const int row = EPI_ROW, col = EPI_COL;
            f32x4 v = acc[ai][bj][m][n];
            const int region = col < 768 ? 0 : (col < 1536 ? 1 : (col < 2304 ? 2 : 3));
            if (region <= 1) {
                const bool rot = ((wc & 1) == 0) && (n == 0);
                if (rot) {
                    f32x4 pr; pr[0] = __shfl_xor(v[0], 32); pr[1] = __shfl_xor(v[1], 32); pr[2] = __shfl_xor(v[2], 32); pr[3] = __shfl_xor(v[3], 32);
                    const int pos = row < TP ? (row & 4095) : 1024 + ((row - TP) & 63);
                    const float4* cs = (const float4*)(ropeD + pos * 8 + 4 * (fq & 1));
                    const float4 c01 = cs[0], c23 = cs[1];
                    const float cc[4] = {c01.x, c01.z, c23.x, c23.z}, sn[4] = {c01.y, c01.w, c23.y, c23.w};
#pragma unroll
                    for (int q = 0; q < 4; ++q) v[q] = fq < 2 ? v[q] * cc[q] - pr[q] * sn[q] : pr[q] * sn[q] + v[q] * cc[q];
                }
                const uint2 pk = make_uint2(pk2(v[0], v[1]), pk2(v[2], v[3]));
                if (region == 0) *(uint2*)(QM + (size_t)row * 1024 + col) = pk;
                else {
                    const int kc = col - 768;
                    if (row < TP) { *(uint2*)(KBP + (size_t)row * 768 + kc) = pk; *(f32x4*)(out + O_DKP + (size_t)row * 768 + kc) = v; }
                    else { const int rs = row - TP, b = rs >> 6, s = rs & 63; *(uint2*)(KBS + (size_t)(b * 1088 + 1024 + s) * 768 + kc) = pk; *(f32x4*)(out + O_DKS + (size_t)rs * 768 + kc) = v; }
                }
            } else if (region == 2) {
                const int vc = col - 1536, h = vc >> 7, dim = vc & 127;
                if (row < TP) {
                    const int b = row >> 12, s = row & 4095;
                    *(f32x4*)(out + O_DVP + (size_t)row * 768 + vc) = v;
#pragma unroll
                    for (int q = 0; q < 4; ++q) VTP[((size_t)(b * 6 + h) * 128 + dim + q) * 4096 + vperm(s)] = f2bf(v[q]);
                } else {
                    const int rs = row - TP, b = rs >> 6, s = rs & 63;
                    *(f32x4*)(out + O_DVS + (size_t)rs * 768 + vc) = v;
#pragma unroll
                    for (int q = 0; q < 4; ++q) VTS[((size_t)(b * 6 + h) * 128 + dim + q) * 1088 + 1024 + vperm(s)] = f2bf(v[q]);
                }
            } else {
                *(uint2*)(QM + (size_t)row * 1024 + 768 + (col - 2304)) = make_uint2(pk2(v[0], v[1]), pk2(v[2], v[3]));
            }
        }
    }
};

struct TrDesc { const float* src; bf16_t* dst; int lds_, ldd, k0, n0, mode, which; };
__device__ __forceinline__ void tr_load(const TrDesc& d, float4 (&r)[4], int tid) {
#pragma unroll
    for (int i = 0; i < 4; ++i) { const int k = (tid >> 4) + 16 * i, n4 = (tid & 15) * 4; r[i] = *(const float4*)(d.src + (size_t)(d.k0 + k) * d.lds_ + d.n0 + n4); }
}
__device__ __forceinline__ void tr_finish(const TrDesc& d, const float4 (&r)[4], float* tile, int tid) {
#pragma unroll
    for (int i = 0; i < 4; ++i) { const int k = (tid >> 4) + 16 * i, n4 = (tid & 15) * 4; float* t = tile + k * 65 + n4; t[0] = r[i].x; t[1] = r[i].y; t[2] = r[i].z; t[3] = r[i].w; }
    __syncthreads();
    const int n = tid >> 2, kq = (tid & 3) * 16;
    uint32_t w[8];
#pragma unroll
    for (int q = 0; q < 8; ++q) w[q] = pk2(tile[(kq + 2 * q) * 65 + n], tile[(kq + 2 * q + 1) * 65 + n]);
    const int c = d.n0 + n;
    const int row = d.mode != 1 ? c : (256 * (c >> 7) + 128 * ((c >> 6) & 1) + 32 * ((c >> 4) & 3) + 16 * d.which + (c & 15));
    if (d.mode == 2) {
        const int kk = d.k0 + kq, blk = kk & ~31, hi = (kk >> 4) & 1;
        bf16_t* o = d.dst + (size_t)c * d.ldd + blk + 4 * hi;
#pragma unroll
        for (int gg = 0; gg < 4; ++gg) *(uint2*)(o + 8 * gg) = make_uint2(w[2 * gg], w[2 * gg + 1]);
    } else {
        uint4* o = (uint4*)(d.dst + (size_t)row * d.ldd + d.k0 + kq);
        o[0] = make_uint4(w[0], w[1], w[2], w[3]); o[1] = make_uint4(w[4], w[5], w[6], w[7]);
    }
    __syncthreads();
}
__device__ __forceinline__ TrDesc tr_desc0(const Params& p, int it) {
    char* ws = p.ws;
    constexpr int T0 = 832, T1 = T0 + 640, T2 = T1 + 256, T3 = T2 + 512, T4 = T3 + 1408, T5 = T4 + 1408;
    if (it < T0) { const int kt = it / 52, nt = it % 52; return TrDesc{p.in[8], (bf16_t*)(ws + W_WRET), NRET, 1024, kt * 64, nt * 64, 0, 0}; }
    if (it < T1) { const int r = it - T0, kt = r / 40, nt = r % 40; return TrDesc{p.in[10], (bf16_t*)(ws + W_WDIFF), NDIFF, 1024, kt * 64, nt * 64, 0, 0}; }
    if (it < T2) { const int r = it - T1, l = r >> 7, q = r & 127, kt = q >> 3, nt = q & 7; return TrDesc{p.in[16] + (size_t)l * 1024 * 512, (bf16_t*)(ws + W_WMKV) + (size_t)l * 512 * 1024, 512, 1024, kt * 64, nt * 64, 0, 0}; }
    if (it < T3) { const int r = it - T2, l = r >> 8, q = r & 255, kt = q >> 4, nt = q & 15; return TrDesc{p.in[17] + (size_t)l * 1024 * 1024, (bf16_t*)(ws + W_WO) + (size_t)l * 1024 * 1024, 1024, 1024, kt * 64, nt * 64, 0, 0}; }
    if (it < T5) { const int wh = it >= T4; const int r = it - (wh ? T4 : T3), l = r / 704, q = r % 704, kt = q / 44, nt = q % 44;
        return TrDesc{p.in[wh ? 21 : 20] + (size_t)l * 1024 * DFF, (bf16_t*)(ws + W_WGU) + (size_t)l * 5632 * 1024, DFF, 1024, kt * 64, nt * 64, 1, wh}; }
    { const int r = it - T5, l = r / 704, q = r % 704, kt = q >> 4, nt = q & 15; return TrDesc{p.in[22] + (size_t)l * DFF * 1024, (bf16_t*)(ws + W_WD) + (size_t)l * 1024 * DFF, 1024, DFF, kt * 64, nt * 64, 0, 0}; }
}
__device__ __forceinline__ TrDesc tr_desc9(const Params& p, int it) {
    const int bh = it >> 5, q = it & 31, jt = q >> 1, dt = q & 1, b = bh / 6, h = bh % 6;
    return TrDesc{p.in[5] + (size_t)b * 1024 * 768 + h * 128, (bf16_t*)(p.ws + W_VTS) + (size_t)bh * 128 * 1088, 768, 1088, jt * 64, dt * 64, 2, 0};
}

__device__ __forceinline__ void phase_prep(const Params& p, char* lds) {
    char* ws = p.ws;
    const int nb = gridDim.x, bid = BIDX(), tid = TIDX(), half = tid >> 8, tl = tid & 255;
    float* tile = (float*)lds + half * 4224;
    constexpr int T6 = 832 + 640 + 256 + 512 + 3 * 1408;
    if (bid < T6 / 2) {
        TrDesc dc = tr_desc0(p, 2 * bid + half); float4 r[4]; tr_load(dc, r, tl);
        for (int it2 = bid; it2 < T6 / 2; it2 += nb) {
            const bool has = it2 + nb < T6 / 2;
            TrDesc dn = dc; float4 rn[4];
            if (has) { dn = tr_desc0(p, 2 * (it2 + nb) + half); tr_load(dn, rn, tl); }
            tr_finish(dc, r, tile, tl);
            if (has) { dc = dn;
#pragma unroll
                for (int i = 0; i < 4; ++i) r[i] = rn[i]; }
        }
    }
    const size_t gt = (size_t)bid * NTHR + tid, gs = (size_t)nb * NTHR;
    { uint2* dst = (uint2*)(ws + W_XB); const float4* xp = (const float4*)p.in[0]; const float4* xs = (const float4*)p.in[1];
      const size_t n4 = (size_t)TT * 256, np4 = (size_t)TP * 256;
      for (size_t i = gt; i < n4; i += gs) { const float4 v = i < np4 ? xp[i] : xs[i - np4]; dst[i] = make_uint2(pk2(v.x, v.y), pk2(v.z, v.w)); } }
    { uint2* dst = (uint2*)(ws + W_MB); const float4* s = (const float4*)p.in[2];
      for (size_t i = gt; i < 2048ull * 256; i += gs) { const float4 v = s[i]; dst[i] = make_uint2(pk2(v.x, v.y), pk2(v.z, v.w)); } }
    { uint2* dst = (uint2*)(ws + W_MK); const float4* s = (const float4*)p.in[6];
      for (size_t i = gt; i < 2ull * 16 * 16384; i += gs) { const size_t l = i / (16 * 16384), rem = i - l * 16 * 16384; const float4 v = s[i]; dst[(l * 24 + 8) * 16384 + rem] = make_uint2(pk2(v.x, v.y), pk2(v.z, v.w)); } }
    { bf16_t* dst = (bf16_t*)(ws + W_MVT); const float* s = p.in[7];
      for (size_t i = gt; i < 2ull * 16 * 65536; i += gs) {
          const int m = i & 255, dim = (i >> 8) & 63, h = (i >> 14) & 3, b = (i >> 16) & 15, l = (int)(i >> 20);
          dst[((size_t)((l * 24 + 8 + b) * 4 + h) * 64 + dim) * 256 + m] = f2bf(s[((size_t)(l * 16 + b) * 256 + m) * 256 + h * 64 + dim]); } }
    { float2* rr = (float2*)(ws + W_ROPER); float2* rd = (float2*)(ws + W_ROPED);
      for (size_t i = gt; i < 4096ull * 64; i += gs) { const int pos = (int)(i >> 6), f = (int)(i & 63); const float inv = expf(-logf(10000.f) * (float)f * 2.0f / 128.f); float sn, cs; sincosf((float)pos * inv, &sn, &cs); rr[i] = make_float2(cs, sn); }
      for (size_t i = gt; i < 4096ull * 8; i += gs) { const int pos = (int)(i >> 3), f = (int)(i & 7); const float inv = expf(-logf(500000.f) * (float)f * 2.0f / 16.f); float sn, cs; sincosf((float)pos * inv, &sn, &cs); rd[i] = make_float2(cs, sn); } }
    if (bid == 0 && tid < 64) ((int*)(ws + W_CTRL))[tid] = 0;
}

__device__ __forceinline__ void ret_chain(const Params& p, int h, int sl, int nsteps, int rowbase, int posbase, const float* init, bf16_t* rs, float* fin, char* lds) {
    const int tid = TIDX(), lane = tid & 63, w = tid >> 6, g = lane >> 4, lc = lane & 15;
    const float log_g = logf(1.f - exp2f(-5.f - (float)h));
    const float gch = expf(64.f * log_g);
    const float kscale = 0.08838834764831845f;
    const bf16_t* proj = (const bf16_t*)(p.ws + W_RA);
    const float2* ropeR = (const float2*)(p.ws + W_ROPER);
    f32x4 acc[2];
#pragma unroll
    for (int jj = 0; jj < 2; ++jj)
#pragma unroll
        for (int r = 0; r < 4; ++r) { const int d = 16 * w + 4 * g + r, e = sl * 32 + 16 * jj + lc; acc[jj][r] = init ? init[d * 128 + e] : 0.f; }
    const float zeta = expf((float)(63 - (tid >> 3)) * log_g) * kscale;
    uint4 ka0, kb0, vv0, ka1, kb1, vv1, ka2, kb2, vv2, ka3, kb3, vv3;
    float4 ca0[4], ca1[4], ca2[4], ca3[4];
    const int kj = tid >> 3, kdg = tid & 7, vj = (tid >> 2) & 63, veg = tid & 3;
    const int kjs = kj ^ (kdg << 3), vjs = vj ^ (veg << 4);
#define RC_LOAD(c_, K1, K2, VV, CS) do { const bf16_t* s_ = proj + (size_t)(rowbase + (c_) * 64 + kj) * NRET + 768 + h * 128 + kdg * 8; K1 = *(const uint4*)s_; K2 = *(const uint4*)(s_ + 64); \
        { const float4* cs_ = (const float4*)(ropeR + (size_t)(posbase + (c_) * 64 + kj) * 64 + kdg * 8); CS[0] = cs_[0]; CS[1] = cs_[1]; CS[2] = cs_[2]; CS[3] = cs_[3]; } \
        VV = *(const uint4*)(proj + (size_t)(rowbase + (c_) * 64 + vj) * NRET + 1536 + h * 128 + sl * 32 + veg * 8); } while (0)
#define RC_STEP(c_, K1, K2, VV, CS) if ((c_) < nsteps) { const int c = (c_); \
        bf16_t* Kt = (bf16_t*)(lds + (c & 1) * 18432); \
        bf16_t* Vt = (bf16_t*)(lds + 36864 + (c & 1) * 4608); \
        { \
            float x1[8], x2[8]; unpack8(K1, x1); unpack8(K2, x2); \
            _Pragma("unroll") for (int e2 = 0; e2 < 4; ++e2) { \
                const float4 t = CS[e2]; \
                { const float a = x1[2 * e2], b = x2[2 * e2]; Kt[(kdg * 8 + 2 * e2) * 72 + kjs] = f2bf((a * t.x - b * t.y) * zeta); Kt[(64 + kdg * 8 + 2 * e2) * 72 + kjs] = f2bf((a * t.y + b * t.x) * zeta); } \
                { const float a = x1[2 * e2 + 1], b = x2[2 * e2 + 1]; Kt[(kdg * 8 + 2 * e2 + 1) * 72 + kjs] = f2bf((a * t.z - b * t.w) * zeta); Kt[(64 + kdg * 8 + 2 * e2 + 1) * 72 + kjs] = f2bf((a * t.w + b * t.z) * zeta); } \
            } \
        } \
        if (tid < 256) { const uint32_t u[4] = {VV.x, VV.y, VV.z, VV.w}; \
          _Pragma("unroll") for (int e2 = 0; e2 < 4; ++e2) { Vt[(veg * 8 + 2 * e2) * 72 + vjs] = (bf16_t)(u[e2] & 0xffff); Vt[(veg * 8 + 2 * e2 + 1) * 72 + vjs] = (bf16_t)(u[e2] >> 16); } } \
        if (c + 4 < nsteps) RC_LOAD(c + 4, K1, K2, VV, CS); \
        __syncthreads(); \
        bf16_t* rsc = rs + (size_t)c * 16384; \
        _Pragma("unroll") for (int jj = 0; jj < 2; ++jj) { \
            const int d = 16 * w + 4 * g, e = sl * 32 + 16 * jj + lc; \
            *(uint2*)(rsc + e * 128 + d) = make_uint2(pk2(acc[jj][0], acc[jj][1]), pk2(acc[jj][2], acc[jj][3])); \
            acc[jj] = acc[jj] * gch; \
        } \
        _Pragma("unroll") for (int s = 0; s < 2; ++s) { \
            const bf16x8 a = ld8(Kt + (16 * w + lc) * 72 + ((4 * s + g) ^ ((2 * w + (lc >> 3)) & 7)) * 8); \
            _Pragma("unroll") for (int jj = 0; jj < 2; ++jj) acc[jj] = MFMA16(a, ld8(Vt + (16 * jj + lc) * 72 + ((4 * s + g) ^ (((2 * jj + (lc >> 3)) & 3) << 1)) * 8), acc[jj]); \
        } \
    }
    RC_LOAD(0, ka0, kb0, vv0, ca0);
    if (1 < nsteps) RC_LOAD(1, ka1, kb1, vv1, ca1);
    if (2 < nsteps) RC_LOAD(2, ka2, kb2, vv2, ca2);
    if (3 < nsteps) RC_LOAD(3, ka3, kb3, vv3, ca3);
    for (int c4 = 0; c4 < nsteps; c4 += 4) {
        RC_STEP(c4, ka0, kb0, vv0, ca0)
        RC_STEP(c4 + 1, ka1, kb1, vv1, ca1)
        RC_STEP(c4 + 2, ka2, kb2, vv2, ca2)
        RC_STEP(c4 + 3, ka3, kb3, vv3, ca3)
    }
#pragma unroll
    for (int jj = 0; jj < 2; ++jj)
#pragma unroll
        for (int r = 0; r < 4; ++r) { const int d = 16 * w + 4 * g + r, e = sl * 32 + 16 * jj + lc; fin[d * 128 + e] = acc[jj][r]; }
    __syncthreads();
#undef RC_LOAD
#undef RC_STEP
}
__device__ __forceinline__ void ret_out(const Params& p, int u2, char* lds_) {
    const int tid_ = TIDX(), half = tid_ >> 8, tid = tid_ & 255, lane = tid & 63, w = tid >> 6, g = lane >> 4, lc = lane & 15;
    const int u = 2 * u2 + half; char* lds = lds_ + half * 53248;
    int b, h, rowbase, pos0;
    if (u < 3072) { const int chain = u >> 6, c = u & 63; b = chain / 6; h = chain % 6; rowbase = b * 4096 + c * 64; pos0 = c * 64; }
    else { const int cs = u - 3072; b = cs / 6; h = cs % 6; rowbase = TP + b * 64; pos0 = 1024; }
    const float log_g = logf(1.f - exp2f(-5.f - (float)h));
    const float log2g = log_g * 1.44269504089f;
    const float kscale = 0.08838834764831845f;
    const bf16_t* proj = (const bf16_t*)(p.ws + W_RA);
    const float2* ropeR = (const float2*)(p.ws + W_ROPER);
    const bf16_t* rsu = (const bf16_t*)(p.out + O_DKP) + (size_t)u * 16384;
    bf16_t* H = (bf16_t*)(p.ws + W_H);
    bf16_t* Qs = (bf16_t*)lds; bf16_t* Ks = (bf16_t*)(lds + 17408); bf16_t* Vt = (bf16_t*)(lds + 34816);
#pragma unroll
    for (int q = 0; q < 2; ++q) {
        const int it = tid + 256 * q, j = it >> 3, dg = it & 7;
        const bf16_t* s = proj + (size_t)(rowbase + j) * NRET + h * 128 + dg * 8;
        const uint4 q1 = *(const uint4*)s, q2 = *(const uint4*)(s + 64), kk1 = *(const uint4*)(s + 768), kk2 = *(const uint4*)(s + 768 + 64);
        const float4* cs = (const float4*)(ropeR + (size_t)(pos0 + j) * 64 + dg * 8);
        float a1[8], a2[8], b1[8], b2[8]; unpack8(q1, a1); unpack8(q2, a2); unpack8(kk1, b1); unpack8(kk2, b2);
        float qo1[8], qo2[8], ko1[8], ko2[8];
#pragma unroll
        for (int e2 = 0; e2 < 4; ++e2) {
            const float4 t = cs[e2];
            qo1[2 * e2] = a1[2 * e2] * t.x - a2[2 * e2] * t.y; qo2[2 * e2] = a1[2 * e2] * t.y + a2[2 * e2] * t.x;
            qo1[2 * e2 + 1] = a1[2 * e2 + 1] * t.z - a2[2 * e2 + 1] * t.w; qo2[2 * e2 + 1] = a1[2 * e2 + 1] * t.w + a2[2 * e2 + 1] * t.z;
            ko1[2 * e2] = (b1[2 * e2] * t.x - b2[2 * e2] * t.y) * kscale; ko2[2 * e2] = (b1[2 * e2] * t.y + b2[2 * e2] * t.x) * kscale;
            ko1[2 * e2 + 1] = (b1[2 * e2 + 1] * t.z - b2[2 * e2 + 1] * t.w) * kscale; ko2[2 * e2 + 1] = (b1[2 * e2 + 1] * t.w + b2[2 * e2 + 1] * t.z) * kscale;
        }
        *(uint4*)(Qs + j * 136 + dg * 8) = make_uint4(pk2(qo1[0], qo1[1]), pk2(qo1[2], qo1[3]), pk2(qo1[4], qo1[5]), pk2(qo1[6], qo1[7]));
        *(uint4*)(Qs + j * 136 + 64 + dg * 8) = make_uint4(pk2(qo2[0], qo2[1]), pk2(qo2[2], qo2[3]), pk2(qo2[4], qo2[5]), pk2(qo2[6], qo2[7]));
        *(uint4*)(Ks + j * 136 + dg * 8) = make_uint4(pk2(ko1[0], ko1[1]), pk2(ko1[2], ko1[3]), pk2(ko1[4], ko1[5]), pk2(ko1[6], ko1[7]));
        *(uint4*)(Ks + j * 136 + 64 + dg * 8) = make_uint4(pk2(ko2[0], ko2[1]), pk2(ko2[2], ko2[3]), pk2(ko2[4], ko2[5]), pk2(ko2[6], ko2[7]));
    }
#pragma unroll
    for (int q = 0; q < 4; ++q) {
        const int it = tid + 256 * q, j = it >> 4, eg = it & 15;
        const uint4 v = *(const uint4*)(proj + (size_t)(rowbase + j) * NRET + 1536 + h * 128 + eg * 8);
        const uint32_t uu[4] = {v.x, v.y, v.z, v.w};
#pragma unroll
        for (int e2 = 0; e2 < 4; ++e2) { Vt[(eg * 8 + 2 * e2) * 72 + j] = (bf16_t)(uu[e2] & 0xffff); Vt[(eg * 8 + 2 * e2 + 1) * 72 + j] = (bf16_t)(uu[e2] >> 16); }
    }
    __syncthreads();
    bf16x8 qf[4];
#pragma unroll
    for (int s = 0; s < 4; ++s) qf[s] = ld8(Qs + (16 * w + lc) * 136 + 32 * s + 8 * g);
    f32x4 st[4];
#pragma unroll
    for (int t = 0; t < 4; ++t) {
        st[t] = (f32x4){0.f, 0.f, 0.f, 0.f};
#pragma unroll
        for (int s = 0; s < 4; ++s) st[t] = MFMA16(ld8(Ks + (16 * t + lc) * 136 + 32 * s + 8 * g), qf[s], st[t]);
    }
    const int ii = 16 * w + lc;
#pragma unroll
    for (int t = 0; t < 4; ++t)
#pragma unroll
        for (int r = 0; r < 4; ++r) { const int j = 16 * t + 4 * g + r; st[t][r] *= exp2f(fabsf((float)(ii - j)) * log2g); }
    f32x4 o[8], oc[8];
#pragma unroll
    for (int et = 0; et < 8; ++et) { o[et] = (f32x4){0.f, 0.f, 0.f, 0.f}; oc[et] = (f32x4){0.f, 0.f, 0.f, 0.f}; }
#pragma unroll
    for (int s = 0; s < 2; ++s) {
        const bf16x8 pb = pack8(st[2 * s], st[2 * s + 1]);
#pragma unroll
        for (int et = 0; et < 8; ++et) { const bf16_t* vr = Vt + (16 * et + lc) * 72 + 32 * s + 4 * g; o[et] = MFMA16(ld44(vr, vr + 16), pb, o[et]); }
    }
#pragma unroll
    for (int et = 0; et < 8; ++et)
#pragma unroll
        for (int s = 0; s < 4; ++s) oc[et] = MFMA16(ld8(rsu + (16 * et + lc) * 128 + 32 * s + 8 * g), qf[s], oc[et]);
    const float xi = exp2f((float)(ii + 1) * log2g);
    float sum = 0.f;
#pragma unroll
    for (int et = 0; et < 8; ++et)
#pragma unroll
        for (int r = 0; r < 4; ++r) { o[et][r] += xi * oc[et][r]; sum += o[et][r]; }
    const float mean = xr16_32_sum(sum) * (1.f / 128.f);
    float sq = 0.f;
#pragma unroll
    for (int et = 0; et < 8; ++et)
#pragma unroll
        for (int r = 0; r < 4; ++r) { const float dd = o[et][r] - mean; sq += dd * dd; }
    const float rstd = rsqrtf(xr16_32_sum(sq) * (1.f / 128.f) + 1e-5f);
    const size_t row = (size_t)rowbase + ii;
    const float* gn = p.in[9] + h * 128;
#pragma unroll
    for (int et = 0; et < 8; ++et) {
        const int e = 16 * et + 4 * g;
        const uint2 gt = *(const uint2*)(proj + row * NRET + 2304 + h * 128 + e);
        const float4 gg = *(const float4*)(gn + e);
        const float y0 = (o[et][0] - mean) * rstd * gg.x * silu(bflo(gt.x)), y1 = (o[et][1] - mean) * rstd * gg.y * silu(bfhi(gt.x));
        const float y2 = (o[et][2] - mean) * rstd * gg.z * silu(bflo(gt.y)), y3 = (o[et][3] - mean) * rstd * gg.w * silu(bfhi(gt.y));
        *(uint2*)(H + row * 1024 + h * 128 + e) = make_uint2(pk2(y0, y1), pk2(y2, y3));
    }
    __syncthreads();
}

__device__ __forceinline__ void glds16_asm(const void* gsrc, unsigned lds_dst) {
    unsigned keep;
    asm volatile("s_mov_b32 %0, m0\n\ts_mov_b32 m0, %2\n\ts_nop 0\n\tglobal_load_lds_dwordx4 %1, off\n\ts_mov_b32 m0, %0" : "=&s"(keep) : "v"(gsrc), "s"(lds_dst) : "memory");
}
__device__ __forceinline__ void mem_attn(const Params& p, int unit, int layer, char* lds) {
    const int tid = TIDX(), lane = tid & 63, w = tid >> 6, g = lane >> 4, lc = lane & 15;
    const bf16_t* Q; int ldq;
    if (layer == 0) { Q = (const bf16_t*)(p.ws + W_RA) + 3072; ldq = NRET; } else { Q = (const bf16_t*)(p.ws + W_QM) + 768; ldq = 1024; }
    int bb, h, r0, npass; bool all8;
    if (unit < 256) { const int b = unit >> 5; h = (unit >> 3) & 3; bb = b; r0 = b * 4096 + (unit & 7) * 512; npass = 4; all8 = true; }
    else { const int us = unit - 256, b = us >> 2; h = us & 3; bb = 8 + b; r0 = TP + b * 64; npass = 1; all8 = false; }
    const bf16_t* mk = (const bf16_t*)(p.ws + W_MK) + (size_t)(layer * 24 + bb) * 65536 + h * 64;
    const bf16_t* mv = (const bf16_t*)(p.ws + W_MVT) + (size_t)((layer * 24 + bb) * 4 + h) * 16384;
    bf16_t* H = (bf16_t*)(p.ws + W_H);
    const float sc = 0.125f * 1.44269504089f;
    asm volatile("s_waitcnt vmcnt(0) lgkmcnt(0)" ::: "memory");
    __syncthreads();
    {
        const unsigned lds_w = (unsigned)__builtin_amdgcn_readfirstlane((int)(unsigned)(size_t)(LAS char*)lds + (tid & ~63) * 16);
#pragma unroll
        for (int i = 0; i < 4; ++i) {
            const int kr = (tid >> 3) + 64 * i, kc = (tid & 7) ^ ((kr >> 1) & 7);
            glds16_asm(mk + (size_t)kr * 256 + kc * 8, lds_w + i * 8192);
            const int vr = (tid >> 5) + 16 * i, vc = (tid & 31) ^ (vr & 15);
            glds16_asm(mv + (size_t)vr * 256 + vc * 8, lds_w + 32768 + i * 8192);
        }
    }
    const bf16_t* Ks = (const bf16_t*)lds; const bf16_t* Vs = (const bf16_t*)(lds + 32768);
    const bool act = all8 || w < 4;
    const size_t rowb = (size_t)r0 + 16 * (all8 ? w : (w & 3)) + lc;
    bf16x8 qf[2];
#pragma unroll
    for (int s = 0; s < 2; ++s) qf[s] = ld8(Q + rowb * ldq + h * 64 + 32 * s + 8 * g);
#pragma unroll
    for (int s = 0; s < 2; ++s) asm volatile("" : "+v"(qf[s]));
    asm volatile("s_waitcnt vmcnt(0)" ::: "memory");
    __syncthreads();
    for (int it = 0; it < npass; ++it) {
        const size_t row = rowb + (size_t)it * 128;
        bf16x8 qn[2];
        if (it + 1 < npass) {
#pragma unroll
            for (int s = 0; s < 2; ++s) qn[s] = ld8(Q + (row + 128) * ldq + h * 64 + 32 * s + 8 * g);
        }
        if (act) {
            f32x4 st[16];
            float mx = -3.0e38f;
#pragma unroll
            for (int t = 0; t < 16; ++t) {
                st[t] = (f32x4){0.f, 0.f, 0.f, 0.f};
#pragma unroll
                for (int s = 0; s < 2; ++s) st[t] = MFMA16(ld8(Ks + (16 * t + lc) * 64 + ((4 * s + g) ^ ((lc >> 1) & 7)) * 8), qf[s], st[t]);
                mx = fmaxf(mx, fmaxf(fmaxf(st[t][0], st[t][1]), fmaxf(st[t][2], st[t][3])));
            }
            mx = xr16_32_max(mx) * sc;
            float sum = 0.f;
#pragma unroll
            for (int t = 0; t < 16; ++t)
#pragma unroll
                for (int r = 0; r < 4; ++r) { st[t][r] = __builtin_amdgcn_exp2f(st[t][r] * sc - mx); sum += st[t][r]; }
            const float inv = 1.f / xr16_32_sum(sum);
            f32x4 o[4];
#pragma unroll
            for (int dt = 0; dt < 4; ++dt) o[dt] = (f32x4){0.f, 0.f, 0.f, 0.f};
#pragma unroll
            for (int s = 0; s < 8; ++s) {
                const bf16x8 pb = pack8(st[2 * s] * inv, st[2 * s + 1] * inv);
#pragma unroll
                for (int dt = 0; dt < 4; ++dt) { const bf16_t* vr = Vs + (16 * dt + lc) * 256 + (g & 1) * 4; o[dt] = MFMA16(ld44(vr + ((4 * s + (g >> 1)) ^ lc) * 8, vr + ((4 * s + (g >> 1) + 2) ^ lc) * 8), pb, o[dt]); }
            }
#pragma unroll
            for (int dt = 0; dt < 4; ++dt) *(uint2*)(H + row * 1024 + 768 + h * 64 + 16 * dt + 4 * g) = make_uint2(pk2(o[dt][0], o[dt][1]), pk2(o[dt][2], o[dt][3]));
        }
        if (it + 1 < npass) { qf[0] = qn[0]; qf[1] = qn[1]; }
    }
    __syncthreads();
}

__device__ __forceinline__ void diff_attn(const Params& p, int rowq0, int h, const bf16_t* Kp, const bf16_t* Vp, int ldv, int nkt, int nkt_lo, bool hi_active, float lam, char* lds) {
    const int tid = TIDX(), lane = tid & 63, w = tid >> 6, g = lane >> 4, lc = lane & 15;
    const bf16_t* QM = (const bf16_t*)(p.ws + W_QM);
    bf16_t* H = (bf16_t*)(p.ws + W_H);
    const size_t row = (size_t)rowq0 + 16 * (hi_active ? w : (w & 3)) + lc;
    const int my_nkt = w < 4 ? nkt_lo : (hi_active ? nkt : 0);
    const float sc = 0.125f * 1.44269504089f;
    bf16x8 qf[2][2];
#pragma unroll
    for (int c = 0; c < 2; ++c)
#pragma unroll
        for (int s = 0; s < 2; ++s) qf[c][s] = ld8(QM + row * 1024 + h * 128 + c * 64 + 32 * s + 8 * g);
    f32x4 o[2][8];
    float m[2] = {0.f, 0.f};
    f32x4 osum[2] = {(f32x4){0.f, 0.f, 0.f, 0.f}, (f32x4){0.f, 0.f, 0.f, 0.f}};
    const bf16x8 onesA = mk8(0x3F803F80u, 0x3F803F80u, 0x3F803F80u, 0x3F803F80u);
#pragma unroll
    for (int c = 0; c < 2; ++c)
#pragma unroll
        for (int dt = 0; dt < 8; ++dt) o[c][dt] = (f32x4){0.f, 0.f, 0.f, 0.f};
    const int kkey = tid >> 4, kdc = tid & 15;
    const int vdim = tid >> 3, vkc = tid & 7;
    const bf16_t* kg0 = Kp + (size_t)kkey * 768 + (kdc ^ (kkey & 15)) * 8;
    const bf16_t* vg0 = Vp + (size_t)vdim * ldv + (vkc ^ (vdim & 7)) * 8;
    const unsigned lds_w = (unsigned)__builtin_amdgcn_readfirstlane((int)(unsigned)(size_t)(LAS char*)lds + (tid & ~63) * 16);
#define DA_ISSUE(vt_) do { const int st_ = (vt_) & 3; const int tt_ = (vt_) < nkt ? (vt_) : nkt - 1; \
        const bf16_t* kg_ = kg0 + (size_t)tt_ * (64 * 768); const bf16_t* vg_ = vg0 + tt_ * 64; const unsigned dst_ = lds_w + st_ * 32768; \
        glds16_asm(kg_, dst_); glds16_asm(kg_ + 32 * 768, dst_ + 8192); glds16_asm(vg_, dst_ + 16384); glds16_asm(vg_ + (size_t)64 * ldv, dst_ + 16384 + 8192); } while (0)
#pragma unroll
    for (int c = 0; c < 2; ++c)
#pragma unroll
        for (int s = 0; s < 2; ++s) asm volatile("" : "+v"(qf[c][s]));
    asm volatile("s_waitcnt vmcnt(0) lgkmcnt(0)" ::: "memory");
    __syncthreads();
    DA_ISSUE(0); DA_ISSUE(1); DA_ISSUE(2);
    asm volatile("s_waitcnt vmcnt(8)" ::: "memory");
    __builtin_amdgcn_s_barrier();
    for (int kt = 0; kt < nkt; ++kt) {
        DA_ISSUE(kt + 3);
        if (kt < my_nkt) {
            const bf16_t* Ks = (const bf16_t*)(lds + (kt & 3) * 32768); const bf16_t* Vt = (const bf16_t*)(lds + (kt & 3) * 32768 + 16384);
            f32x4 st[2][4];
#pragma unroll
            for (int c = 0; c < 2; ++c)
#pragma unroll
                for (int t = 0; t < 4; ++t) {
                    st[c][t] = (f32x4){0.f, 0.f, 0.f, 0.f};
#pragma unroll
                    for (int s = 0; s < 2; ++s) st[c][t] = MFMA16(ld8(Ks + (16 * t + lc) * 128 + ((c * 8 + 4 * s + g) ^ lc) * 8), qf[c][s], st[c][t]);
                }
#pragma unroll
            for (int c = 0; c < 2; ++c) {
                const float mneg = -m[c];
#pragma unroll
                for (int t = 0; t < 4; ++t)
#pragma unroll
                    for (int r = 0; r < 4; ++r) st[c][t][r] = __builtin_fmaf(st[c][t][r], sc, mneg);
                float mx = -3.0e38f;
#pragma unroll
                for (int t = 0; t < 4; ++t) mx = fmaxf(mx, fmaxf(fmaxf(st[c][t][0], st[c][t][1]), fmaxf(st[c][t][2], st[c][t][3])));
                mx = xr16_32_max(mx);
                const bool first = kt == 0;
                if (first || __builtin_amdgcn_ballot_w64(mx > 8.f) != 0ull) {
                    const float d = first ? mx : fmaxf(mx, 0.f);
                    m[c] += d;
                    if (!first) {
                        const float al = __builtin_amdgcn_exp2f(-d);
                        osum[c] = osum[c] * al;
#pragma unroll
                        for (int dt = 0; dt < 8; ++dt) o[c][dt] = o[c][dt] * al;
                    }
#pragma unroll
                    for (int t = 0; t < 4; ++t)
#pragma unroll
                        for (int r = 0; r < 4; ++r) st[c][t][r] -= d;
                }
#pragma unroll
                for (int t = 0; t < 4; ++t)
#pragma unroll
                    for (int r = 0; r < 4; ++r) st[c][t][r] = __builtin_amdgcn_exp2f(st[c][t][r]);
            }
#pragma unroll
            for (int s = 0; s < 2; ++s) {
                const bf16x8 pb0 = pack8(st[0][2 * s], st[0][2 * s + 1]), pb1 = pack8(st[1][2 * s], st[1][2 * s + 1]);
                osum[0] = MFMA16(onesA, pb0, osum[0]); osum[1] = MFMA16(onesA, pb1, osum[1]);
#pragma unroll
                for (int dt = 0; dt < 8; ++dt) {
                    const bf16x8 va = ld8(Vt + (16 * dt + lc) * 64 + ((4 * s + g) ^ (lc & 7)) * 8);
                    o[0][dt] = MFMA16(va, pb0, o[0][dt]); o[1][dt] = MFMA16(va, pb1, o[1][dt]);
                }
            }
        }
        asm volatile("s_waitcnt vmcnt(8) lgkmcnt(0)" ::: "memory");
        __builtin_amdgcn_s_barrier();
    }
    asm volatile("s_waitcnt vmcnt(0)" ::: "memory");
    if (my_nkt > 0) {
        const float i0 = 1.f / osum[0][0], i1 = lam / osum[1][0];
        float sq = 0.f;
#pragma unroll
        for (int dt = 0; dt < 8; ++dt)
#pragma unroll
            for (int r = 0; r < 4; ++r) { const float v = o[0][dt][r] * i0 - o[1][dt][r] * i1; o[0][dt][r] = v; sq += v * v; }
        const float rs = rsqrtf(xr16_32_sum(sq) * (1.f / 128.f) + 1e-5f) * (1.f - LAM_INIT);
        const float* sg = p.in[15];
#pragma unroll
        for (int dt = 0; dt < 8; ++dt) {
            const int e = 16 * dt + 4 * g;
            const float4 gg = *(const float4*)(sg + e);
            *(uint2*)(H + row * 1024 + h * 128 + e) = make_uint2(pk2(o[0][dt][0] * rs * gg.x, o[0][dt][1] * rs * gg.y), pk2(o[0][dt][2] * rs * gg.z, o[0][dt][3] * rs * gg.w));
        }
    }
#undef DA_ISSUE
}

__device__ __forceinline__ void phase_ln(const Params& p, const float* gam, const float* bet, const bf16_t* Zb, bf16_t* Xd, bool fin) {
    const int lane = TIDX() & 63, w = TIDX() >> 6;
    float4 gg[4], bb[4];
#pragma unroll
    for (int i = 0; i < 4; ++i) { gg[i] = ((const float4*)gam)[lane + 64 * i]; bb[i] = ((const float4*)bet)[lane + 64 * i]; }
    for (int row = BIDX() * 8 + w; row < TT; row += gridDim.x * 8) {
        const uint2* z = (const uint2*)(Zb + (size_t)row * 1024);
        float4 v[4]; float s = 0.f;
#pragma unroll
        for (int i = 0; i < 4; ++i) { const uint2 u = z[lane + 64 * i]; v[i] = make_float4(bflo(u.x), bfhi(u.x), bflo(u.y), bfhi(u.y)); s += (v[i].x + v[i].y) + (v[i].z + v[i].w); }
        const float mean = wave_sum(s) * (1.f / 1024.f);
        float q = 0.f;
#pragma unroll
        for (int i = 0; i < 4; ++i) { v[i].x -= mean; v[i].y -= mean; v[i].z -= mean; v[i].w -= mean; q += (v[i].x * v[i].x + v[i].y * v[i].y) + (v[i].z * v[i].z + v[i].w * v[i].w); }
        const float rstd = rsqrtf(wave_sum(q) * (1.f / 1024.f) + 1e-5f);
        uint2* xd = (uint2*)(Xd + (size_t)row * 1024);
        float4* yo = (float4*)(p.out + (size_t)row * 1024);
#pragma unroll
        for (int i = 0; i < 4; ++i) {
            float4 y; y.x = v[i].x * rstd * gg[i].x + bb[i].x; y.y = v[i].y * rstd * gg[i].y + bb[i].y; y.z = v[i].z * rstd * gg[i].z + bb[i].z; y.w = v[i].w * rstd * gg[i].w + bb[i].w;
            if (fin) yo[lane + 64 * i] = y; else xd[lane + 64 * i] = make_uint2(pk2(y.x, y.y), pk2(y.z, y.w));
        }
    }
}

__device__ __forceinline__ int next_unit(int* ctr, char* lds) {
    int* slot = (int*)(lds + LDS_MAIN);
    if (TIDX() == 0) *slot = atomicAdd(ctr, 1);
    __syncthreads();
    const int u = *slot;
    __syncthreads();
    return u;
}


#define XB_TMO      128
#define XB_XCNT(j)  (256  + 64 * (j))
#define XB_XSUB(j)  (1280 + 64 * (j))
#define XB_XGEN(j)  (2304 + 64 * (j))
#define XB_TOP      3328
#define XB_TOPGEN   3392
#define XCD_BAR_WORDS 3456
#define XB_SPIN_CAP (1u << 18)
__device__ __forceinline__ unsigned xb_ld(unsigned* p)              { return __hip_atomic_load(p, __ATOMIC_RELAXED, __HIP_MEMORY_SCOPE_AGENT); }
__device__ __forceinline__ unsigned xb_add(unsigned* p, unsigned v) { return __hip_atomic_fetch_add(p, v, __ATOMIC_RELAXED, __HIP_MEMORY_SCOPE_AGENT); }
__device__ __forceinline__ unsigned xb_xcc_id() { return (unsigned)__builtin_amdgcn_s_getreg((3 << 11) | 20) & 0xFu; }
#define XB_SPIN(cond, bar) do { unsigned _sp = 0; while (cond) { __builtin_amdgcn_s_sleep(1); \
    if ((++_sp & 255u) == 0u) { if (xb_ld(&(bar)[XB_TMO])) break; if (_sp > XB_SPIN_CAP) { atomicAdd(&(bar)[XB_TMO], 1u); break; } } } } while (0)
struct XcdBarrier { unsigned* bar; unsigned x; volatile LAS unsigned* st; };
__device__ __forceinline__ XcdBarrier xcd_barrier_post(unsigned* bar, volatile LAS unsigned* st) {
    XcdBarrier b; b.bar = bar; b.x = xb_xcc_id(); b.st = st;
    if (TIDX() == 0) (void)xb_add(&bar[XB_XCNT(b.x)], 1u);
    return b;
}
__device__ __forceinline__ void xcd_barrier_complete(unsigned* bar, unsigned x, unsigned& nloc, unsigned& nx) {
    const unsigned G = gridDim.x * gridDim.y * gridDim.z;
    unsigned sum, cnt, mine, sp = 0u;
    for (;;) {
        sum = 0u; cnt = 0u; mine = 0u;
#pragma unroll
        for (unsigned j = 0; j < 16; ++j) { const unsigned c = xb_ld(&bar[XB_XCNT(j)]); sum += c; cnt += (c > 0u) ? 1u : 0u; mine = (j == x) ? c : mine; }
        if (sum == G) break;
        __builtin_amdgcn_s_sleep(1);
        if ((++sp & 255u) == 0u) { if (xb_ld(&bar[XB_TMO])) break; if (sp > XB_SPIN_CAP) { atomicAdd(&bar[XB_TMO], 1u); break; } }
    }
    nloc = mine > 0u ? mine : 1u; nx = cnt > 0u ? cnt : 1u;
}
__device__ __forceinline__ void xcd_barrier(const XcdBarrier& b) {
    asm volatile("s_waitcnt vmcnt(0)" ::: "memory");
    __syncthreads();
    if (TIDX() == 0) {
        unsigned* bar = b.bar;
        __builtin_amdgcn_s_waitcnt(0);
        unsigned nloc = b.st[0], nx = b.st[1];
        if (nloc == 0u) { xcd_barrier_complete(bar, b.x, nloc, nx); b.st[0] = nloc; b.st[1] = nx; }
        const unsigned old = xb_add(&bar[XB_XSUB(b.x)], 1u);
        const unsigned gen = old / nloc;
        if (old + 1u == (gen + 1u) * nloc) {
            __builtin_amdgcn_fence(__ATOMIC_RELEASE, "agent");
            asm volatile("s_waitcnt vmcnt(0)" ::: "memory");
            const unsigned og = xb_add(&bar[XB_TOP], 1u);
            const unsigned tg = og / nx;
            if (og + 1u == (tg + 1u) * nx) xb_add(&bar[XB_TOPGEN], 1u);
            else XB_SPIN(xb_ld(&bar[XB_TOPGEN]) == tg, bar);
            __builtin_amdgcn_fence(__ATOMIC_ACQUIRE, "agent");
            xb_add(&bar[XB_XGEN(b.x)], 1u);
            asm volatile("s_waitcnt vmcnt(0)" ::: "memory");
        } else {
            XB_SPIN(xb_ld(&bar[XB_XGEN(b.x)]) == gen, bar);
            __builtin_amdgcn_fence(__ATOMIC_ACQUIRE, "agent");
            asm volatile("s_waitcnt vmcnt(0)" ::: "memory");
        }
    }
    __syncthreads();
}

constexpr int MA_P2 = 160;
__device__ __forceinline__ void run_phase(const Params& p_, const int ph, const int l, char* lds, const int cslot = 0) {
    Params p = p_;
    asm volatile("" : "+s"(p.ws), "+s"(p.out));
    char* ws = p.ws;
    bf16_t* XB = (bf16_t*)(ws + W_XB); bf16_t* Hb = (bf16_t*)(ws + W_H); bf16_t* RA = (bf16_t*)(ws + W_RA);
    int* ctr = (int*)(ws + W_CTRL);
    switch (ph) {
    case 0: phase_prep(p, lds); break;
    case 1: {
        gemm_phase(XB, (const bf16_t*)(ws + W_WRET), 1024, TT / 256, NRET / 256, lds, EpiBf16{RA, NRET});
        for (int ll = 0; ll < 2; ++ll)
            gemm_phase((const bf16_t*)(ws + W_MB), (const bf16_t*)(ws + W_WMKV) + (size_t)ll * 512 * 1024, 1024, 8, 2, lds,
                       EpiMemKV{p.out + O_MKP + (size_t)ll * 524288, p.out + O_MVP + (size_t)ll * 524288, (bf16_t*)(ws + W_MK) + (size_t)ll * 24 * 65536, (bf16_t*)(ws + W_MVT) + (size_t)ll * 24 * 65536},
                       (1716 % 256 + 16 * ll) % (int)gridDim.x);
    } break;
    case 2: {
        bf16_t* RS = (bf16_t*)(p.out + O_DKP);
        for (;;) {
            const int u = next_unit(ctr + 0 + cslot, lds);
            if (u >= 192 + 384 + MA_P2) break;
            if (u < 576) {
                const bool pr = u < 192; const int us = pr ? u : u - 192, chain = us >> 2, sl = us & 3, b = chain / 6, h = chain % 6;
                ret_chain(p, h, sl, pr ? 64 : 1, pr ? b * 4096 : TP + b * 64, pr ? 0 : 1024, pr ? nullptr : p.in[3] + (size_t)chain * 16384,
                          RS + (pr ? (size_t)chain * 64 : (size_t)(3072 + chain)) * 16384, p.out + (pr ? O_RSP : O_RSS) + (size_t)chain * 16384, lds);
            }
            else mem_attn(p, u - 576, 0, lds);
        }
    } break;
    case 3: {
        for (int u2 = BIDX(); u2 < 1584; u2 += gridDim.x) ret_out(p, u2, lds);
        const int busy = (int)gridDim.x <= 1584 ? 1584 % (int)gridDim.x : 0;
        if (BIDX() >= busy)
            for (;;) { const int u = next_unit(ctr + 2, lds); if (u >= 320 - MA_P2) break; mem_attn(p, MA_P2 + u, 0, lds); }
    } break;
    case 4: gemm_phase(Hb, (const bf16_t*)(ws + W_WO) + (size_t)l * 1024 * 1024, 1024, TT / 256, 4, lds, EpiResid{XB, RA}); break;
    case 5: phase_ln(p, p.in[18] + l * 1024, p.in[19] + l * 1024, RA, Hb, false); break;
    case 6: gemm_phase(Hb, (const bf16_t*)(ws + W_WGU) + (size_t)l * 5632 * 1024, 1024, TT / 256, 22, lds, EpiGU{RA}); break;
    case 7: gemm_phase(RA, (const bf16_t*)(ws + W_WD) + (size_t)l * 1024 * DFF, DFF, TT / 256, 4, lds, EpiResid{Hb, XB}); break;
    case 8: phase_ln(p, p.in[23] + l * 1024, p.in[24] + l * 1024, XB, XB, l == 1); break;
    case 9: {
        { uint2* dst = (uint2*)(ws + W_KBS); const float4* s = (const float4*)p.in[4];
          const int skip = (int)gridDim.x > 80 ? 40 : 0, cb = BIDX() - skip, ncb = (int)gridDim.x - skip;
          const size_t per = 1024ull * 192, gt = (size_t)cb * NTHR + TIDX(), gs = (size_t)ncb * NTHR;
          if (cb >= 0) for (size_t i = gt; i < 16 * per; i += gs) { const size_t b = i / per, rem = i - b * per; const float4 v = s[i]; dst[b * (1088ull * 192) + rem] = make_uint2(pk2(v.x, v.y), pk2(v.z, v.w)); } }
        { const int tid = TIDX(), half = tid >> 8;
          const int skip = (int)gridDim.x > 80 ? 40 : 0, cb = BIDX() - skip, ncb = (int)gridDim.x - skip;
          if (cb >= 0 && cb < 1536) {
              float* tile = (float*)lds + half * 4224; const int tl = tid & 255;
              TrDesc dc = tr_desc9(p, 2 * cb + half); float4 r[4]; tr_load(dc, r, tl);
              for (int it2 = cb; it2 < 1536; it2 += ncb) {
                  const bool has = it2 + ncb < 1536;
                  TrDesc dn = dc; float4 rn[4];
                  if (has) { dn = tr_desc9(p, 2 * (it2 + ncb) + half); tr_load(dn, rn, tl); }
                  tr_finish(dc, r, tile, tl);
                  if (has) { dc = dn;
#pragma unroll
                      for (int i = 0; i < 4; ++i) r[i] = rn[i]; }
              }
          } }
        gemm_phase(XB, (const bf16_t*)(ws + W_WDIFF), 1024, TT / 256, NDIFF / 256, lds,
                   EpiProj1{(bf16_t*)(ws + W_QM), (bf16_t*)(ws + W_KBP), (bf16_t*)(ws + W_KBS), (bf16_t*)(ws + W_VTP), (bf16_t*)(ws + W_VTS), p.out, (const float2*)(ws + W_ROPED)});
    } break;
    case 10: {
        float lam;
        { const int lane = TIDX() & 63; const float a = wave_sum(p.in[11][lane] * p.in[12][lane]), b = wave_sum(p.in[13][lane] * p.in[14][lane]); lam = expf(a) - expf(b) + LAM_INIT; }
        for (;;) {
            const int u = next_unit(ctr + 1 + cslot, lds);
            if (u >= 1536 + 96 + 320) break;
            if (u < 1632) {
                const bool pr = u >= 96; const int up = u - 96, qp = 31 - up / 48, bh = pr ? up % 48 : u, b = bh / 6, h = bh % 6;
                diff_attn(p, pr ? b * 4096 + qp * 128 : TP + b * 64, h,
                          pr ? (const bf16_t*)(ws + W_KBP) + (size_t)b * 4096 * 768 + h * 128 : (const bf16_t*)(ws + W_KBS) + (size_t)b * 1088 * 768 + h * 128,
                          pr ? (const bf16_t*)(ws + W_VTP) + (size_t)bh * 128 * 4096 : (const bf16_t*)(ws + W_VTS) + (size_t)bh * 128 * 1088,
                          pr ? 4096 : 1088, pr ? 2 * qp + 2 : 17, pr ? 2 * qp + 1 : 17, pr, lam, lds);
            }
            else mem_attn(p, u - 1632, 1, lds);
        }
    } break;
    default: break;
    }
}

#ifndef PROBE_PH
#define PROBE_PH -1
#endif
extern "C" __global__ void __launch_bounds__(512, 2) mega_fwd(Params p) {
    extern __shared__ __attribute__((aligned(16))) char lds[];
    cg::grid_group grid = cg::this_grid();
    volatile LAS unsigned* xst = (volatile LAS unsigned*)(lds + LDS_MAIN + 16);
    if (TIDX() == 0) { xst[0] = 0u; xst[1] = 0u; }
    __syncthreads();
    (void)xcd_barrier_post((unsigned*)(p.ws + W_CTRL), xst);
#define XBAR() do { XcdBarrier xb_; xb_.bar = (unsigned*)(p.ws + W_CTRL); xb_.x = xb_xcc_id(); xb_.st = (volatile LAS unsigned*)(lds + LDS_MAIN + 16); xcd_barrier(xb_); } while (0)
    run_phase(p, 0, 0, lds);
    if (p.ph_lo != 0) grid.sync();
    XBAR();
#if PROBE_PH == 0
    run_phase(p, 0, 0, lds); XBAR();
#endif
    run_phase(p, 1, 0, lds); XBAR();
    run_phase(p, 2, 0, lds); XBAR();
#if PROBE_PH == 2
    run_phase(p, 2, 0, lds, 2); XBAR();
#endif
    run_phase(p, 3, 0, lds); XBAR();
#if PROBE_PH == 3
    run_phase(p, 3, 0, lds); XBAR();
#endif
    run_phase(p, 4, 0, lds); XBAR();
    run_phase(p, 5, 0, lds); XBAR();
    run_phase(p, 6, 0, lds); XBAR();
    run_phase(p, 7, 0, lds); XBAR();
    run_phase(p, 8, 0, lds); XBAR();
    run_phase(p, 9, 1, lds); XBAR();
    run_phase(p, 10, 1, lds); XBAR();
    run_phase(p, 4, 1, lds); XBAR();
    run_phase(p, 5, 1, lds); XBAR();
    run_phase(p, 6, 1, lds); XBAR();
    run_phase(p, 7, 1, lds); XBAR();
    run_phase(p, 8, 1, lds);
}

#ifndef PROBE_PH
#define PROBE_PH -1
#endif
#ifndef MULTI_LAUNCH
#define MULTI_LAUNCH 0
#endif
#if MULTI_LAUNCH
extern "C" __global__ void __launch_bounds__(512, 2) phase_kernel(Params p) {
    extern __shared__ __attribute__((aligned(16))) char lds[];
    switch (p.ph_lo) {
    case 0: run_phase(p, 0, 0, lds); break;
    case 1: run_phase(p, 1, 0, lds); break;
    case 2: run_phase(p, 2, 0, lds); break;
    case 3: run_phase(p, 3, 0, lds); break;
    case 4: run_phase(p, 4, p.ph_hi, lds); break;
    case 5: run_phase(p, 5, p.ph_hi, lds); break;
    case 6: run_phase(p, 6, p.ph_hi, lds); break;
    case 7: run_phase(p, 7, p.ph_hi, lds); break;
    case 8: run_phase(p, 8, p.ph_hi, lds); break;
    case 9: run_phase(p, 9, 1, lds); break;
    case 10: run_phase(p, 10, 1, lds); break;
    default: break;
    }
}
#endif

extern "C" void kernel_launch(void* const* d_in, const int* in_sizes, int n_in, void* d_out, int out_size, void* d_ws, size_t ws_size, hipStream_t stream) {
    static int grid = 0;
#if MULTI_LAUNCH
    const void* kfn = (const void*)phase_kernel;
#else
    const void* kfn = (const void*)mega_fwd;
#endif
    if (grid == 0) {
        int dev = 0, cus = 0, per_cu = 0;
        (void)hipGetDevice(&dev);
        (void)hipDeviceGetAttribute(&cus, hipDeviceAttributeMultiprocessorCount, dev);
        (void)hipFuncSetAttribute(kfn, hipFuncAttributeMaxDynamicSharedMemorySize, LDS_BYTES);
        (void)hipOccupancyMaxActiveBlocksPerMultiprocessor(&per_cu, kfn, NTHR, LDS_BYTES);
        if (per_cu < 1) { fprintf(stderr, "kernel_launch: occupancy query reports %d blocks per CU\n", per_cu); per_cu = 1; }
        grid = cus;
        if (ws_size < W_END) { fprintf(stderr, "kernel_launch: workspace too small: %zu < %zu\n", ws_size, (size_t)W_END); grid = -1; }
    }
    if (grid < 0) return;
    (void)hipMemsetAsync((char*)d_ws + W_CTRL, 0, 16384, stream);
    Params p{};
    for (int i = 0; i < 25; ++i) p.in[i] = (const float*)d_in[i];
    p.out = (float*)d_out; p.ws = (char*)d_ws; p.ph_lo = 0; p.ph_hi = 16;
#if MULTI_LAUNCH
    static const int seq[16][2] = {{0,0},{1,0},{2,0},{3,0},{4,0},{5,0},{6,0},{7,0},{8,0},{9,1},{10,1},{4,1},{5,1},{6,1},{7,1},{8,1}};
    for (int i = 0; i < 16; ++i) {
        p.ph_lo = seq[i][0]; p.ph_hi = seq[i][1];
        hipLaunchKernelGGL(phase_kernel, dim3(grid), dim3(NTHR), LDS_BYTES, stream, p);
    }
#else
    void* args[] = {&p};
    hipError_t e = hipLaunchCooperativeKernel(kfn, dim3(grid), dim3(NTHR), args, LDS_BYTES, stream);
    if (e != hipSuccess) fprintf(stderr, "cooperative launch failed: %s (grid %d)\n", hipGetErrorString(e), grid);
#endif
}
```

```cpp
#include <hip/hip_runtime.h>
#include <hip/hip_cooperative_groups.h>
#include <stdint.h>
#include <stdio.h>
namespace cg = cooperative_groups;

typedef unsigned short bf16_t;
typedef short bf16x8 __attribute__((ext_vector_type(8)));
typedef float f32x4 __attribute__((ext_vector_type(4)));
typedef float f32x16 __attribute__((ext_vector_type(16)));
#define LAS __attribute__((address_space(3)))

#define MFMA32(a, b, c) __builtin_amdgcn_mfma_f32_32x32x16_bf16(a, b, c, 0, 0, 0)
#define MFMA16(a, b, c) __builtin_amdgcn_mfma_f32_16x16x32_bf16(a, b, c, 0, 0, 0)

constexpr int TP = 32768, TS = 1024, TT = TP + TS;
constexpr int NRET = 3328, NDIFF = 2560, DFF = 2816;
constexpr float ALPHA = 1.41421356237f;
constexpr float LAM_INIT = 0.35550907f;
constexpr int NTHR = 512;
constexpr int LDS_MAIN = 131072, LDS_BYTES = LDS_MAIN + 256;

constexpr size_t O_YP = 0, O_RSP = 34603008, O_RSS = 35389440, O_DKP = 36962304, O_DVP = 62128128,
                 O_DKS = 87293952, O_DVS = 88080384, O_MKP = 88866816, O_MVP = 89915392;
constexpr size_t W_CTRL = 0;
constexpr size_t W_ROPER = 16384;
constexpr size_t W_ROPED = W_ROPER + 4096ull * 64 * 8;
constexpr size_t W_WRET = W_ROPED + 4096ull * 8 * 8;
constexpr size_t W_WDIFF = W_WRET + (size_t)NRET * 1024 * 2;
constexpr size_t W_WMKV = W_WDIFF + (size_t)NDIFF * 1024 * 2;
constexpr size_t W_WO = W_WMKV + 2ull * 512 * 1024 * 2;
constexpr size_t W_WGU = W_WO + 2ull * 1024 * 1024 * 2;
constexpr size_t W_WD = W_WGU + 2ull * 5632 * 1024 * 2;
constexpr size_t W_MB = W_WD + 2ull * 1024 * 2816 * 2;
constexpr size_t W_MK = W_MB + 2048ull * 1024 * 2;
constexpr size_t W_MVT = W_MK + 2ull * 24 * 65536 * 2;
constexpr size_t W_XB = W_MVT + 2ull * 24 * 65536 * 2;
constexpr size_t W_H = W_XB + (size_t)TT * 1024 * 2;
constexpr size_t W_RA = W_H + (size_t)TT * 1024 * 2;
constexpr size_t W_END = W_RA + (size_t)TT * NRET * 2;
constexpr size_t W_QM = W_RA;
constexpr size_t W_KBP = W_QM + (size_t)TT * 1024 * 2;
constexpr size_t W_KBS = W_KBP + 8ull * 4096 * 768 * 2;
constexpr size_t W_VTP = W_KBS + 16ull * 1088 * 768 * 2;
constexpr size_t W_VTS = W_VTP + 8ull * 6 * 128 * 4096 * 2;
static_assert(W_VTS + 16ull * 6 * 128 * 1088 * 2 <= W_END, "layer-1 overlay too big");

struct Params {
    const float* in[25];
    float* out;
    char* ws;
    int ph_lo, ph_hi;
};

__device__ __forceinline__ int TIDX() { int t = threadIdx.x; asm volatile("" : "+v"(t)); return t; }
__device__ __forceinline__ int BIDX() { int t = blockIdx.x; asm volatile("" : "+s"(t)); return t; }
typedef __bf16 bf2_t __attribute__((ext_vector_type(2)));
typedef float f2_t __attribute__((ext_vector_type(2)));
__device__ __forceinline__ uint32_t pk2(float lo, float hi) { f2_t f = {lo, hi}; bf2_t b = __builtin_convertvector(f, bf2_t); return *(uint32_t*)&b; }
__device__ __forceinline__ bf16_t f2bf(float f) { return (bf16_t)(pk2(f, 0.f) & 0xffffu); }
__device__ __forceinline__ float bf2f(bf16_t b) { return __uint_as_float(((uint32_t)b) << 16); }
__device__ __forceinline__ float bflo(uint32_t u) { return __uint_as_float(u << 16); }
__device__ __forceinline__ float bfhi(uint32_t u) { return __uint_as_float(u & 0xffff0000u); }
__device__ __forceinline__ bf16x8 mk8(uint32_t a, uint32_t b, uint32_t c, uint32_t d) { uint4 u = make_uint4(a, b, c, d); return *(bf16x8*)&u; }
__device__ __forceinline__ bf16x8 pack8(f32x4 a, f32x4 b) { return mk8(pk2(a[0], a[1]), pk2(a[2], a[3]), pk2(b[0], b[1]), pk2(b[2], b[3])); }
__device__ __forceinline__ bf16x8 ld8(const bf16_t* p) { return *(const bf16x8*)p; }
__device__ __forceinline__ bf16x8 ld44(const bf16_t* lo, const bf16_t* hi) { uint2 a = *(const uint2*)lo, b = *(const uint2*)hi; return mk8(a.x, a.y, b.x, b.y); }
__device__ __forceinline__ float xr16_32_max(float v) { v = fmaxf(v, __shfl_xor(v, 16)); v = fmaxf(v, __shfl_xor(v, 32)); return v; }
__device__ __forceinline__ float xr16_32_sum(float v) { v += __shfl_xor(v, 16); v += __shfl_xor(v, 32); return v; }
__device__ __forceinline__ float wave_sum(float v) { for (int o = 1; o < 64; o <<= 1) v += __shfl_xor(v, o); return v; }
__device__ __forceinline__ void unpack8(uint4 u, float* f) { f[0] = bflo(u.x); f[1] = bfhi(u.x); f[2] = bflo(u.y); f[3] = bfhi(u.y); f[4] = bflo(u.z); f[5] = bfhi(u.z); f[6] = bflo(u.w); f[7] = bfhi(u.w); }
__device__ __forceinline__ float silu(float x) { return x / (1.f + __expf(-x)); }

constexpr int G_BK = 64, G_HT = 128 * 64;
__device__ __forceinline__ int lds_byte(int r, int c) { const int st = (r >> 4) * 2 + (c >> 5), rr = r & 15, cc = c & 31, ob = rr * 64 + cc * 2; return st * 1024 + (ob ^ (((ob >> 9) & 1) << 5)); }
__device__ __forceinline__ void stage_rc(int b, int& R, int& C) { const int st = b / 1024, sb = b % 1024, swz = sb ^ (((sb >> 9) & 1) << 5); R = (st >> 1) * 16 + swz / 64; C = (st & 1) * 32 + (swz % 64) / 2; }

template <class Epi>
__device__ __forceinline__ void gemm256_tile(const bf16_t* __restrict__ A, const bf16_t* __restrict__ Bt, const int K, const int brow, const int bcol, const bool pre, const int nrow, const int ncol, char* lds, const Epi& epi) {
    bf16_t* shm = (bf16_t*)lds;
#define SA(b, h) (shm + ((b) * 2 + (h)) * G_HT)
#define SB(b, h) (shm + (4 + (b) * 2 + (h)) * G_HT)
#define STAGE(P, BASE, br, kt) do { const long _g = (long)(br) * K + (long)(kt) * G_BK; \
    _Pragma("unroll") for (int _i = 0; _i < 2; ++_i) { const int _b = tid * 16 + _i * 8192; int _r, _c; stage_rc(_b, _r, _c); \
      __builtin_amdgcn_global_load_lds((const unsigned*)(BASE + _g + (long)_r * K + _c), (__attribute__((address_space(3))) unsigned*)((char*)(P) + _b), 16, 0, 0); } } while (0)
#define LDA(dst, b, h) _Pragma("unroll") for (int m = 0; m < 4; ++m) _Pragma("unroll") for (int k = 0; k < 2; ++k) \
    dst[m][k] = *reinterpret_cast<const bf16x8*>((char*)SA(b, h) + lds_byte(wr * 64 + m * 16 + fr, k * 32 + fq * 8))
#define LDB(dst, b, h) _Pragma("unroll") for (int n = 0; n < 2; ++n) _Pragma("unroll") for (int k = 0; k < 2; ++k) \
    dst[n][k] = *reinterpret_cast<const bf16x8*>((char*)SB(b, h) + lds_byte(wc * 32 + n * 16 + fr, k * 32 + fq * 8))
#define MMA(ai, bj, At_, Bt_) do { __builtin_amdgcn_s_setprio(1); \
    _Pragma("unroll") for (int m = 0; m < 4; ++m) _Pragma("unroll") for (int n = 0; n < 2; ++n) _Pragma("unroll") for (int k = 0; k < 2; ++k) \
      acc[ai][bj][m][n] = MFMA16(Bt_[n][k], At_[m][k], acc[ai][bj][m][n]); \
    __builtin_amdgcn_s_setprio(0); } while (0)
#define WAIT_V(n) asm volatile("s_waitcnt vmcnt(" #n ")" ::: "memory")
#define WAIT_L(n) asm volatile("s_waitcnt lgkmcnt(" #n ")" ::: "memory")
#define BAR __builtin_amdgcn_s_barrier()
#define SCHED __builtin_amdgcn_sched_barrier(0)
    const int tid = TIDX();
    const int wid = tid >> 6, lane = tid & 63, wr = wid >> 2, wc = wid & 3, fr = lane & 15, fq = lane >> 4;
    constexpr int HALF = 128;
    f32x4 acc[2][2][4][2];
#pragma unroll
    for (int a = 0; a < 2; ++a)
#pragma unroll
        for (int b = 0; b < 2; ++b)
#pragma unroll
            for (int m = 0; m < 4; ++m)
#pragma unroll
                for (int n = 0; n < 2; ++n) acc[a][b][m][n] = (f32x4){0.f, 0.f, 0.f, 0.f};
    bf16x8 At[4][2], B0[2][2], B1[2][2];
    const int nt = K / G_BK;
    asm volatile("s_waitcnt vmcnt(0) lgkmcnt(0)" ::: "memory");
    __syncthreads();
    if (!pre) {
        STAGE(SB(0, 0), Bt, bcol, 0); STAGE(SA(0, 0), A, brow, 0);
        STAGE(SB(0, 1), Bt, bcol + HALF, 0); STAGE(SA(0, 1), A, brow + HALF, 0);
    }
    if (wr == 1) BAR;
    WAIT_V(4); BAR;
    STAGE(SB(1, 0), Bt, bcol, 1); STAGE(SA(1, 0), A, brow, 1); STAGE(SB(1, 1), Bt, bcol + HALF, 1);
    WAIT_V(6); BAR;
    for (int t = 0; t < nt - 2; t += 2) {
        LDB(B0, 0, 0); SCHED; LDA(At, 0, 0); STAGE(SA(1, 1), A, brow + HALF, t + 1);
        WAIT_L(8); BAR; WAIT_L(0); MMA(0, 0, At, B0); BAR; SCHED;
        LDB(B1, 0, 1); STAGE(SB(0, 0), Bt, bcol, t + 2);
        BAR; WAIT_L(0); MMA(0, 1, At, B1); BAR;
        LDA(At, 0, 1); STAGE(SA(0, 0), A, brow, t + 2);
        BAR; WAIT_L(0); MMA(1, 0, At, B0); BAR; SCHED;
        STAGE(SB(0, 1), Bt, bcol + HALF, t + 2);
        WAIT_V(6); BAR; MMA(1, 1, At, B1); BAR;
        LDB(B0, 1, 0); SCHED; LDA(At, 1, 0); STAGE(SA(0, 1), A, brow + HALF, t + 2);
        WAIT_L(8); BAR; WAIT_L(0); MMA(0, 0, At, B0); BAR; SCHED;
        LDB(B1, 1, 1); STAGE(SB(1, 0), Bt, bcol, t + 3);
        BAR; WAIT_L(0); MMA(0, 1, At, B1); BAR;
        LDA(At, 1, 1); STAGE(SA(1, 0), A, brow, t + 3);
        BAR; WAIT_L(0); MMA(1, 0, At, B0); BAR; SCHED;
        STAGE(SB(1, 1), Bt, bcol + HALF, t + 3);
        WAIT_V(6); BAR; MMA(1, 1, At, B1); BAR;
    }
    { LDB(B0, 0, 0); LDA(At, 0, 0); STAGE(SA(1, 1), A, brow + HALF, nt - 1);
      BAR; WAIT_L(0); MMA(0, 0, At, B0); BAR;
      LDB(B1, 0, 1); BAR; WAIT_L(0); MMA(0, 1, At, B1); BAR;
      LDA(At, 0, 1); WAIT_V(4); BAR; WAIT_L(0); MMA(1, 0, At, B0); MMA(1, 1, At, B1); BAR; }
    { LDB(B0, 1, 0); LDA(At, 1, 0); WAIT_V(2); BAR; WAIT_L(0); MMA(0, 0, At, B0); BAR;
      LDB(B1, 1, 1); WAIT_V(0); BAR; WAIT_L(0); MMA(0, 1, At, B1); BAR;
      LDA(At, 1, 1); BAR; WAIT_L(0); MMA(1, 0, At, B0); MMA(1, 1, At, B1); BAR; }
    if (wr == 0) BAR;
    if (nrow >= 0) {
        STAGE(SB(0, 0), Bt, ncol, 0); STAGE(SA(0, 0), A, nrow, 0);
        STAGE(SB(0, 1), Bt, ncol + HALF, 0); STAGE(SA(0, 1), A, nrow + HALF, 0);
    }
    epi(acc, brow, bcol, wr, wc, fr, fq);
#undef SA
#undef SB
#undef STAGE
#undef LDA
#undef LDB
#undef MMA
}

__device__ __forceinline__ bool gemm_tile_coord(int i, int G, int c, int nM, int nN, int& pm, int& pn) {
    const int nwg = nM * nN; const long L = (long)i * G + c; if (L >= nwg) return false;
    int wgid = (int)L; { const int q = nwg / 8, r = nwg % 8, xcd = wgid % 8, off = wgid / 8; wgid = (xcd < r ? xcd * (q + 1) : r * (q + 1) + (xcd - r) * q) + off; }
    const int nig = 8 * nN, gid = wgid / nig, fm = gid * 8, gsz = (nM - fm) < 8 ? (nM - fm) : 8;
    pm = fm + ((wgid % nig) % gsz); pn = (wgid % nig) / gsz; return true;
}
template <class Epi>
__device__ __forceinline__ void gemm_phase(const bf16_t* A, const bf16_t* Bt, int K, int nM, int nN, char* lds, const Epi& epi, const int coff = 0) {
    const int G = gridDim.x, c = (BIDX() + G - coff) % G;
    int pm, pn; bool have = gemm_tile_coord(0, G, c, nM, nN, pm, pn), pre = false;
    for (int i = 0; have; ++i) {
        int qm = 0, qn = 0; const bool nxt = gemm_tile_coord(i + 1, G, c, nM, nN, qm, qn);
        gemm256_tile(A, Bt, K, pm * 256, pn * 256, pre, (Epi::PRESTAGE && nxt) ? qm * 256 : -1, qn * 256, lds, epi);
        pre = Epi::PRESTAGE && nxt; have = nxt; pm = qm; pn = qn;
    }
}

#define EPI_ARGS f32x4 (&acc)[2][2][4][2], int brow, int bcol, int wr, int wc, int fr, int fq
#define EPI_LOOP _Pragma("unroll") for (int ai = 0; ai < 2; ++ai) _Pragma("unroll") for (int bj = 0; bj < 2; ++bj) _Pragma("unroll") for (int m = 0; m < 4; ++m) _Pragma("unroll") for (int n = 0; n < 2; ++n)
#define EPI_ROW (brow + 128 * ai + 64 * wr + 16 * m + fr)
#define EPI_COL (bcol + 128 * bj + 32 * wc + 16 * n + 4 * fq)

__device__ __forceinline__ int vperm(int s) { return (s & ~31) | (((s >> 2) & 3) << 3) | (((s >> 4) & 1) << 2) | (s & 3); }
struct EpiBf16 {
    static constexpr bool PRESTAGE = true;
    bf16_t* C; int ldc;
    __device__ __forceinline__ void operator()(EPI_ARGS) const {
        EPI_LOOP { const f32x4 v = acc[ai][bj][m][n]; *(uint2*)(C + (size_t)EPI_ROW * ldc + EPI_COL) = make_uint2(pk2(v[0], v[1]), pk2(v[2], v[3])); }
    }
};
struct EpiMemKV {
    static constexpr bool PRESTAGE = false;
    float* outk; float* outv; bf16_t* mk; bf16_t* mvt;
    __device__ __forceinline__ void operator()(EPI_ARGS) const {
        EPI_LOOP {
            const int row = EPI_ROW, col = EPI_COL; const f32x4 v = acc[ai][bj][m][n];
            if (bcol == 0) { *(f32x4*)(outk + (size_t)row * 256 + col) = v; *(uint2*)(mk + (size_t)row * 256 + col) = make_uint2(pk2(v[0], v[1]), pk2(v[2], v[3])); }
            else { const int c = col - 256, b = row >> 8, mm = row & 255; *(f32x4*)(outv + (size_t)row * 256 + c) = v;
#pragma unroll
                for (int q = 0; q < 4; ++q) mvt[(size_t)((b * 4 + (c >> 6)) * 64 + (c & 63) + q) * 256 + mm] = f2bf(v[q]); }
        }
    }
};
struct EpiResid {
    static constexpr bool PRESTAGE = false;
    const bf16_t* X; bf16_t* Zb;
    __device__ __forceinline__ void operator()(EPI_ARGS) const {
#pragma unroll
        for (int ai = 0; ai < 2; ++ai)
#pragma unroll
            for (int bj = 0; bj < 2; ++bj) {
#pragma unroll
                for (int m = 0; m < 4; ++m)
#pragma unroll
                    for (int n = 0; n < 2; ++n) { const unsigned o = (unsigned)EPI_ROW * 1024u + (unsigned)EPI_COL; const uint2 x = *(const uint2*)(X + o); const f32x4 v = acc[ai][bj][m][n];
                        *(uint2*)(Zb + o) = make_uint2(pk2(ALPHA * bflo(x.x) + v[0], ALPHA * bfhi(x.x) + v[1]), pk2(ALPHA * bflo(x.y) + v[2], ALPHA * bfhi(x.y) + v[3])); }
                __builtin_amdgcn_sched_barrier(0);
            }
    }
};
struct EpiGU {
    static constexpr bool PRESTAGE = false;
    bf16_t* ACT;
    __device__ __forceinline__ void operator()(EPI_ARGS) const {
#pragma unroll
        for (int ai = 0; ai < 2; ++ai)
#pragma unroll
            for (int bj = 0; bj < 2; ++bj)
#pragma unroll
                for (int m = 0; m < 4; ++m) {
                    const int row = brow + 128 * ai + 64 * wr + 16 * m + fr, ocol = (bcol >> 1) + 64 * bj + 16 * wc + 4 * fq;
                    const f32x4 gt = acc[ai][bj][m][0], up = acc[ai][bj][m][1];
                    *(uint2*)(ACT + (size_t)row * DFF + ocol) = make_uint2(pk2(silu(gt[0]) * up[0], silu(gt[1]) * up[1]), pk2(silu(gt[2]) * up[2], silu(gt[3]) * up[3]));
                    __builtin_amdgcn_sched_barrier(0);
                }
    }
};
struct EpiProj1 {
    static constexpr bool PRESTAGE = false;
    bf16_t* QM; bf16_t* KBP; bf16_t* KBS; bf16_t* VTP; bf16_t* VTS; float* out; const float2* ropeD;
    __device__ __forceinline__ void operator()(EPI_ARGS) const {
        EPI_LOOP {
            const int row = EPI_ROW, col = EPI_COL;
            f32x4 v = acc[ai][bj][m][n];
            const int region = col < 768 ? 0 : (col < 1536 ? 1 : (col < 2304 ? 2 : 3));
            if (region <= 1) {
                const bool rot = ((wc & 1) == 0) && (n == 0);
                if (rot) {
                    f32x4 pr; pr[0] = __shfl_xor(v[0], 32); pr[1] = __shfl_xor(v[1], 32); pr[2] = __shfl_xor(v[2], 32); pr[3] = __shfl_xor(v[3], 32);
                    const int pos = row < TP ? (row & 4095) : 1024 + ((row - TP) & 63);
                    const float4* cs = (const float4*)(ropeD + pos * 8 + 4 * (fq & 1));
                    const float4 c01 = cs[0], c23 = cs[1];
                    const float cc[4] = {c01.x, c01.z, c23.x, c23.z}, sn[4] = {c01.y, c01.w, c23.y, c23.w};
#pragma unroll
                    for (int q = 0; q < 4; ++q) v[q] = fq < 2 ? v[q] * cc[q] - pr[q] * sn[q] : pr[q] * sn[q] + v[q] * cc[q];
                }
                const uint2 pk = make_uint2(pk2(v[0], v[1]), pk2(v[2], v[3]));
                if (region == 0) *(uint2*)(QM + (size_t)row * 1024 + col) = pk;
                else {
                    const int kc = col - 768;
                    if (row < TP) { *(uint2*)(KBP + (size_t)row * 768 + kc) = pk; *(f32x4*)(out + O_DKP + (size_t)row * 768 + kc) = v; }
                    else { const int rs = row - TP, b = rs >> 6, s = rs & 63; *(uint2*)(KBS + (size_t)(b * 1088 + 1024 + s) * 768 + kc) = pk; *(f32x4*)(out + O_DKS + (size_t)rs * 768 + kc) = v; }
                }
            } else if (region == 2) {
                const int vc = col - 1536, h = vc >> 7, dim = vc & 127;
                if (row < TP) {
                    const int b = row >> 12, s = row & 4095;
                    *(f32x4*)(out + O_DVP + (size_t)row * 768 + vc) = v;
#pragma unroll
                    for (int q = 0; q < 4; ++q) VTP[((size_t)(b * 6 + h) * 128 + dim + q) * 4096 + vperm(s)] = f2bf(v[q]);
                } else {
                    const int rs = row - TP, b = rs >> 6, s = rs & 63;
                    *(f32x4*)(out + O_DVS + (size_t)rs * 768 + vc) = v;
#pragma unroll
                    for (int q = 0; q < 4; ++q) VTS[((size_t)(b * 6 + h) * 128 + dim + q) * 1088 + 1024 + vperm(s)] = f2bf(v[q]);
                }
            } else {
                *(uint2*)(QM + (size_t)row * 1024 + 768 + (col - 2304)) = make_uint2(pk2(v[0], v[1]), pk2(v[2], v[3]));
            }
        }
    }
};

struct TrDesc { const float* src; bf16_t* dst; int lds_, ldd, k0, n0, mode, which; };
__device__ __forceinline__ void tr_load(const TrDesc& d, float4 (&r)[4], int tid) {
#pragma unroll
    for (int i = 0; i < 4; ++i) { const int k = (tid >> 4) + 16 * i, n4 = (tid & 15) * 4; r[i] = *(const float4*)(d.src + (size_t)(d.k0 + k) * d.lds_ + d.n0 + n4); }
}
__device__ __forceinline__ void tr_finish(const TrDesc& d, const float4 (&r)[4], float* tile, int tid) {
#pragma unroll
    for (int i = 0; i < 4; ++i) { const int k = (tid >> 4) + 16 * i, n4 = (tid & 15) * 4; float* t = tile + k * 65 + n4; t[0] = r[i].x; t[1] = r[i].y; t[2] = r[i].z; t[3] = r[i].w; }
    __syncthreads();
    const int n = tid >> 2, kq = (tid & 3) * 16;
    uint32_t w[8];
#pragma unroll
    for (int q = 0; q < 8; ++q) w[q] = pk2(tile[(kq + 2 * q) * 65 + n], tile[(kq + 2 * q + 1) * 65 + n]);
    const int c = d.n0 + n;
    const int row = d.mode != 1 ? c : (256 * (c >> 7) + 128 * ((c >> 6) & 1) + 32 * ((c >> 4) & 3) + 16 * d.which + (c & 15));
    if (d.mode == 2) {
        const int kk = d.k0 + kq, blk = kk & ~31, hi = (kk >> 4) & 1;
        bf16_t* o = d.dst + (size_t)c * d.ldd + blk + 4 * hi;
#pragma unroll
        for (int gg = 0; gg < 4; ++gg) *(uint2*)(o + 8 * gg) = make_uint2(w[2 * gg], w[2 * gg + 1]);
    } else {
        uint4* o = (uint4*)(d.dst + (size_t)row * d.ldd + d.k0 + kq);
        o[0] = make_uint4(w[0], w[1], w[2], w[3]); o[1] = make_uint4(w[4], w[5], w[6], w[7]);
    }
    __syncthreads();
}
__device__ __forceinline__ TrDesc tr_desc0(const Params& p, int it) {
    char* ws = p.ws;
    constexpr int T0 = 832, T1 = T0 + 640, T2 = T1 + 256, T3 = T2 + 512, T4 = T3 + 1408, T5 = T4 + 1408;
    if (it < T0) { const int kt = it / 52, nt = it % 52; return TrDesc{p.in[8], (bf16_t*)(ws + W_WRET), NRET, 1024, kt * 64, nt * 64, 0, 0}; }
    if (it < T1) { const int r = it - T0, kt = r / 40, nt = r % 40; return TrDesc{p.in[10], (bf16_t*)(ws + W_WDIFF), NDIFF, 1024, kt * 64, nt * 64, 0, 0}; }
    if (it < T2) { const int r = it - T1, l = r >> 7, q = r & 127, kt = q >> 3, nt = q & 7; return TrDesc{p.in[16] + (size_t)l * 1024 * 512, (bf16_t*)(ws + W_WMKV) + (size_t)l * 512 * 1024, 512, 1024, kt * 64, nt * 64, 0, 0}; }
    if (it < T3) { const int r = it - T2, l = r >> 8, q = r & 255, kt = q >> 4, nt = q & 15; return TrDesc{p.in[17] + (size_t)l * 1024 * 1024, (bf16_t*)(ws + W_WO) + (size_t)l * 1024 * 1024, 1024, 1024, kt * 64, nt * 64, 0, 0}; }
    if (it < T5) { const int wh = it >= T4; const int r = it - (wh ? T4 : T3), l = r / 704, q = r % 704, kt = q / 44, nt = q % 44;
        return TrDesc{p.in[wh ? 21 : 20] + (size_t)l * 1024 * DFF, (bf16_t*)(ws + W_WGU) + (size_t)l * 5632 * 1024, DFF, 1024, kt * 64, nt * 64, 1, wh}; }
    { const int r = it - T5, l = r / 704, q = r % 704, kt = q >> 4, nt = q & 15; return TrDesc{p.in[22] + (size_t)l * DFF * 1024, (bf16_t*)(ws + W_WD) + (size_t)l * 1024 * DFF, 1024, DFF, kt * 64, nt * 64, 0, 0}; }
}
__device__ __forceinline__ TrDesc tr_desc9(const Params& p, int it) {
    const int bh = it >> 5, q = it & 31, jt = q >> 1, dt = q & 1, b = bh / 6, h = bh % 6;
    return TrDesc{p.in[5] + (size_t)b * 1024 * 768 + h * 128, (bf16_t*)(p.ws + W_VTS) + (size_t)bh * 128 * 1088, 768, 1088, jt * 64, dt * 64, 2, 0};
}

__device__ __forceinline__ void phase_prep(const Params& p, char* lds) {
    char* ws = p.ws;
    const int nb = gridDim.x, bid = BIDX(), tid = TIDX(), half = tid >> 8, tl = tid & 255;
    float* tile = (float*)lds + half * 4224;
    constexpr int T6 = 832 + 640 + 256 + 512 + 3 * 1408;
    if (bid < T6 / 2) {
        TrDesc dc = tr_desc0(p, 2 * bid + half); float4 r[4]; tr_load(dc, r, tl);
        for (int it2 = bid; it2 < T6 / 2; it2 += nb) {
            const bool has = it2 + nb < T6 / 2;
            TrDesc dn = dc; float4 rn[4];
            if (has) { dn = tr_desc0(p, 2 * (it2 + nb) + half); tr_load(dn, rn, tl); }
            tr_finish(dc, r, tile, tl);
            if (has) { dc = dn;
#pragma unroll
                for (int i = 0; i < 4; ++i) r[i] = rn[i]; }
        }
    }
    const size_t gt = (size_t)bid * NTHR + tid, gs = (size_t)nb * NTHR;
    { uint2* dst = (uint2*)(ws + W_XB); const float4* xp = (const float4*)p.in[0]; const float4* xs = (const float4*)p.in[1];
      const size_t n4 = (size_t)TT * 256, np4 = (size_t)TP * 256;
      for (size_t i = gt; i < n4; i += gs) { const float4 v = i < np4 ? xp[i] : xs[i - np4]; dst[i] = make_uint2(pk2(v.x, v.y), pk2(v.z, v.w)); } }
    { uint2* dst = (uint2*)(ws + W_MB); const float4* s = (const float4*)p.in[2];
      for (size_t i = gt; i < 2048ull * 256; i += gs) { const float4 v = s[i]; dst[i] = make_uint2(pk2(v.x, v.y), pk2(v.z, v.w)); } }
    { uint2* dst = (uint2*)(ws + W_MK); const float4* s = (const float4*)p.in[6];
      for (size_t i = gt; i < 2ull * 16 * 16384; i += gs) { const size_t l = i / (16 * 16384), rem = i - l * 16 * 16384; const float4 v = s[i]; dst[(l * 24 + 8) * 16384 + rem] = make_uint2(pk2(v.x, v.y), pk2(v.z, v.w)); } }
    { bf16_t* dst = (bf16_t*)(ws + W_MVT); const float* s = p.in[7];
      for (size_t i = gt; i < 2ull * 16 * 65536; i += gs) {
          const int m = i & 255, dim = (i >> 8) & 63, h = (i >> 14) & 3, b = (i >> 16) & 15, l = (int)(i >> 20);
          dst[((size_t)((l * 24 + 8 + b) * 4 + h) * 64 + dim) * 256 + m] = f2bf(s[((size_t)(l * 16 + b) * 256 + m) * 256 + h * 64 + dim]); } }
    { float2* rr = (float2*)(ws + W_ROPER); float2* rd = (float2*)(ws + W_ROPED);
      for (size_t i = gt; i < 4096ull * 64; i += gs) { const int pos = (int)(i >> 6), f = (int)(i & 63); const float inv = expf(-logf(10000.f) * (float)f * 2.0f / 128.f); float sn, cs; sincosf((float)pos * inv, &sn, &cs); rr[i] = make_float2(cs, sn); }
      for (size_t i = gt; i < 4096ull * 8; i += gs) { const int pos = (int)(i >> 3), f = (int)(i & 7); const float inv = expf(-logf(500000.f) * (float)f * 2.0f / 16.f); float sn, cs; sincosf((float)pos * inv, &sn, &cs); rd[i] = make_float2(cs, sn); } }
    if (bid == 0 && tid < 64) ((int*)(ws + W_CTRL))[tid] = 0;
}

__device__ __forceinline__ void ret_chain(const Params& p, int h, int sl, int nsteps, int rowbase, int posbase, const float* init, bf16_t* rs, float* fin, char* lds) {
    const int tid = TIDX(), lane = tid & 63, w = tid >> 6, g = lane >> 4, lc = lane & 15;
    const float log_g = logf(1.f - exp2f(-5.f - (float)h));
    const float gch = expf(64.f * log_g);
    const float kscale = 0.08838834764831845f;
    const bf16_t* proj = (const bf16_t*)(p.ws + W_RA);
    const float2* ropeR = (const float2*)(p.ws + W_ROPER);
    f32x4 acc[2];
#pragma unroll
    for (int jj = 0; jj < 2; ++jj)
#pragma unroll
        for (int r = 0; r < 4; ++r) { const int d = 16 * w + 4 * g + r, e = sl * 32 + 16 * jj + lc; acc[jj][r] = init ? init[d * 128 + e] : 0.f; }
    const float zeta = expf((float)(63 - (tid >> 3)) * log_g) * kscale;
    uint4 ka0, kb0, vv0, ka1, kb1, vv1, ka2, kb2, vv2, ka3, kb3, vv3;
    float4 ca0[4], ca1[4], ca2[4], ca3[4];
    const int kj = tid >> 3, kdg = tid & 7, vj = (tid >> 2) & 63, veg = tid & 3;
    const int kjs = kj ^ (kdg << 3), vjs = vj ^ (veg << 4);
#define RC_LOAD(c_, K1, K2, VV, CS) do { const bf16_t* s_ = proj + (size_t)(rowbase + (c_) * 64 + kj) * NRET + 768 + h * 128 + kdg * 8; K1 = *(const uint4*)s_; K2 = *(const uint4*)(s_ + 64); \
        { const float4* cs_ = (const float4*)(ropeR + (size_t)(posbase + (c_) * 64 + kj) * 64 + kdg * 8); CS[0] = cs_[0]; CS[1] = cs_[1]; CS[2] = cs_[2]; CS[3] = cs_[3]; } \
        VV = *(const uint4*)(proj + (size_t)(rowbase + (c_) * 64 + vj) * NRET + 1536 + h * 128 + sl * 32 + veg * 8); } while (0)
#define RC_STEP(c_, K1, K2, VV, CS) if ((c_) < nsteps) { const int c = (c_); \
        bf16_t* Kt = (bf16_t*)(lds + (c & 1) * 18432); \
        bf16_t* Vt = (bf16_t*)(lds + 36864 + (c & 1) * 4608); \
        { \
            float x1[8], x2[8]; unpack8(K1, x1); unpack8(K2, x2); \
            _Pragma("unroll") for (int e2 = 0; e2 < 4; ++e2) { \
                const float4 t = CS[e2]; \
                { const float a = x1[2 * e2], b = x2[2 * e2]; Kt[(kdg * 8 + 2 * e2) * 72 + kjs] = f2bf((a * t.x - b * t.y) * zeta); Kt[(64 + kdg * 8 + 2 * e2) * 72 + kjs] = f2bf((a * t.y + b * t.x) * zeta); } \
                { const float a = x1[2 * e2 + 1], b = x2[2 * e2 + 1]; Kt[(kdg * 8 + 2 * e2 + 1) * 72 + kjs] = f2bf((a * t.z - b * t.w) * zeta); Kt[(64 + kdg * 8 + 2 * e2 + 1) * 72 + kjs] = f2bf((a * t.w + b * t.z) * zeta); } \
            } \
        } \
        if (tid < 256) { const uint32_t u[4] = {VV.x, VV.y, VV.z, VV.w}; \
          _Pragma("unroll") for (int e2 = 0; e2 < 4; ++e2) { Vt[(veg * 8 + 2 * e2) * 72 + vjs] = (bf16_t)(u[e2] & 0xffff); Vt[(veg * 8 + 2 * e2 + 1) * 72 + vjs] = (bf16_t)(u[e2] >> 16); } } \
        if (c + 4 < nsteps) RC_LOAD(c + 4, K1, K2, VV, CS); \
        __syncthreads(); \
        bf16_t* rsc = rs + (size_t)c * 16384; \
        _Pragma("unroll") for (int jj = 0; jj < 2; ++jj) { \
            const int d = 16 * w + 4 * g, e = sl * 32 + 16 * jj + lc; \
            *(uint2*)(rsc + e * 128 + d) = make_uint2(pk2(acc[jj][0], acc[jj][1]), pk2(acc[jj][2], acc[jj][3])); \
            acc[jj] = acc[jj] * gch; \
        } \
        _Pragma("unroll") for (int s = 0; s < 2; ++s) { \
            const bf16x8 a = ld8(Kt + (16 * w + lc) * 72 + ((4 * s + g) ^ ((2 * w + (lc >> 3)) & 7)) * 8); \
            _Pragma("unroll") for (int jj = 0; jj < 2; ++jj) acc[jj] = MFMA16(a, ld8(Vt + (16 * jj + lc) * 72 + ((4 * s + g) ^ (((2 * jj + (lc >> 3)) & 3) << 1)) * 8), acc[jj]); \
        } \
    }
    RC_LOAD(0, ka0, kb0, vv0, ca0);
    if (1 < nsteps) RC_LOAD(1, ka1, kb1, vv1, ca1);
    if (2 < nsteps) RC_LOAD(2, ka2, kb2, vv2, ca2);
    if (3 < nsteps) RC_LOAD(3, ka3, kb3, vv3, ca3);
    for (int c4 = 0; c4 < nsteps; c4 += 4) {
        RC_STEP(c4, ka0, kb0, vv0, ca0)
        RC_STEP(c4 + 1, ka1, kb1, vv1, ca1)
        RC_STEP(c4 + 2, ka2, kb2, vv2, ca2)
        RC_STEP(c4 + 3, ka3, kb3, vv3, ca3)
    }
#pragma unroll
    for (int jj = 0; jj < 2; ++jj)
#pragma unroll
        for (int r = 0; r < 4; ++r) { const int d = 16 * w + 4 * g + r, e = sl * 32 + 16 * jj + lc; fin[d * 128 + e] = acc[jj][r]; }
    __syncthreads();
#undef RC_LOAD
#undef RC_STEP
}
__device__ __forceinline__ void ret_out(const Params& p, int u2, char* lds_) {
    const int tid_ = TIDX(), half = tid_ >> 8, tid = tid_ & 255, lane = tid & 63, w = tid >> 6, g = lane >> 4, lc = lane & 15;
    const int u = 2 * u2 + half; char* lds = lds_ + half * 53248;
    int b, h, rowbase, pos0;
    if (u < 3072) { const int chain = u >> 6, c = u & 63; b = chain / 6; h = chain % 6; rowbase = b * 4096 + c * 64; pos0 = c * 64; }
    else { const int cs = u - 3072; b = cs / 6; h = cs % 6; rowbase = TP + b * 64; pos0 = 1024; }
    const float log_g = logf(1.f - exp2f(-5.f - (float)h));
    const float log2g = log_g * 1.44269504089f;
    const float kscale = 0.08838834764831845f;
    const bf16_t* proj = (const bf16_t*)(p.ws + W_RA);
    const float2* ropeR = (const float2*)(p.ws + W_ROPER);
    const bf16_t* rsu = (const bf16_t*)(p.out + O_DKP) + (size_t)u * 16384;
    bf16_t* H = (bf16_t*)(p.ws + W_H);
    bf16_t* Qs = (bf16_t*)lds; bf16_t* Ks = (bf16_t*)(lds + 17408); bf16_t* Vt = (bf16_t*)(lds + 34816);
#pragma unroll
    for (int q = 0; q < 2; ++q) {
        const int it = tid + 256 * q, j = it >> 3, dg = it & 7;
        const bf16_t* s = proj + (size_t)(rowbase + j) * NRET + h * 128 + dg * 8;
        const uint4 q1 = *(const uint4*)s, q2 = *(const uint4*)(s + 64), kk1 = *(const uint4*)(s + 768), kk2 = *(const uint4*)(s + 768 + 64);
        const float4* cs = (const float4*)(ropeR + (size_t)(pos0 + j) * 64 + dg * 8);
        float a1[8], a2[8], b1[8], b2[8]; unpack8(q1, a1); unpack8(q2, a2); unpack8(kk1, b1); unpack8(kk2, b2);
        float qo1[8], qo2[8], ko1[8], ko2[8];
#pragma unroll
        for (int e2 = 0; e2 < 4; ++e2) {
            const float4 t = cs[e2];
            qo1[2 * e2] = a1[2 * e2] * t.x - a2[2 * e2] * t.y; qo2[2 * e2] = a1[2 * e2] * t.y + a2[2 * e2] * t.x;
            qo1[2 * e2 + 1] = a1[2 * e2 + 1] * t.z - a2[2 * e2 + 1] * t.w; qo2[2 * e2 + 1] = a1[2 * e2 + 1] * t.w + a2[2 * e2 + 1] * t.z;
            ko1[2 * e2] = (b1[2 * e2] * t.x - b2[2 * e2] * t.y) * kscale; ko2[2 * e2] = (b1[2 * e2] * t.y + b2[2 * e2] * t.x) * kscale;
            ko1[2 * e2 + 1] = (b1[2 * e2 + 1] * t.z - b2[2 * e2 + 1] * t.w) * kscale; ko2[2 * e2 + 1] = (b1[2 * e2 + 1] * t.w + b2[2 * e2 + 1] * t.z) * kscale;
        }
        *(uint4*)(Qs + j * 136 + dg * 8) = make_uint4(pk2(qo1[0], qo1[1]), pk2(qo1[2], qo1[3]), pk2(qo1[4], qo1[5]), pk2(qo1[6], qo1[7]));
        *(uint4*)(Qs + j * 136 + 64 + dg * 8) = make_uint4(pk2(qo2[0], qo2[1]), pk2(qo2[2], qo2[3]), pk2(qo2[4], qo2[5]), pk2(qo2[6], qo2[7]));
        *(uint4*)(Ks + j * 136 + dg * 8) = make_uint4(pk2(ko1[0], ko1[1]), pk2(ko1[2], ko1[3]), pk2(ko1[4], ko1[5]), pk2(ko1[6], ko1[7]));
        *(uint4*)(Ks + j * 136 + 64 + dg * 8) = make_uint4(pk2(ko2[0], ko2[1]), pk2(ko2[2], ko2[3]), pk2(ko2[4], ko2[5]), pk2(ko2[6], ko2[7]));
    }
#pragma unroll
    for (int q = 0; q < 4; ++q) {
        const int it = tid + 256 * q, j = it >> 4, eg = it & 15;
        const uint4 v = *(const uint4*)(proj + (size_t)(rowbase + j) * NRET + 1536 + h * 128 + eg * 8);
        const uint32_t uu[4] = {v.x, v.y, v.z, v.w};
        const int js = j ^ ((eg & 7) << 3) ^ ((eg >> 3) << 2);
#pragma unroll
        for (int e2 = 0; e2 < 4; ++e2) { Vt[(eg * 8 + 2 * e2) * 72 + js] = (bf16_t)(uu[e2] & 0xffff); Vt[(eg * 8 + 2 * e2 + 1) * 72 + js] = (bf16_t)(uu[e2] >> 16); }
    }
    __syncthreads();
    bf16x8 qf[4];
#pragma unroll
    for (int s = 0; s < 4; ++s) qf[s] = ld8(Qs + (16 * w + lc) * 136 + 32 * s + 8 * g);
    f32x4 st[4];
#pragma unroll
    for (int t = 0; t < 4; ++t) {
        st[t] = (f32x4){0.f, 0.f, 0.f, 0.f};
#pragma unroll
        for (int s = 0; s < 4; ++s) st[t] = MFMA16(ld8(Ks + (16 * t + lc) * 136 + 32 * s + 8 * g), qf[s], st[t]);
    }
    const int ii = 16 * w + lc;
#pragma unroll
    for (int t = 0; t < 4; ++t)
#pragma unroll
        for (int r = 0; r < 4; ++r) { const int j = 16 * t + 4 * g + r; st[t][r] *= exp2f(fabsf((float)(ii - j)) * log2g); }
    f32x4 o[8], oc[8];
#pragma unroll
    for (int et = 0; et < 8; ++et) { o[et] = (f32x4){0.f, 0.f, 0.f, 0.f}; oc[et] = (f32x4){0.f, 0.f, 0.f, 0.f}; }
#pragma unroll
    for (int s = 0; s < 2; ++s) {
        const bf16x8 pb = pack8(st[2 * s], st[2 * s + 1]);
#pragma unroll
        for (int et = 0; et < 8; ++et) { const int sw3 = (2 * et + (lc >> 3)) & 7, hf = ((g & 1) ^ (et >> 2)) * 4; const bf16_t* vr = Vt + (16 * et + lc) * 72 + hf;
            o[et] = MFMA16(ld44(vr + ((4 * s + (g >> 1)) ^ sw3) * 8, vr + ((4 * s + (g >> 1) + 2) ^ sw3) * 8), pb, o[et]); }
    }
#pragma unroll
    for (int et = 0; et < 8; ++et)
#pragma unroll
        for (int s = 0; s < 4; ++s) oc[et] = MFMA16(ld8(rsu + (16 * et + lc) * 128 + 32 * s + 8 * g), qf[s], oc[et]);
    const float xi = exp2f((float)(ii + 1) * log2g);
    float sum = 0.f;
#pragma unroll
    for (int et = 0; et < 8; ++et)
#pragma unroll
        for (int r = 0; r < 4; ++r) { o[et][r] += xi * oc[et][r]; sum += o[et][r]; }
    const float mean = xr16_32_sum(sum) * (1.f / 128.f);
    float sq = 0.f;
#pragma unroll
    for (int et = 0; et < 8; ++et)
#pragma unroll
        for (int r = 0; r < 4; ++r) { const float dd = o[et][r] - mean; sq += dd * dd; }
    const float rstd = rsqrtf(xr16_32_sum(sq) * (1.f / 128.f) + 1e-5f);
    const size_t row = (size_t)rowbase + ii;
    const float* gn = p.in[9] + h * 128;
#pragma unroll
    for (int et = 0; et < 8; ++et) {
        const int e = 16 * et + 4 * g;
        const uint2 gt = *(const uint2*)(proj + row * NRET + 2304 + h * 128 + e);
        const float4 gg = *(const float4*)(gn + e);
        const float y0 = (o[et][0] - mean) * rstd * gg.x * silu(bflo(gt.x)), y1 = (o[et][1] - mean) * rstd * gg.y * silu(bfhi(gt.x));
        const float y2 = (o[et][2] - mean) * rstd * gg.z * silu(bflo(gt.y)), y3 = (o[et][3] - mean) * rstd * gg.w * silu(bfhi(gt.y));
        *(uint2*)(H + row * 1024 + h * 128 + e) = make_uint2(pk2(y0, y1), pk2(y2, y3));
    }
    __syncthreads();
}

__device__ __forceinline__ void glds16_asm(const void* gsrc, unsigned lds_dst) {
    unsigned keep;
    asm volatile("s_mov_b32 %0, m0\n\ts_mov_b32 m0, %2\n\ts_nop 0\n\tglobal_load_lds_dwordx4 %1, off\n\ts_mov_b32 m0, %0" : "=&s"(keep) : "v"(gsrc), "s"(lds_dst) : "memory");
}
__device__ __forceinline__ void mem_attn(const Params& p, int unit, int layer, char* lds) {
    const int tid = TIDX(), lane = tid & 63, w = tid >> 6, g = lane >> 4, lc = lane & 15;
    const bf16_t* Q; int ldq;
    if (layer == 0) { Q = (const bf16_t*)(p.ws + W_RA) + 3072; ldq = NRET; } else { Q = (const bf16_t*)(p.ws + W_QM) + 768; ldq = 1024; }
    int bb, h, r0, npass; bool all8;
    if (unit < 256) { const int b = unit >> 5; h = (unit >> 3) & 3; bb = b; r0 = b * 4096 + (unit & 7) * 512; npass = 4; all8 = true; }
    else { const int us = unit - 256, b = us >> 2; h = us & 3; bb = 8 + b; r0 = TP + b * 64; npass = 1; all8 = false; }
    const bf16_t* mk = (const bf16_t*)(p.ws + W_MK) + (size_t)(layer * 24 + bb) * 65536 + h * 64;
    const bf16_t* mv = (const bf16_t*)(p.ws + W_MVT) + (size_t)((layer * 24 + bb) * 4 + h) * 16384;
    bf16_t* H = (bf16_t*)(p.ws + W_H);
    const float sc = 0.125f * 1.44269504089f;
    asm volatile("s_waitcnt vmcnt(0) lgkmcnt(0)" ::: "memory");
    __syncthreads();
    {
        const unsigned lds_w = (unsigned)__builtin_amdgcn_readfirstlane((int)(unsigned)(size_t)(LAS char*)lds + (tid & ~63) * 16);
#pragma unroll
        for (int i = 0; i < 4; ++i) {
            const int kr = (tid >> 3) + 64 * i, kc = (tid & 7) ^ ((kr >> 1) & 7);
            glds16_asm(mk + (size_t)kr * 256 + kc * 8, lds_w + i * 8192);
            const int vr = (tid >> 5) + 16 * i, vc = (tid & 31) ^ (vr & 15);
            glds16_asm(mv + (size_t)vr * 256 + vc * 8, lds_w + 32768 + i * 8192);
        }
    }
    const bf16_t* Ks = (const bf16_t*)lds; const bf16_t* Vs = (const bf16_t*)(lds + 32768);
    const bool act = all8 || w < 4;
    const size_t rowb = (size_t)r0 + 16 * (all8 ? w : (w & 3)) + lc;
    bf16x8 qf[2];
#pragma unroll
    for (int s = 0; s < 2; ++s) qf[s] = ld8(Q + rowb * ldq + h * 64 + 32 * s + 8 * g);
#pragma unroll
    for (int s = 0; s < 2; ++s) asm volatile("" : "+v"(qf[s]));
    asm volatile("s_waitcnt vmcnt(0)" ::: "memory");
    __syncthreads();
    for (int it = 0; it < npass; ++it) {
        const size_t row = rowb + (size_t)it * 128;
        bf16x8 qn[2];
        if (it + 1 < npass) {
#pragma unroll
            for (int s = 0; s < 2; ++s) qn[s] = ld8(Q + (row + 128) * ldq + h * 64 + 32 * s + 8 * g);
        }
        if (act) {
            f32x4 st[16];
            float mx = -3.0e38f;
#pragma unroll
            for (int t = 0; t < 16; ++t) {
                st[t] = (f32x4){0.f, 0.f, 0.f, 0.f};
#pragma unroll
                for (int s = 0; s < 2; ++s) st[t] = MFMA16(ld8(Ks + (16 * t + lc) * 64 + ((4 * s + g) ^ ((lc >> 1) & 7)) * 8), qf[s], st[t]);
                mx = fmaxf(mx, fmaxf(fmaxf(st[t][0], st[t][1]), fmaxf(st[t][2], st[t][3])));
            }
            mx = xr16_32_max(mx) * sc;
            float sum = 0.f;
#pragma unroll
            for (int t = 0; t < 16; ++t)
#pragma unroll
                for (int r = 0; r < 4; ++r) { st[t][r] = __builtin_amdgcn_exp2f(st[t][r] * sc - mx); sum += st[t][r]; }
            const float inv = 1.f / xr16_32_sum(sum);
            f32x4 o[4];
#pragma unroll
            for (int dt = 0; dt < 4; ++dt) o[dt] = (f32x4){0.f, 0.f, 0.f, 0.f};
#pragma unroll
            for (int s = 0; s < 8; ++s) {
                const bf16x8 pb = pack8(st[2 * s] * inv, st[2 * s + 1] * inv);
#pragma unroll
                for (int dt = 0; dt < 4; ++dt) { const bf16_t* vr = Vs + (16 * dt + lc) * 256 + (g & 1) * 4; o[dt] = MFMA16(ld44(vr + ((4 * s + (g >> 1)) ^ lc) * 8, vr + ((4 * s + (g >> 1) + 2) ^ lc) * 8), pb, o[dt]); }
            }
#pragma unroll
            for (int dt = 0; dt < 4; ++dt) *(uint2*)(H + row * 1024 + 768 + h * 64 + 16 * dt + 4 * g) = make_uint2(pk2(o[dt][0], o[dt][1]), pk2(o[dt][2], o[dt][3]));
        }
        if (it + 1 < npass) { qf[0] = qn[0]; qf[1] = qn[1]; }
    }
    __syncthreads();
}

__device__ __forceinline__ void diff_attn(const Params& p, int rowq0, int h, const bf16_t* Kp, const bf16_t* Vp, int ldv, int nkt, int nkt_lo, bool hi_active, float lam, char* lds) {
    const int tid = TIDX(), lane = tid & 63, w = tid >> 6, g = lane >> 4, lc = lane & 15;
    const bf16_t* QM = (const bf16_t*)(p.ws + W_QM);
    bf16_t* H = (bf16_t*)(p.ws + W_H);
    const size_t row = (size_t)rowq0 + 16 * (hi_active ? w : (w & 3)) + lc;
    const int my_nkt = w < 4 ? nkt_lo : (hi_active ? nkt : 0);
    const float sc = 0.125f * 1.44269504089f;
    bf16x8 qf[2][2];
#pragma unroll
    for (int c = 0; c < 2; ++c)
#pragma unroll
        for (int s = 0; s < 2; ++s) qf[c][s] = ld8(QM + row * 1024 + h * 128 + c * 64 + 32 * s + 8 * g);
    f32x4 o[2][8];
    float m[2] = {0.f, 0.f};
    f32x4 osum[2] = {(f32x4){0.f, 0.f, 0.f, 0.f}, (f32x4){0.f, 0.f, 0.f, 0.f}};
    const bf16x8 onesA = mk8(0x3F803F80u, 0x3F803F80u, 0x3F803F80u, 0x3F803F80u);
#pragma unroll
    for (int c = 0; c < 2; ++c)
#pragma unroll
        for (int dt = 0; dt < 8; ++dt) o[c][dt] = (f32x4){0.f, 0.f, 0.f, 0.f};
    const int kkey = tid >> 4, kdc = tid & 15;
    const int vdim = tid >> 3, vkc = tid & 7;
    const bf16_t* kg0 = Kp + (size_t)kkey * 768 + (kdc ^ (kkey & 15)) * 8;
    const bf16_t* vg0 = Vp + (size_t)vdim * ldv + (vkc ^ (vdim & 7)) * 8;
    const unsigned lds_w = (unsigned)__builtin_amdgcn_readfirstlane((int)(unsigned)(size_t)(LAS char*)lds + (tid & ~63) * 16);
#define DA_ISSUE(vt_) do { const int st_ = (vt_) & 3; const int tt_ = (vt_) < nkt ? (vt_) : nkt - 1; \
        const bf16_t* kg_ = kg0 + (size_t)tt_ * (64 * 768); const bf16_t* vg_ = vg0 + tt_ * 64; const unsigned dst_ = lds_w + st_ * 32768; \
        glds16_asm(kg_, dst_); glds16_asm(kg_ + 32 * 768, dst_ + 8192); glds16_asm(vg_, dst_ + 16384); glds16_asm(vg_ + (size_t)64 * ldv, dst_ + 16384 + 8192); } while (0)
#pragma unroll
    for (int c = 0; c < 2; ++c)
#pragma unroll
        for (int s = 0; s < 2; ++s) asm volatile("" : "+v"(qf[c][s]));
    asm volatile("s_waitcnt vmcnt(0) lgkmcnt(0)" ::: "memory");
    __syncthreads();
    DA_ISSUE(0); DA_ISSUE(1); DA_ISSUE(2);
    asm volatile("s_waitcnt vmcnt(8)" ::: "memory");
    __builtin_amdgcn_s_barrier();
    for (int kt = 0; kt < nkt; ++kt) {
        DA_ISSUE(kt + 3);
        if (kt < my_nkt) {
            const bf16_t* Ks = (const bf16_t*)(lds + (kt & 3) * 32768); const bf16_t* Vt = (const bf16_t*)(lds + (kt & 3) * 32768 + 16384);
            f32x4 st[2][4];
#pragma unroll
            for (int c = 0; c < 2; ++c)
#pragma unroll
                for (int t = 0; t < 4; ++t) {
                    st[c][t] = (f32x4){0.f, 0.f, 0.f, 0.f};
#pragma unroll
                    for (int s = 0; s < 2; ++s) st[c][t] = MFMA16(ld8(Ks + (16 * t + lc) * 128 + ((c * 8 + 4 * s + g) ^ lc) * 8), qf[c][s], st[c][t]);
                }
#pragma unroll
            for (int c = 0; c < 2; ++c) {
                const float mneg = -m[c];
#pragma unroll
                for (int t = 0; t < 4; ++t)
#pragma unroll
                    for (int r = 0; r < 4; ++r) st[c][t][r] = __builtin_fmaf(st[c][t][r], sc, mneg);
                float mx = -3.0e38f;
#pragma unroll
                for (int t = 0; t < 4; ++t) mx = fmaxf(mx, fmaxf(fmaxf(st[c][t][0], st[c][t][1]), fmaxf(st[c][t][2], st[c][t][3])));
                mx = xr16_32_max(mx);
                const bool first = kt == 0;
                if (first || __builtin_amdgcn_ballot_w64(mx > 8.f) != 0ull) {
                    const float d = first ? mx : fmaxf(mx, 0.f);
                    m[c] += d;
                    if (!first) {
                        const float al = __builtin_amdgcn_exp2f(-d);
                        osum[c] = osum[c] * al;
#pragma unroll
                        for (int dt = 0; dt < 8; ++dt) o[c][dt] = o[c][dt] * al;
                    }
#pragma unroll
                    for (int t = 0; t < 4; ++t)
#pragma unroll
                        for (int r = 0; r < 4; ++r) st[c][t][r] -= d;
                }
#pragma unroll
                for (int t = 0; t < 4; ++t)
#pragma unroll
                    for (int r = 0; r < 4; ++r) st[c][t][r] = __builtin_amdgcn_exp2f(st[c][t][r]);
            }
#pragma unroll
            for (int s = 0; s < 2; ++s) {
                const bf16x8 pb0 = pack8(st[0][2 * s], st[0][2 * s + 1]), pb1 = pack8(st[1][2 * s], st[1][2 * s + 1]);
                osum[0] = MFMA16(onesA, pb0, osum[0]); osum[1] = MFMA16(onesA, pb1, osum[1]);
#pragma unroll
                for (int dt = 0; dt < 8; ++dt) {
                    const bf16x8 va = ld8(Vt + (16 * dt + lc) * 64 + ((4 * s + g) ^ (lc & 7)) * 8);
                    o[0][dt] = MFMA16(va, pb0, o[0][dt]); o[1][dt] = MFMA16(va, pb1, o[1][dt]);
                }
            }
        }
        asm volatile("s_waitcnt vmcnt(8) lgkmcnt(0)" ::: "memory");
        __builtin_amdgcn_s_barrier();
    }
    asm volatile("s_waitcnt vmcnt(0)" ::: "memory");
    if (my_nkt > 0) {
        const float i0 = 1.f / osum[0][0], i1 = lam / osum[1][0];
        float sq = 0.f;
#pragma unroll
        for (int dt = 0; dt < 8; ++dt)
#pragma unroll
            for (int r = 0; r < 4; ++r) { const float v = o[0][dt][r] * i0 - o[1][dt][r] * i1; o[0][dt][r] = v; sq += v * v; }
        const float rs = rsqrtf(xr16_32_sum(sq) * (1.f / 128.f) + 1e-5f) * (1.f - LAM_INIT);
        const float* sg = p.in[15];
#pragma unroll
        for (int dt = 0; dt < 8; ++dt) {
            const int e = 16 * dt + 4 * g;
            const float4 gg = *(const float4*)(sg + e);
            *(uint2*)(H + row * 1024 + h * 128 + e) = make_uint2(pk2(o[0][dt][0] * rs * gg.x, o[0][dt][1] * rs * gg.y), pk2(o[0][dt][2] * rs * gg.z, o[0][dt][3] * rs * gg.w));
        }
    }
#undef DA_ISSUE
}

__device__ __forceinline__ void phase_ln(const Params& p, const float* gam, const float* bet, const bf16_t* Zb, bf16_t* Xd, bool fin) {
    const int lane = TIDX() & 63, w = TIDX() >> 6;
    float4 gg[4], bb[4];
#pragma unroll
    for (int i = 0; i < 4; ++i) { gg[i] = ((const float4*)gam)[lane + 64 * i]; bb[i] = ((const float4*)bet)[lane + 64 * i]; }
    for (int row = BIDX() * 8 + w; row < TT; row += gridDim.x * 8) {
        const uint2* z = (const uint2*)(Zb + (size_t)row * 1024);
        float4 v[4]; float s = 0.f;
#pragma unroll
        for (int i = 0; i < 4; ++i) { const uint2 u = z[lane + 64 * i]; v[i] = make_float4(bflo(u.x), bfhi(u.x), bflo(u.y), bfhi(u.y)); s += (v[i].x + v[i].y) + (v[i].z + v[i].w); }
        const float mean = wave_sum(s) * (1.f / 1024.f);
        float q = 0.f;
#pragma unroll
        for (int i = 0; i < 4; ++i) { v[i].x -= mean; v[i].y -= mean; v[i].z -= mean; v[i].w -= mean; q += (v[i].x * v[i].x + v[i].y * v[i].y) + (v[i].z * v[i].z + v[i].w * v[i].w); }
        const float rstd = rsqrtf(wave_sum(q) * (1.f / 1024.f) + 1e-5f);
        uint2* xd = (uint2*)(Xd + (size_t)row * 1024);
        float4* yo = (float4*)(p.out + (size_t)row * 1024);
#pragma unroll
        for (int i = 0; i < 4; ++i) {
            float4 y; y.x = v[i].x * rstd * gg[i].x + bb[i].x; y.y = v[i].y * rstd * gg[i].y + bb[i].y; y.z = v[i].z * rstd * gg[i].z + bb[i].z; y.w = v[i].w * rstd * gg[i].w + bb[i].w;
            if (fin) yo[lane + 64 * i] = y; else xd[lane + 64 * i] = make_uint2(pk2(y.x, y.y), pk2(y.z, y.w));
        }
    }
}

__device__ __forceinline__ int next_unit(int* ctr, char* lds) {
    int* slot = (int*)(lds + LDS_MAIN);
    if (TIDX() == 0) *slot = atomicAdd(ctr, 1);
    __syncthreads();
    const int u = *slot;
    __syncthreads();
    return u;
}


#define XB_TMO      128
#define XB_XCNT(j)  (256  + 64 * (j))
#define XB_XSUB(j)  (1280 + 64 * (j))
#define XB_XGEN(j)  (2304 + 64 * (j))
#define XB_TOP      3328
#define XB_TOPGEN   3392
#define XCD_BAR_WORDS 3456
#define XB_SPIN_CAP (1u << 18)
__device__ __forceinline__ unsigned xb_ld(unsigned* p)              { return __hip_atomic_load(p, __ATOMIC_RELAXED, __HIP_MEMORY_SCOPE_AGENT); }
__device__ __forceinline__ unsigned xb_add(unsigned* p, unsigned v) { return __hip_atomic_fetch_add(p, v, __ATOMIC_RELAXED, __HIP_MEMORY_SCOPE_AGENT); }
__device__ __forceinline__ unsigned xb_xcc_id() { return (unsigned)__builtin_amdgcn_s_getreg((3 << 11) | 20) & 0xFu; }
#define XB_SPIN(cond, bar) do { unsigned _sp = 0; while (cond) { __builtin_amdgcn_s_sleep(1); \
    if ((++_sp & 255u) == 0u) { if (xb_ld(&(bar)[XB_TMO])) break; if (_sp > XB_SPIN_CAP) { atomicAdd(&(bar)[XB_TMO], 1u); break; } } } } while (0)
struct XcdBarrier { unsigned* bar; unsigned x; volatile LAS unsigned* st; };
__device__ __forceinline__ XcdBarrier xcd_barrier_post(unsigned* bar, volatile LAS unsigned* st) {
    XcdBarrier b; b.bar = bar; b.x = xb_xcc_id(); b.st = st;
    if (TIDX() == 0) (void)xb_add(&bar[XB_XCNT(b.x)], 1u);
    return b;
}
__device__ __forceinline__ void xcd_barrier_complete(unsigned* bar, unsigned x, unsigned& nloc, unsigned& nx) {
    const unsigned G = gridDim.x * gridDim.y * gridDim.z;
    unsigned sum, cnt, mine, sp = 0u;
    for (;;) {
        sum = 0u; cnt = 0u; mine = 0u;
#pragma unroll
        for (unsigned j = 0; j < 16; ++j) { const unsigned c = xb_ld(&bar[XB_XCNT(j)]); sum += c; cnt += (c > 0u) ? 1u : 0u; mine = (j == x) ? c : mine; }
        if (sum == G) break;
        __builtin_amdgcn_s_sleep(1);
        if ((++sp & 255u) == 0u) { if (xb_ld(&bar[XB_TMO])) break; if (sp > XB_SPIN_CAP) { atomicAdd(&bar[XB_TMO], 1u); break; } }
    }
    nloc = mine > 0u ? mine : 1u; nx = cnt > 0u ? cnt : 1u;
}
__device__ __forceinline__ void xcd_barrier(const XcdBarrier& b) {
    asm volatile("s_waitcnt vmcnt(0)" ::: "memory");
    __syncthreads();
    if (TIDX() == 0) {
        unsigned* bar = b.bar;
        __builtin_amdgcn_s_waitcnt(0);
        unsigned nloc = b.st[0], nx = b.st[1];
        if (nloc == 0u) { xcd_barrier_complete(bar, b.x, nloc, nx); b.st[0] = nloc; b.st[1] = nx; }
        const unsigned old = xb_add(&bar[XB_XSUB(b.x)], 1u);
        const unsigned gen = old / nloc;
        if (old + 1u == (gen + 1u) * nloc) {
            __builtin_amdgcn_fence(__ATOMIC_RELEASE, "agent");
            asm volatile("s_waitcnt vmcnt(0)" ::: "memory");
            const unsigned og = xb_add(&bar[XB_TOP], 1u);
            const unsigned tg = og / nx;
            if (og + 1u == (tg + 1u) * nx) xb_add(&bar[XB_TOPGEN], 1u);
            else XB_SPIN(xb_ld(&bar[XB_TOPGEN]) == tg, bar);
            __builtin_amdgcn_fence(__ATOMIC_ACQUIRE, "agent");
            xb_add(&bar[XB_XGEN(b.x)], 1u);
            asm volatile("s_waitcnt vmcnt(0)" ::: "memory");
        } else {
            XB_SPIN(xb_ld(&bar[XB_XGEN(b.x)]) == gen, bar);
            __builtin_amdgcn_fence(__ATOMIC_ACQUIRE, "agent");
            asm volatile("s_waitcnt vmcnt(0)" ::: "memory");
        }
    }
    __syncthreads();
}

constexpr int MA_P2 = 160;
__device__ __forceinline__ void run_phase(const Params& p_, const int ph, const int l, char* lds, const int cslot = 0) {
    Params p = p_;
    asm volatile("" : "+s"(p.ws), "+s"(p.out));
    char* ws = p.ws;
    bf16_t* XB = (bf16_t*)(ws + W_XB); bf16_t* Hb = (bf16_t*)(ws + W_H); bf16_t* RA = (bf16_t*)(ws + W_RA);
    int* ctr = (int*)(ws + W_CTRL);
    switch (ph) {
    case 0: phase_prep(p, lds); break;
    case 1: {
        gemm_phase(XB, (const bf16_t*)(ws + W_WRET), 1024, TT / 256, NRET / 256, lds, EpiBf16{RA, NRET});
        for (int ll = 0; ll < 2; ++ll)
            gemm_phase((const bf16_t*)(ws + W_MB), (const bf16_t*)(ws + W_WMKV) + (size_t)ll * 512 * 1024, 1024, 8, 2, lds,
                       EpiMemKV{p.out + O_MKP + (size_t)ll * 524288, p.out + O_MVP + (size_t)ll * 524288, (bf16_t*)(ws + W_MK) + (size_t)ll * 24 * 65536, (bf16_t*)(ws + W_MVT) + (size_t)ll * 24 * 65536},
                       (1716 % 256 + 16 * ll) % (int)gridDim.x);
    } break;
    case 2: {
        bf16_t* RS = (bf16_t*)(p.out + O_DKP);
        for (;;) {
            const int u = next_unit(ctr + 0 + cslot, lds);
            if (u >= 192 + 384 + MA_P2) break;
            if (u < 576) {
                const bool pr = u < 192; const int us = pr ? u : u - 192, chain = us >> 2, sl = us & 3, b = chain / 6, h = chain % 6;
                ret_chain(p, h, sl, pr ? 64 : 1, pr ? b * 4096 : TP + b * 64, pr ? 0 : 1024, pr ? nullptr : p.in[3] + (size_t)chain * 16384,
                          RS + (pr ? (size_t)chain * 64 : (size_t)(3072 + chain)) * 16384, p.out + (pr ? O_RSP : O_RSS) + (size_t)chain * 16384, lds);
            }
            else mem_attn(p, u - 576, 0, lds);
        }
    } break;
    case 3: {
        for (int u2 = BIDX(); u2 < 1584; u2 += gridDim.x) ret_out(p, u2, lds);
        const int busy = (int)gridDim.x <= 1584 ? 1584 % (int)gridDim.x : 0;
        if (BIDX() >= busy)
            for (;;) { const int u = next_unit(ctr + 2, lds); if (u >= 320 - MA_P2) break; mem_attn(p, MA_P2 + u, 0, lds); }
    } break;
    case 4: gemm_phase(Hb, (const bf16_t*)(ws + W_WO) + (size_t)l * 1024 * 1024, 1024, TT / 256, 4, lds, EpiResid{XB, RA}); break;
    case 5: phase_ln(p, p.in[18] + l * 1024, p.in[19] + l * 1024, RA, Hb, false); break;
    case 6: gemm_phase(Hb, (const bf16_t*)(ws + W_WGU) + (size_t)l * 5632 * 1024, 1024, TT / 256, 22, lds, EpiGU{RA}); break;
    case 7: gemm_phase(RA, (const bf16_t*)(ws + W_WD) + (size_t)l * 1024 * DFF, DFF, TT / 256, 4, lds, EpiResid{Hb, XB}); break;
    case 8: phase_ln(p, p.in[23] + l * 1024, p.in[24] + l * 1024, XB, XB, l == 1); break;
    case 9: {
        { uint2* dst = (uint2*)(ws + W_KBS); const float4* s = (const float4*)p.in[4];
          const int skip = (int)gridDim.x > 80 ? 40 : 0, cb = BIDX() - skip, ncb = (int)gridDim.x - skip;
          const size_t per = 1024ull * 192, gt = (size_t)cb * NTHR + TIDX(), gs = (size_t)ncb * NTHR;
          if (cb >= 0) for (size_t i = gt; i < 16 * per; i += gs) { const size_t b = i / per, rem = i - b * per; const float4 v = s[i]; dst[b * (1088ull * 192) + rem] = make_uint2(pk2(v.x, v.y), pk2(v.z, v.w)); } }
        { const int tid = TIDX(), half = tid >> 8;
          const int skip = (int)gridDim.x > 80 ? 40 : 0, cb = BIDX() - skip, ncb = (int)gridDim.x - skip;
          if (cb >= 0 && cb < 1536) {
              float* tile = (float*)lds + half * 4224; const int tl = tid & 255;
              TrDesc dc = tr_desc9(p, 2 * cb + half); float4 r[4]; tr_load(dc, r, tl);
              for (int it2 = cb; it2 < 1536; it2 += ncb) {
                  const bool has = it2 + ncb < 1536;
                  TrDesc dn = dc; float4 rn[4];
                  if (has) { dn = tr_desc9(p, 2 * (it2 + ncb) + half); tr_load(dn, rn, tl); }
                  tr_finish(dc, r, tile, tl);
                  if (has) { dc = dn;
#pragma unroll
                      for (int i = 0; i < 4; ++i) r[i] = rn[i]; }
              }
          } }
        gemm_phase(XB, (const bf16_t*)(ws + W_WDIFF), 1024, TT / 256, NDIFF / 256, lds,
                   EpiProj1{(bf16_t*)(ws + W_QM), (bf16_t*)(ws + W_KBP), (bf16_t*)(ws + W_KBS), (bf16_t*)(ws + W_VTP), (bf16_t*)(ws + W_VTS), p.out, (const float2*)(ws + W_ROPED)});
    } break;
    case 10: {
        float lam;
        { const int lane = TIDX() & 63; const float a = wave_sum(p.in[11][lane] * p.in[12][lane]), b = wave_sum(p.in[13][lane] * p.in[14][lane]); lam = expf(a) - expf(b) + LAM_INIT; }
        for (;;) {
            const int u = next_unit(ctr + 1 + cslot, lds);
            if (u >= 1536 + 96 + 320) break;
            if (u < 1632) {
                const bool pr = u >= 96; const int up = u - 96, qp = 31 - up / 48, bh = pr ? up % 48 : u, b = bh / 6, h = bh % 6;
                diff_attn(p, pr ? b * 4096 + qp * 128 : TP + b * 64, h,
                          pr ? (const bf16_t*)(ws + W_KBP) + (size_t)b * 4096 * 768 + h * 128 : (const bf16_t*)(ws + W_KBS) + (size_t)b * 1088 * 768 + h * 128,
                          pr ? (const bf16_t*)(ws + W_VTP) + (size_t)bh * 128 * 4096 : (const bf16_t*)(ws + W_VTS) + (size_t)bh * 128 * 1088,
                          pr ? 4096 : 1088, pr ? 2 * qp + 2 : 17, pr ? 2 * qp + 1 : 17, pr, lam, lds);
            }
            else mem_attn(p, u - 1632, 1, lds);
        }
    } break;
    default: break;
    }
}

#ifndef PROBE_PH
#define PROBE_PH -1
#endif
extern "C" __global__ void __launch_bounds__(512, 2) mega_fwd(Params p) {
    extern __shared__ __attribute__((aligned(16))) char lds[];
    cg::grid_group grid = cg::this_grid();
    volatile LAS unsigned* xst = (volatile LAS unsigned*)(lds + LDS_MAIN + 16);
    if (TIDX() == 0) { xst[0] = 0u; xst[1] = 0u; }
    __syncthreads();
    (void)xcd_barrier_post((unsigned*)(p.ws + W_CTRL), xst);
#define XBAR() do { XcdBarrier xb_; xb_.bar = (unsigned*)(p.ws + W_CTRL); xb_.x = xb_xcc_id(); xb_.st = (volatile LAS unsigned*)(lds + LDS_MAIN + 16); xcd_barrier(xb_); } while (0)
    run_phase(p, 0, 0, lds);
    if (p.ph_lo != 0) grid.sync();
    XBAR();
#if PROBE_PH == 0
    run_phase(p, 0, 0, lds); XBAR();
#endif
    run_phase(p, 1, 0, lds); XBAR();
    run_phase(p, 2, 0, lds); XBAR();
#if PROBE_PH == 2
    run_phase(p, 2, 0, lds, 2); XBAR();
#endif
    run_phase(p, 3, 0, lds); XBAR();
#if PROBE_PH == 3
    run_phase(p, 3, 0, lds); XBAR();
#endif
    run_phase(p, 4, 0, lds); XBAR();
    run_phase(p, 5, 0, lds); XBAR();
    run_phase(p, 6, 0, lds); XBAR();
    run_phase(p, 7, 0, lds); XBAR();
    run_phase(p, 8, 0, lds); XBAR();
    run_phase(p, 9, 1, lds); XBAR();
    run_phase(p, 10, 1, lds); XBAR();
    run_phase(p, 4, 1, lds); XBAR();
    run_phase(p, 5, 1, lds); XBAR();
    run_phase(p, 6, 1, lds); XBAR();
    run_phase(p, 7, 1, lds); XBAR();
    run_phase(p, 8, 1, lds);
}

#ifndef PROBE_PH
#define PROBE_PH -1
#endif
#ifndef MULTI_LAUNCH
#define MULTI_LAUNCH 0
#endif
#if MULTI_LAUNCH
extern "C" __global__ void __launch_bounds__(512, 2) phase_kernel(Params p) {
    extern __shared__ __attribute__((aligned(16))) char lds[];
    switch (p.ph_lo) {
    case 0: run_phase(p, 0, 0, lds); break;
    case 1: run_phase(p, 1, 0, lds); break;
    case 2: run_phase(p, 2, 0, lds); break;
    case 3: run_phase(p, 3, 0, lds); break;
    case 4: run_phase(p, 4, p.ph_hi, lds); break;
    case 5: run_phase(p, 5, p.ph_hi, lds); break;
    case 6: run_phase(p, 6, p.ph_hi, lds); break;
    case 7: run_phase(p, 7, p.ph_hi, lds); break;
    case 8: run_phase(p, 8, p.ph_hi, lds); break;
    case 9: run_phase(p, 9, 1, lds); break;
    case 10: run_phase(p, 10, 1, lds); break;
    default: break;
    }
}
#endif

extern "C" void kernel_launch(void* const* d_in, const int* in_sizes, int n_in, void* d_out, int out_size, void* d_ws, size_t ws_size, hipStream_t stream) {
    static int grid = 0;
#if MULTI_LAUNCH
    const void* kfn = (const void*)phase_kernel;
#else
    const void* kfn = (const void*)mega_fwd;
#endif
    if (grid == 0) {
        int dev = 0, cus = 0, per_cu = 0;
        (void)hipGetDevice(&dev);
        (void)hipDeviceGetAttribute(&cus, hipDeviceAttributeMultiprocessorCount, dev);
        (void)hipFuncSetAttribute(kfn, hipFuncAttributeMaxDynamicSharedMemorySize, LDS_BYTES);
        (void)hipOccupancyMaxActiveBlocksPerMultiprocessor(&per_cu, kfn, NTHR, LDS_BYTES);
        if (per_cu < 1) { fprintf(stderr, "kernel_launch: occupancy query reports %d blocks per CU\n", per_cu); per_cu = 1; }
        grid = cus;
        if (ws_size < W_END) { fprintf(stderr, "kernel_launch: workspace too small: %zu < %zu\n", ws_size, (size_t)W_END); grid = -1; }
    }
    if (grid < 0) return;
    (void)hipMemsetAsync((char*)d_ws + W_CTRL, 0, 16384, stream);
    Params p{};
    for (int i = 0; i < 25; ++i) p.in[i] = (const float*)d_in[i];
    p.out = (float*)d_out; p.ws = (char*)d_ws; p.ph_lo = 0; p.ph_hi = 16;
#if MULTI_LAUNCH
    static const int seq[16][2] = {{0,0},{1,0},{2,0},{3,0},{4,0},{5,0},{6,0},{7,0},{8,0},{9,1},{10,1},{4,1},{5,1},{6,1},{7,1},{8,1}};
    for (int i = 0; i < 16; ++i) {
        p.ph_lo = seq[i][0]; p.ph_hi = seq[i][1];
        hipLaunchKernelGGL(phase_kernel, dim3(grid), dim3(NTHR), LDS_BYTES, stream, p);
    }
#else
    void* args[] = {&p};
    hipError_t e = hipLaunchCooperativeKernel(kfn, dim3(grid), dim3(NTHR), args, LDS_BYTES, stream);
    if (e != hipSuccess) fprintf(stderr, "cooperative launch failed: %s (grid %d)\n", hipGetErrorString(e), grid);
#endif
}
```
